# Optimizing an MI355X kernel written in HIP

```python
import math
import jax, jax.numpy as jnp
from jax import lax
import numpy as np

D_MODEL = 1024
BATCH = 4
SEQ = 8192
DEPTH = 1

D_MIX = D_MODEL
D_LRU = D_MIX // 2
LRU_HEADS = 8
LRU_HEAD_DIM = D_LRU // LRU_HEADS
CONV_WIDTH = 4
LRU_C = 8.0
D_FOURIER = D_MIX - D_LRU
FOURIER_GROUPS = 4
FOURIER_GROUP_DIM = D_FOURIER // FOURIER_GROUPS
D_IN_PROJ = 2 * D_LRU + D_FOURIER
N_EXPERTS = 16
CAPACITY_FACTOR = 2
D_FF_EXPERT = 2 * D_MODEL
EPS = 1e-6

kernel_name = "hybrid_rglru_fourier_ecmoe_encoder"


def rmsnorm(x, g):
    xf = x.astype(jnp.float32)
    y = xf * lax.rsqrt(jnp.mean(xf * xf, axis=-1, keepdims=True) + EPS)
    return (y * g.astype(jnp.float32)).astype(x.dtype)


def centred_depthwise_conv(u, w, b):
    s = u.shape[1]
    left = CONV_WIDTH // 2
    right = CONV_WIDTH - 1 - left
    up = jnp.pad(u, ((0, 0), (left, right), (0, 0)))
    out = b
    for k in range(CONV_WIDTH):
        out = out + w[k] * up[:, k:k + s, :]
    return out


def _linear_recurrence_combine(left, right):
    a1, b1 = left
    a2, b2 = right
    return a1 * a2, a2 * b1 + b2


def rglru(u, w_a, b_a, w_x, b_x, lam, reverse):
    bsz, s, _ = u.shape
    uf = u.astype(jnp.float32)
    uh = uf.reshape(bsz, s, LRU_HEADS, LRU_HEAD_DIM)
    r = jax.nn.sigmoid(jnp.einsum('bshi,hij->bshj', uh, w_a.astype(jnp.float32)).reshape(bsz, s, D_LRU) + b_a)
    i = jax.nn.sigmoid(jnp.einsum('bshi,hij->bshj', uh, w_x.astype(jnp.float32)).reshape(bsz, s, D_LRU) + b_x)
    log_a = LRU_C * r * jax.nn.log_sigmoid(lam.astype(jnp.float32))
    a = jnp.exp(log_a)
    mult = jnp.sqrt(-jnp.expm1(2.0 * log_a))
    bterm = mult * (i * uf)
    _, h = lax.associative_scan(_linear_recurrence_combine, (a, bterm), axis=1, reverse=reverse)
    return h


def fourier_mix(u):
    bsz, s, _ = u.shape
    f = u.astype(jnp.float32).reshape(bsz, s, FOURIER_GROUPS, FOURIER_GROUP_DIM)
    y = jnp.fft.fft2(f, axes=(1, 3), norm='ortho').real
    return y.reshape(bsz, s, D_FOURIER)


def expert_choice_moe(h, w_router, w_gate, w_up, w_down):
    bsz, s, d = h.shape
    cap = CAPACITY_FACTOR * s // N_EXPERTS
    logits = jnp.einsum('bsd,de->bse', h.astype(jnp.float32), w_router.astype(jnp.float32))
    aff = jax.nn.softmax(logits, axis=-1)
    scores = jnp.transpose(aff, (0, 2, 1))
    gate, idx = lax.top_k(scores, cap)
    bidx = jnp.arange(bsz)[:, None, None]
    xin = h[bidx, idx]
    g = jnp.einsum('becd,edf->becf', xin, w_gate)
    u = jnp.einsum('becd,edf->becf', xin, w_up)
    eo = jnp.einsum('becf,efd->becd', jax.nn.silu(g) * u, w_down)
    contrib = gate.astype(eo.dtype)[..., None] * eo
    out = jnp.zeros((bsz, s, d), dtype=eo.dtype).at[bidx, idx].add(contrib)
    return out


def setup_inputs(seed: int = 0) -> dict:
    key = jax.random.key(seed)
    ks = jax.random.split(key, 24)
    f32 = jnp.float32
    nrm = lambda k, shape, scale: jax.random.normal(k, shape, f32) * scale

    def lam_init(k):
        u = jax.random.uniform(k, (D_LRU,), f32, 0.9, 0.999)
        return jnp.log(u) - jnp.log1p(-u)

    return {
        "x": nrm(ks[0], (BATCH, SEQ, D_MODEL), 1.0),
        "norm1_g": 1.0 + nrm(ks[1], (D_MODEL,), 0.02),
        "w_in": nrm(ks[2], (D_MODEL, D_IN_PROJ), D_MODEL ** -0.5),
        "conv_w": nrm(ks[3], (CONV_WIDTH, D_LRU), CONV_WIDTH ** -0.5),
        "conv_b": nrm(ks[4], (D_LRU,), 0.01),
        "lru_wa_f": nrm(ks[5], (LRU_HEADS, LRU_HEAD_DIM, LRU_HEAD_DIM), LRU_HEAD_DIM ** -0.5),
        "lru_ba_f": nrm(ks[6], (D_LRU,), 0.01),
        "lru_wx_f": nrm(ks[7], (LRU_HEADS, LRU_HEAD_DIM, LRU_HEAD_DIM), LRU_HEAD_DIM ** -0.5),
        "lru_bx_f": nrm(ks[8], (D_LRU,), 0.01),
        "lru_lam_f": lam_init(ks[9]),
        "lru_wa_b": nrm(ks[10], (LRU_HEADS, LRU_HEAD_DIM, LRU_HEAD_DIM), LRU_HEAD_DIM ** -0.5),
        "lru_ba_b": nrm(ks[11], (D_LRU,), 0.01),
        "lru_wx_b": nrm(ks[12], (LRU_HEADS, LRU_HEAD_DIM, LRU_HEAD_DIM), LRU_HEAD_DIM ** -0.5),
        "lru_bx_b": nrm(ks[13], (D_LRU,), 0.01),
        "lru_lam_b": lam_init(ks[14]),
        "w_out": nrm(ks[15], (D_MIX, D_MODEL), D_MIX ** -0.5),
        "norm2_g": 1.0 + nrm(ks[16], (D_MODEL,), 0.02),
        "w_router": nrm(ks[17], (D_MODEL, N_EXPERTS), D_MODEL ** -0.5),
        "w_gate": nrm(ks[18], (N_EXPERTS, D_MODEL, D_FF_EXPERT), D_MODEL ** -0.5),
        "w_up": nrm(ks[19], (N_EXPERTS, D_MODEL, D_FF_EXPERT), D_MODEL ** -0.5),
        "w_down": nrm(ks[20], (N_EXPERTS, D_FF_EXPERT, D_MODEL), D_FF_EXPERT ** -0.5),
        "normf_g": 1.0 + nrm(ks[21], (D_MODEL,), 0.02),
    }


def reference(x, norm1_g, w_in, conv_w, conv_b,
              lru_wa_f, lru_ba_f, lru_wx_f, lru_bx_f, lru_lam_f,
              lru_wa_b, lru_ba_b, lru_wx_b, lru_bx_b, lru_lam_b,
              w_out, norm2_g, w_router, w_gate, w_up, w_down, normf_g):
    for _ in range(DEPTH):
        h = rmsnorm(x, norm1_g)
        p = jnp.einsum('bsd,dn->bsn', h, w_in)
        lru_x = p[..., :D_LRU]
        lru_gate = p[..., D_LRU:2 * D_LRU]
        four_in = p[..., 2 * D_LRU:]
        c = centred_depthwise_conv(lru_x, conv_w, conv_b)
        h_f = rglru(c, lru_wa_f, lru_ba_f, lru_wx_f, lru_bx_f, lru_lam_f, reverse=False)
        h_b = rglru(c, lru_wa_b, lru_ba_b, lru_wx_b, lru_bx_b, lru_lam_b, reverse=True)
        y_lru = (jax.nn.gelu(lru_gate.astype(jnp.float32)) * (h_f + h_b)).astype(x.dtype)
        y_four = fourier_mix(four_in).astype(x.dtype)
        mixed = jnp.concatenate([y_lru, y_four], axis=-1)
        x = x + jnp.einsum('bsm,md->bsd', mixed, w_out)
        h2 = rmsnorm(x, norm2_g)
        x = x + expert_choice_moe(h2, w_router, w_gate, w_up, w_down).astype(x.dtype)
    return rmsnorm(x, normf_g)
```

```cpp
#include <hip/hip_runtime.h>
#include <hip/hip_cooperative_groups.h>
#include <cstdio>
#include <cstdint>
namespace cg = cooperative_groups;

#ifndef USE_COOP
#define USE_COOP 2
#endif
#ifndef N_LAUNCH_PER_PHASE
#define N_LAUNCH_PER_PHASE 0
#endif
#ifndef DBG_NO_MOE
#define DBG_NO_MOE 0
#endif

#ifndef REPEAT_PHASE
#define REPEAT_PHASE -1
#endif
#ifndef REPEAT_N
#define REPEAT_N 0
#endif
#define LAS __attribute__((address_space(3)))
typedef unsigned short bf16_t;
typedef short bf16x8 __attribute__((ext_vector_type(8)));
typedef float f32x4 __attribute__((ext_vector_type(4)));
typedef float f32x2 __attribute__((ext_vector_type(2)));
typedef unsigned u32x4 __attribute__((ext_vector_type(4)));
typedef unsigned u32x2 __attribute__((ext_vector_type(2)));
typedef int i32x4 __attribute__((ext_vector_type(4)));
typedef int i32x8 __attribute__((ext_vector_type(8)));

constexpr int NB = 4, SEQ = 8192, DM = 1024, MTOK = NB * SEQ;
constexpr int DLRU = 512, NHEAD = 8, HDIM = 64, NPROJ = 1536, KOUT = 1536;
constexpr int NEXP = 16, CAP = 1024, DFF = 2048, EROWS = NB * CAP;
constexpr float EPS = 1e-6f;
constexpr int NTHREADS = 512, NWAVES = 8;
constexpr int LDS_BYTES = 147456;
constexpr int MISC_OFF = 131072 + 8192;

constexpr size_t KiB = 1024, MiB = 1u << 20;
constexpr size_t WS_CTL = 0;
constexpr size_t WS_RSTD1 = 64 * KiB;
constexpr size_t WS_WGT = 256 * KiB;
constexpr size_t WS_IDX = 512 * KiB;
constexpr size_t WS_GATE = 768 * KiB;
constexpr size_t WS_AGG = 1 * MiB;
constexpr size_t WS_SCORES = 3 * MiB;
constexpr size_t WS_INV = 5 * MiB;
constexpr size_t WS_RS = 7 * MiB;
constexpr size_t WS_TOK = 7 * MiB + 256 * KiB;
constexpr size_t WS_WGU = 8 * MiB;
constexpr size_t WS_EO = 8 * MiB;
constexpr size_t WS_WD = 136 * MiB;
constexpr size_t WS_H = 200 * MiB;
constexpr size_t WS_XB = 436 * MiB;
constexpr size_t WS_V = 200 * MiB;
constexpr size_t WS_A2 = 270 * MiB;
constexpr size_t WS_WIN = 366 * MiB;
constexpr size_t WS_W2 = 369 * MiB;
constexpr size_t WS_DELTA = 372 * MiB;
constexpr size_t WS_H2 = 168 * MiB;
constexpr size_t WS_END = 520 * MiB;

__device__ __forceinline__ unsigned f2bf(float f) { unsigned u = __builtin_bit_cast(unsigned, f); return (u + 0x7fffu + ((u >> 16) & 1u)) >> 16; }
__device__ __forceinline__ unsigned pk2(float lo, float hi) { return f2bf(lo) | (f2bf(hi) << 16); }
__device__ __forceinline__ unsigned cvt_pk_bf16(float lo, float hi) { unsigned r; asm volatile("v_cvt_pk_bf16_f32 %0, %1, %2" : "=v"(r) : "v"(lo), "v"(hi)); return r; }
__device__ __forceinline__ float bf2f(unsigned h) { return __builtin_bit_cast(float, h << 16); }
__device__ __forceinline__ float wave_sum(float v) {
#pragma unroll
    for (int o = 1; o < 64; o <<= 1) v += __shfl_xor(v, o);
    return v;
}
__device__ __forceinline__ float fast_sigmoid(float x) { return __builtin_amdgcn_rcpf(1.0f + __builtin_amdgcn_exp2f(-1.4426950408889634f * x)); }
__device__ __forceinline__ unsigned pk4_fp8(float a, float b, float c, float d) { int w = 0; w = __builtin_amdgcn_cvt_pk_fp8_f32(a, b, w, false); w = __builtin_amdgcn_cvt_pk_fp8_f32(c, d, w, true); return (unsigned)w; }
__device__ __forceinline__ float xchg16(float v, int lane) { const unsigned u = __builtin_bit_cast(unsigned, v); const auto r = __builtin_amdgcn_permlane16_swap(u, u, false, false); return __builtin_bit_cast(float, (lane & 16) ? r[0] : r[1]); }
__device__ __forceinline__ float xchg32(float v, int lane) { const unsigned u = __builtin_bit_cast(unsigned, v); const auto r = __builtin_amdgcn_permlane32_swap(u, u, false, false); return __builtin_bit_cast(float, (lane & 32) ? r[0] : r[1]); }
#define LDS_WAIT() asm volatile("s_waitcnt lgkmcnt(0)" ::: "memory")

#define XB_TMO      128
#define XB_XCNT(j)  (256  + 64 * (j))
#define XB_XSUB(j)  (1280 + 64 * (j))
#define XB_XGEN(j)  (2304 + 64 * (j))
#define XB_TOP      3328
#define XB_TOPGEN   3392
#define XCD_BAR_WORDS 3456
#define XB_SPIN_CAP (1u << 20)
__device__ __forceinline__ unsigned xb_ld(unsigned* p)              { return __hip_atomic_load(p, __ATOMIC_RELAXED, __HIP_MEMORY_SCOPE_AGENT); }
__device__ __forceinline__ unsigned xb_add(unsigned* p, unsigned v) { return __hip_atomic_fetch_add(p, v, __ATOMIC_RELAXED, __HIP_MEMORY_SCOPE_AGENT); }
__device__ __forceinline__ unsigned xb_xcc_id() { return (unsigned)__builtin_amdgcn_s_getreg((3 << 11) | 20) & 0xFu; }
#define XB_SPIN(cond, bar) do { unsigned _sp = 0; while (cond) { __builtin_amdgcn_s_sleep(1); \
    if ((++_sp & 255u) == 0u) { if (xb_ld(&(bar)[XB_TMO])) break; if (_sp > XB_SPIN_CAP) { atomicAdd(&(bar)[XB_TMO], 1u); break; } } } } while (0)
struct XcdBarrier { unsigned* bar; unsigned x; volatile LAS unsigned* st; };
__device__ __forceinline__ XcdBarrier xcd_barrier_post(unsigned* bar, volatile LAS unsigned* st) {
    XcdBarrier b; b.bar = bar; b.x = xb_xcc_id(); b.st = st;
    if (threadIdx.x == 0) (void)xb_add(&bar[XB_XCNT(b.x)], 1u);
    return b;
}
__device__ __forceinline__ void xcd_barrier_complete(unsigned* bar, unsigned x, unsigned& nloc, unsigned& nx) {
    const unsigned G = gridDim.x * gridDim.y * gridDim.z;
    unsigned sum, cnt, mine, sp = 0u;
    for (;;) {
        sum = 0u; cnt = 0u; mine = 0u;
#pragma unroll
        for (unsigned j = 0; j < 16; ++j) { const unsigned c = xb_ld(&bar[XB_XCNT(j)]); sum += c; cnt += (c > 0u) ? 1u : 0u; mine = (j == x) ? c : mine; }
        if (sum == G) break;
        __builtin_amdgcn_s_sleep(1);
        if ((++sp & 255u) == 0u) { if (xb_ld(&bar[XB_TMO])) break; if (sp > XB_SPIN_CAP) { atomicAdd(&bar[XB_TMO], 1u); break; } }
    }
    nloc = mine > 0u ? mine : 1u; nx = cnt > 0u ? cnt : 1u;
}
__device__ __forceinline__ void xcd_barrier(const XcdBarrier& b) {
    asm volatile("s_waitcnt vmcnt(0)" ::: "memory");
    __syncthreads();
    if (threadIdx.x == 0) {
        unsigned* bar = b.bar;
        __builtin_amdgcn_s_waitcnt(0);
        unsigned nloc = b.st[0], nx = b.st[1];
        if (nloc == 0u) { xcd_barrier_complete(bar, b.x, nloc, nx); b.st[0] = nloc; b.st[1] = nx; }
        const unsigned old = xb_add(&bar[XB_XSUB(b.x)], 1u);
        const unsigned gen = old / nloc;
        if (old + 1u == (gen + 1u) * nloc) {
            __builtin_amdgcn_fence(__ATOMIC_RELEASE, "agent");
            asm volatile("s_waitcnt vmcnt(0)" ::: "memory");
            const unsigned og = xb_add(&bar[XB_TOP], 1u);
            const unsigned tg = og / nx;
            if (og + 1u == (tg + 1u) * nx) xb_add(&bar[XB_TOPGEN], 1u);
            else XB_SPIN(xb_ld(&bar[XB_TOPGEN]) == tg, bar);
            __builtin_amdgcn_fence(__ATOMIC_ACQUIRE, "agent");
            xb_add(&bar[XB_XGEN(b.x)], 1u);
            asm volatile("s_waitcnt vmcnt(0)" ::: "memory");
        } else {
            XB_SPIN(xb_ld(&bar[XB_XGEN(b.x)]) == gen, bar);
            __builtin_amdgcn_fence(__ATOMIC_ACQUIRE, "agent");
            asm volatile("s_waitcnt vmcnt(0)" ::: "memory");
        }
    }
    __syncthreads();
}

namespace pg8 {
constexpr int BM = 256, BK = 64, HALF = 128, HTB = HALF * BK * 2, STAGE_BYTES = 8 * HTB, NXCD = 8, WGM = 8;
__host__ __device__ __forceinline__ int lds_byte(int r, int c) { return r * 128 + ((((c >> 3) ^ (r >> 1)) & 7) << 4) + (c & 7) * 2; }
__host__ __device__ __forceinline__ void stage_rc(int b, int& R, int& C) { R = b >> 7; C = ((((b >> 4) ^ (R >> 1)) & 7) << 3); }
__host__ __device__ __forceinline__ int perm32(int rho) { const int n = rho >> 4, i = rho & 15; return 8 * (i >> 2) + 4 * n + (i & 3); }

struct Unit { unsigned a, b; int row0, col0; };

struct DenseOrder {
    unsigned A, Bt; int K, nM, nN, nwg, G, c;
    __device__ void init(size_t A_, size_t Bt_, int M, int N, int K_, int G_, int c_) { A = (unsigned)A_; Bt = (unsigned)Bt_; K = K_; nM = M / BM; nN = N / BM; nwg = nM * nN; G = G_; c = c_; }
    __device__ bool next(int i, Unit& u) const {
        const long L = (long)i * G + c; if (L >= nwg) return false;
        int wgid = (int)L; { const int q = nwg / NXCD, r = nwg % NXCD, xcd = wgid % NXCD, off = wgid / NXCD; wgid = (xcd < r ? xcd * (q + 1) : r * (q + 1) + (xcd - r) * q) + off; }
        const int nig = WGM * nN, gid = wgid / nig, fm = gid * WGM, gsz = (nM - fm) < WGM ? (nM - fm) : WGM;
        const int pm = fm + ((wgid % nig) % gsz), pn = (wgid % nig) / gsz;
        u.a = A + (unsigned)(pm * BM * K * 2); u.b = Bt + (unsigned)(pn * BM * K * 2); u.row0 = pm * BM; u.col0 = pn * BM; return true;
    }
    __device__ __forceinline__ int arow(const Unit&, int) const { return 0; }
    __device__ __forceinline__ unsigned tokoff() const { return 0u; }
};
struct G1Order {
    unsigned h2, wgu; const int* tok; int G, c;
    __device__ bool next(int i, Unit& u) const {
        const long L = (long)i * G + c; if (L >= 4096) return false;
        const int e = (int)(L >> 8), w = (int)(L & 255), xcd = w & 7, l = w >> 3;
        const int pm = 4 * (xcd & 3) + (l & 3), pn = 8 * (xcd >> 2) + (l >> 2);
        u.a = h2; u.b = wgu + (unsigned)((e * 4096 + pn * 256) * DM); u.row0 = e * EROWS + pm * 256; u.col0 = pn * 128; return true;
    }
    __device__ __forceinline__ int arow(const Unit& u, int r) const { return tok[u.row0 + r]; }
    __device__ __forceinline__ unsigned tokoff() const { return (unsigned)WS_TOK; }
};
struct G2Order {
    unsigned H, wd; int G, c;
    __device__ bool next(int i, Unit& u) const {
        const long L = (long)i * G + c; if (L >= 1024) return false;
        const int r4 = (int)(L >> 8), w = (int)(L & 255), xcd = w & 7, l = w >> 3;
        const int e = 4 * r4 + (xcd >> 1), pm = 8 * (xcd & 1) + (l & 7), pn = l >> 3;
        u.a = H + (unsigned)((e * EROWS + pm * 256) * DFF); u.b = wd + (unsigned)((e * DM + pn * 256) * DFF); u.row0 = e * EROWS + pm * 256; u.col0 = pn * 256; return true;
    }
    __device__ __forceinline__ int arow(const Unit&, int) const { return 0; }
    __device__ __forceinline__ unsigned tokoff() const { return 0u; }
};

struct EpiP {
    static constexpr bool PERM = true, HAS_SCALE = true;
    bf16_t* P; unsigned soff;
    __device__ __forceinline__ unsigned scale_off() const { return soff; }
    __device__ __forceinline__ void operator()(const f32x4 (&acc)[2][2][4][2], const Unit& u, int wr, int wc, int fr, int fq, const LAS float* scl) const {
        const int row0 = u.row0 + wr * 64 + fr, col0 = u.col0 + wc * 32 + 8 * fq;
#pragma unroll
        for (int ai = 0; ai < 2; ++ai)
#pragma unroll
            for (int m = 0; m < 4; ++m) { const int r = row0 + ai * HALF + m * 16; const float rs = scl[wr * 64 + fr + ai * HALF + m * 16]; bf16_t* rowp = P + (size_t)r * NPROJ + col0;
#pragma unroll
                for (int bj = 0; bj < 2; ++bj) { const f32x4 v0 = acc[ai][bj][m][0] * rs, v1 = acc[ai][bj][m][1] * rs;
                    u32x4 w; w.x = cvt_pk_bf16(v0[0], v0[1]); w.y = cvt_pk_bf16(v0[2], v0[3]); w.z = cvt_pk_bf16(v1[0], v1[1]); w.w = cvt_pk_bf16(v1[2], v1[3]);
                    *(u32x4*)(rowp + bj * HALF) = w; } }
    }
};
struct EpiD {
    static constexpr bool PERM = true, HAS_SCALE = false;
    bf16_t* O; const bf16_t* XB;
    __device__ __forceinline__ unsigned scale_off() const { return 0u; }
    __device__ __forceinline__ void operator()(const f32x4 (&acc)[2][2][4][2], const Unit& u, int wr, int wc, int fr, int fq, const LAS float*) const {
        const int row0 = u.row0 + wr * 64 + fr, col0 = u.col0 + wc * 32 + 8 * fq;
#pragma unroll
        for (int ai = 0; ai < 2; ++ai) { u32x4 xv[4][2];
#pragma unroll
            for (int m = 0; m < 4; ++m)
#pragma unroll
                for (int bj = 0; bj < 2; ++bj) xv[m][bj] = *(const u32x4*)(XB + (size_t)(row0 + ai * HALF + m * 16) * DM + col0 + bj * HALF);
#pragma unroll
            for (int m = 0; m < 4; ++m) { bf16_t* rowp = O + (size_t)(row0 + ai * HALF + m * 16) * DM + col0;
#pragma unroll
                for (int bj = 0; bj < 2; ++bj) { const f32x4 v0 = acc[ai][bj][m][0], v1 = acc[ai][bj][m][1]; const u32x4 x = xv[m][bj];
                    u32x4 w; w.x = cvt_pk_bf16(v0[0] + bf2f(x.x & 0xffffu), v0[1] + bf2f(x.x >> 16)); w.y = cvt_pk_bf16(v0[2] + bf2f(x.y & 0xffffu), v0[3] + bf2f(x.y >> 16));
                    w.z = cvt_pk_bf16(v1[0] + bf2f(x.z & 0xffffu), v1[1] + bf2f(x.z >> 16)); w.w = cvt_pk_bf16(v1[2] + bf2f(x.w & 0xffffu), v1[3] + bf2f(x.w >> 16));
                    *(u32x4*)(rowp + bj * HALF) = w; } } }
    }
};
struct EpiH {
    static constexpr bool PERM = true, HAS_SCALE = true;
    unsigned char* Hh; unsigned soff;
    __device__ __forceinline__ unsigned scale_off() const { return soff; }
    __device__ __forceinline__ void operator()(const f32x4 (&acc)[2][2][4][2], const Unit& u, int wr, int wc, int fr, int fq, const LAS float* scl) const {
        const int row0 = u.row0 + wr * 64 + fr, col0 = u.col0 + wc * 32 + 8 * fq;
#pragma unroll
        for (int ai = 0; ai < 2; ++ai)
#pragma unroll
            for (int m = 0; m < 4; ++m) { const int r = row0 + ai * HALF + m * 16; unsigned char* rowp = Hh + (size_t)r * DFF + col0; const float rsc = scl[wr * 64 + fr + ai * HALF + m * 16] * 0.03125f;
                float h[8]; const float ke = -1.4426950408889634f * rsc, k2 = rsc * rsc;
#pragma unroll
                for (int n = 0; n < 2; ++n)
#pragma unroll
                    for (int jp = 0; jp < 2; ++jp) { const f32x2 ag = (f32x2){acc[ai][0][m][n][2 * jp], acc[ai][0][m][n][2 * jp + 1]}, au = (f32x2){acc[ai][1][m][n][2 * jp], acc[ai][1][m][n][2 * jp + 1]};
                        const f32x2 ex = ag * ke; f32x2 d; d.x = __builtin_amdgcn_exp2f(ex.x); d.y = __builtin_amdgcn_exp2f(ex.y); d = d + 1.0f;
                        f32x2 rc; rc.x = __builtin_amdgcn_rcpf(d.x); rc.y = __builtin_amdgcn_rcpf(d.y);
                        const f32x2 hv = (ag * au) * k2 * rc; h[n * 4 + 2 * jp] = hv.x; h[n * 4 + 2 * jp + 1] = hv.y; }
                u32x2 w; w.x = pk4_fp8(h[0], h[1], h[2], h[3]); w.y = pk4_fp8(h[4], h[5], h[6], h[7]);
                *(u32x2*)rowp = w; }
    }
};
struct EpiEo {
    static constexpr bool PERM = true, HAS_SCALE = true;
    unsigned char* O; unsigned soff;
    __device__ __forceinline__ unsigned scale_off() const { return soff; }
    __device__ __forceinline__ void operator()(const f32x4 (&acc)[2][2][4][2], const Unit& u, int wr, int wc, int fr, int fq, const LAS float* scl) const {
        const int row0 = u.row0 + wr * 64 + fr, col0 = u.col0 + wc * 32 + 8 * fq;
#pragma unroll
        for (int ai = 0; ai < 2; ++ai)
#pragma unroll
            for (int m = 0; m < 4; ++m) { const int r = row0 + ai * HALF + m * 16; const float gs = scl[wr * 64 + fr + ai * HALF + m * 16] * 0.5f; unsigned char* rowp = O + (size_t)r * DM + col0;
#pragma unroll
                for (int bj = 0; bj < 2; ++bj) { const f32x4 v0 = acc[ai][bj][m][0] * gs, v1 = acc[ai][bj][m][1] * gs;
                    u32x2 w; w.x = pk4_fp8(v0[0], v0[1], v0[2], v0[3]); w.y = pk4_fp8(v1[0], v1[1], v1[2], v1[3]);
                    *(u32x2*)(rowp + bj * HALF) = w; } }
    }
};

template <class Epi, class Sched, bool GATHER, bool FP8>
__device__ __forceinline__ void gemm_phase(LAS unsigned char* lds, const __amdgpu_buffer_rsrc_t rs, const int tid, const int KB, const Sched& S, const Epi& E) {
    const int wid = __builtin_amdgcn_readfirstlane(tid >> 6), lane = tid & 63, wr = wid >> 2, wc = wid & 3, fr = lane & 15, fq = lane >> 4;
    const int nt = KB / 128;
    int RA[2], CA[2];
    unsigned voffA[2][2], voffB[2];
#pragma unroll
    for (int i = 0; i < 2; ++i) { int R, C; stage_rc(tid * 16 + i * 8192, R, C); const int Rb = Epi::PERM ? ((R & ~31) + perm32(R & 31)) : R;
        RA[i] = R; CA[i] = C; voffB[i] = (unsigned)(Rb * KB + C * 2); }
    const unsigned kstep = 128u;
    const unsigned hstep = (unsigned)(HALF * KB);
    const unsigned ldsw = (unsigned)wid * 1024u;
    const int aoff = lds_byte(wr * 64 + fr, fq * 8), boff = lds_byte(wc * 32 + fr, fq * 8);
    const int aoff1 = lds_byte(wr * 64 + fr, 32 + fq * 8), boff1 = lds_byte(wc * 32 + fr, 32 + fq * 8);
#define PG8_SA(b, h) (((b) * 2 + (h)) * HTB)
#define PG8_SB(b, h) ((4 + (b) * 2 + (h)) * HTB)
#define PG8_STAGE(bufoff, gbase, voff) do { _Pragma("unroll") for (int _i = 0; _i < 2; ++_i) \
        __builtin_amdgcn_raw_ptr_buffer_load_lds(rs, (LAS void*)(lds + (bufoff) + ldsw + _i * 8192), 16, (int)(voff)[_i], (int)(gbase), 0, 0); } while (0)
#define PG8_STAGE_A(bufoff, gbase, h) do { if constexpr (GATHER) { PG8_STAGE(bufoff, gbase, voffA[h]); } else { PG8_STAGE(bufoff, (gbase) + (h) * hstep, voffA[0]); } } while (0)
#define PG8_LDA(dst, b, h) do { _Pragma("unroll") for (int m = 0; m < 4; ++m) { const i32x4 _lo = *(const LAS i32x4*)(lds + PG8_SA(b, h) + aoff + m * 2048), _hi = *(const LAS i32x4*)(lds + PG8_SA(b, h) + aoff1 + m * 2048); \
        dst[m] = __builtin_shufflevector(_lo, _hi, 0, 1, 2, 3, 4, 5, 6, 7); } } while (0)
#define PG8_LDB(dst, b, h) do { _Pragma("unroll") for (int n = 0; n < 2; ++n) { const i32x4 _lo = *(const LAS i32x4*)(lds + PG8_SB(b, h) + boff + n * 2048), _hi = *(const LAS i32x4*)(lds + PG8_SB(b, h) + boff1 + n * 2048); \
        dst[n] = __builtin_shufflevector(_lo, _hi, 0, 1, 2, 3, 4, 5, 6, 7); } } while (0)
#define PG8_MMA(ai, bj, At, Bt) do { __builtin_amdgcn_s_setprio(1); _Pragma("unroll") for (int m = 0; m < 4; ++m) _Pragma("unroll") for (int n = 0; n < 2; ++n) { \
        if constexpr (FP8) asm volatile("v_mfma_scale_f32_16x16x128_f8f6f4 %0, %1, %2, %0, %3, %3 op_sel_hi:[0,0,0]" : "+v"(acc[ai][bj][m][n]) : "v"(Bt[n]), "v"(At[m]), "v"(sc1)); \
        else { acc[ai][bj][m][n] = __builtin_amdgcn_mfma_f32_16x16x32_bf16((bf16x8)__builtin_shufflevector(Bt[n], Bt[n], 0, 1, 2, 3), (bf16x8)__builtin_shufflevector(At[m], At[m], 0, 1, 2, 3), acc[ai][bj][m][n], 0, 0, 0); \
               acc[ai][bj][m][n] = __builtin_amdgcn_mfma_f32_16x16x32_bf16((bf16x8)__builtin_shufflevector(Bt[n], Bt[n], 4, 5, 6, 7), (bf16x8)__builtin_shufflevector(At[m], At[m], 4, 5, 6, 7), acc[ai][bj][m][n], 0, 0, 0); } } \
        __builtin_amdgcn_s_setprio(0); } while (0)
#define PG8_WAIT_V(n) asm volatile("s_waitcnt vmcnt(" #n ")" ::: "memory")
#define PG8_WAIT_L(n) asm volatile("s_waitcnt lgkmcnt(" #n ")" ::: "memory")
#define PG8_BAR __builtin_amdgcn_s_barrier()
#define PG8_SCHED __builtin_amdgcn_sched_barrier(0)
#define PG8_SETVOFF(dst, unit) do { _Pragma("unroll") for (int _h = 0; _h < 2; ++_h) _Pragma("unroll") for (int _i = 0; _i < 2; ++_i) { \
        if constexpr (GATHER) dst[_h][_i] = (unsigned)(S.arow(unit, _h * HALF + RA[_i]) * KB + CA[_i] * 2); \
        else dst[_h][_i] = (unsigned)(RA[_i] * KB + CA[_i] * 2); } } while (0)
    Unit cur, nxt; int ui = 0;
    if (!S.next(0, cur)) return;
    int sc1 = 0x7f7f7f7f; asm volatile("" : "+v"(sc1));
    f32x4 acc[2][2][4][2];
#pragma unroll
    for (int a = 0; a < 2; ++a)
#pragma unroll
        for (int b = 0; b < 2; ++b)
#pragma unroll
            for (int m = 0; m < 4; ++m)
#pragma unroll
                for (int n = 0; n < 2; ++n) acc[a][b][m][n] = (f32x4){0.f, 0.f, 0.f, 0.f};
    i32x8 At[4], B0[2], B1[2];
    unsigned cA = cur.a, cB = cur.b;
    PG8_SETVOFF(voffA, cur);
    PG8_STAGE(PG8_SB(0, 0), cB, voffB); PG8_STAGE(PG8_SB(0, 1), cB + hstep, voffB); PG8_STAGE_A(PG8_SA(0, 0), cA, 0); PG8_STAGE_A(PG8_SA(0, 1), cA, 1);
    if (wr == 1) PG8_BAR;
    PG8_WAIT_V(2); PG8_BAR;
    PG8_STAGE(PG8_SB(1, 0), cB + kstep, voffB); PG8_STAGE_A(PG8_SA(1, 0), cA + kstep, 0); PG8_STAGE(PG8_SB(1, 1), cB + hstep + kstep, voffB);
    PG8_WAIT_V(6); PG8_BAR;
    for (;;) {
        const bool has_next = S.next(ui + 1, nxt);
        const unsigned nA = has_next ? nxt.a : cA, nB = has_next ? nxt.b : cB;
#pragma clang loop unroll(disable)
        for (int t = 0; t < nt; t += 2) {
            const bool last = (t == nt - 2);
            const unsigned a1 = cA + (unsigned)(t + 1) * kstep;
            const unsigned a2 = last ? nA : cA + (unsigned)(t + 2) * kstep, b2 = last ? nB : cB + (unsigned)(t + 2) * kstep;
            const unsigned a3 = a2 + kstep, b3 = b2 + kstep;
            unsigned nvoff[2][2];
            if constexpr (Epi::HAS_SCALE) { if (t == 0)
                    __builtin_amdgcn_raw_ptr_buffer_load_lds(rs, (LAS void*)(lds + 133120 + (ui & 1) * 2048 + (wid >> 2) * 1024 + (wid & 3) * 256), 4, (int)(lane * 4), (int)(E.scale_off() + (unsigned)(cur.row0 + (wid & 3) * 64) * 4u), 0, 0); }
            if constexpr (GATHER) {
                if (t == 0 && has_next)
                    __builtin_amdgcn_raw_ptr_buffer_load_lds(rs, (LAS void*)(lds + 131072 + (wid >> 2) * 1024 + (wid & 3) * 256), 4, (int)(lane * 4), (int)(S.tokoff() + (unsigned)(nxt.row0 + (wid & 3) * 64) * 4u), 0, 0);
                if (last && has_next) {
#pragma unroll
                    for (int _h = 0; _h < 2; ++_h)
#pragma unroll
                        for (int _i = 0; _i < 2; ++_i) nvoff[_h][_i] = (unsigned)(*(const LAS int*)(lds + 131072 + (_h * HALF + RA[_i]) * 4) * KB + CA[_i] * 2); } }
            PG8_LDB(B0, 0, 0); PG8_LDB(B1, 0, 1); PG8_SCHED; PG8_LDA(At, 0, 0); PG8_STAGE_A(PG8_SA(1, 1), a1, 1);
            PG8_WAIT_V(8); PG8_WAIT_L(0); PG8_BAR; PG8_MMA(0, 0, At, B0); PG8_MMA(0, 1, At, B1); PG8_BAR; PG8_SCHED;
            if constexpr (GATHER) { if (last && has_next) {
#pragma unroll
                for (int _h = 0; _h < 2; ++_h)
#pragma unroll
                    for (int _i = 0; _i < 2; ++_i) voffA[_h][_i] = nvoff[_h][_i]; } }
            PG8_LDA(At, 0, 1); PG8_STAGE(PG8_SB(0, 0), b2, voffB); PG8_STAGE(PG8_SB(0, 1), b2 + hstep, voffB);
            PG8_WAIT_V(6); PG8_WAIT_L(0); PG8_BAR; PG8_MMA(1, 0, At, B0); PG8_SCHED; PG8_STAGE_A(PG8_SA(0, 0), a2, 0); PG8_SCHED; PG8_MMA(1, 1, At, B1); PG8_BAR; PG8_SCHED;
            PG8_LDB(B0, 1, 0); PG8_LDB(B1, 1, 1); PG8_SCHED; PG8_LDA(At, 1, 0); PG8_STAGE_A(PG8_SA(0, 1), a2, 1);
            PG8_WAIT_V(8); PG8_WAIT_L(0); PG8_BAR; PG8_MMA(0, 0, At, B0); PG8_MMA(0, 1, At, B1); PG8_BAR; PG8_SCHED;
            PG8_LDA(At, 1, 1); PG8_STAGE(PG8_SB(1, 0), b3, voffB); PG8_STAGE(PG8_SB(1, 1), b3 + hstep, voffB);
            PG8_WAIT_V(6); PG8_WAIT_L(0); PG8_BAR; PG8_MMA(1, 0, At, B0); PG8_SCHED; PG8_STAGE_A(PG8_SA(1, 0), a3, 0); PG8_SCHED; PG8_MMA(1, 1, At, B1); PG8_BAR; PG8_SCHED;
        }
        if (wr == 0) PG8_BAR;
        if constexpr (FP8) asm volatile("s_nop 15\n\ts_nop 15" ::: "memory");
        E(acc, cur, wr, wc, fr, fq, (const LAS float*)(lds + 133120 + (ui & 1) * 2048));
        if (!has_next) break;
#pragma unroll
        for (int a = 0; a < 2; ++a)
#pragma unroll
            for (int b = 0; b < 2; ++b)
#pragma unroll
                for (int m = 0; m < 4; ++m)
#pragma unroll
                    for (int n = 0; n < 2; ++n) acc[a][b][m][n] = (f32x4){0.f, 0.f, 0.f, 0.f};
        cur = nxt; cA = nA; cB = nB; ++ui;
        if (wr == 1) PG8_BAR;
    }
    PG8_WAIT_V(0);
    PG8_BAR;
#undef PG8_SA
#undef PG8_SB
#undef PG8_STAGE
#undef PG8_STAGE_A
#undef PG8_LDA
#undef PG8_LDB
#undef PG8_MMA
#undef PG8_WAIT_V
#undef PG8_WAIT_L
#undef PG8_BAR
#undef PG8_SCHED
#undef PG8_SETVOFF
}
}

struct Args { const float* in[22]; float* out; unsigned char* ws; int ph_lo, ph_hi, rep_phase, rep_n; };
typedef const __attribute__((address_space(4))) Args KArgs;
struct Frame {
    LAS unsigned char* lds;
    int tid, lane, wave, G, bx, vcu;
};

__device__ __forceinline__ void transpose_item(const float* W, int N, int k0, int n0, bf16_t* WT, int ldk, int drow0, const float* kscale, LAS float* scr, int lane) {
#pragma unroll 8
    for (int i = 0; i < 32; ++i) { const int kk = 2 * i + (lane >> 5); float v = W[(size_t)(k0 + kk) * N + n0 + (lane & 31)]; if (kscale) v *= kscale[k0 + kk]; scr[kk * 33 + (lane & 31)] = v; }
    LDS_WAIT(); asm volatile("" ::: "memory");
    const int c = lane & 7;
#pragma unroll
    for (int j = 0; j < 4; ++j) { const int n = (lane >> 3) + 8 * j; const LAS float* s = scr + (8 * c) * 33 + n;
        u32x4 o; o.x = pk2(s[0 * 33], s[1 * 33]); o.y = pk2(s[2 * 33], s[3 * 33]); o.z = pk2(s[4 * 33], s[5 * 33]); o.w = pk2(s[6 * 33], s[7 * 33]);
        *(u32x4*)(WT + (size_t)(drow0 + n) * ldk + k0 + 8 * c) = o; }
    LDS_WAIT(); asm volatile("" ::: "memory");
}
struct WItem { const float* src; unsigned char* dst; int N, ldk; };
__device__ __forceinline__ WItem w_item(KArgs& a, int which, int r, int lane) {
    unsigned char* ws = a.ws; WItem it; const int e = r >> 9, q = r & 511; const int kq = lane >> 4, n4 = (lane & 15) * 4;
    if (which < 2) { const int kb = q >> 5, nb = q & 31, n0 = nb * 64; it.N = DFF; it.ldk = DM;
        it.src = a.in[18 + which] + (size_t)e * DM * DFF + (size_t)(kb * 64 + kq) * DFF + n0 + n4;
        it.dst = (unsigned char*)(ws + WS_WGU) + (size_t)e * 4096 * DM + (size_t)((n0 >> 7) * 256 + which * 128 + (n0 & 127)) * DM + kb * 64; }
    else { const int kb = q >> 4, nb = q & 15; it.N = DM; it.ldk = DFF;
        it.src = a.in[20] + (size_t)e * DFF * DM + (size_t)(kb * 64 + kq) * DM + nb * 64 + n4;
        it.dst = (unsigned char*)(ws + WS_WD) + (size_t)e * DM * DFF + (size_t)(nb * 64) * DFF + kb * 64; }
    return it;
}
__device__ __forceinline__ void w_load(const WItem& it, f32x4 (&v)[16]) {
#pragma unroll
    for (int i = 0; i < 16; ++i) v[i] = *(const f32x4*)(it.src + (size_t)(4 * i) * it.N);
}
__device__ __forceinline__ void w_finish(const WItem& it, const f32x4 (&v)[16], LAS float* scr, int lane) {
    const int kq = lane >> 4, n4 = (lane & 15) * 4;
#pragma unroll
    for (int i = 0; i < 16; ++i) { const int kk = kq + 4 * i; *(LAS f32x4*)(scr + kk * 68 + ((n4 + 8 * (kk >> 4)) & 63)) = v[i] * 32.0f; }
    LDS_WAIT(); asm volatile("" ::: "memory");
    const int nl = lane >> 2, j = lane & 3;
#pragma unroll
    for (int p = 0; p < 4; ++p) { const int n = 16 * p + nl; const LAS float* sp = scr + (16 * j) * 68 + ((n + 8 * j) & 63);
        u32x4 o; o.x = pk4_fp8(sp[0 * 68], sp[1 * 68], sp[2 * 68], sp[3 * 68]); o.y = pk4_fp8(sp[4 * 68], sp[5 * 68], sp[6 * 68], sp[7 * 68]);
        o.z = pk4_fp8(sp[8 * 68], sp[9 * 68], sp[10 * 68], sp[11 * 68]); o.w = pk4_fp8(sp[12 * 68], sp[13 * 68], sp[14 * 68], sp[15 * 68]);
        *(u32x4*)(it.dst + (size_t)n * it.ldk + 16 * j) = o; }
    LDS_WAIT(); asm volatile("" ::: "memory");
}
constexpr int WD_SPLIT = 6144;
__device__ __forceinline__ void expert_w_items(const Frame& F, KArgs& a, int which, int gwi, int ngw, int r_lo = 0, int r_hi = 8192) {
    LAS float* scr = (LAS float*)(F.lds + F.wave * 17408);
    for (int r = r_lo + gwi; r < r_hi; r += ngw) { const WItem it = w_item(a, which, r, F.lane); f32x4 v[16]; w_load(it, v); w_finish(it, v, scr, F.lane); }
}
__device__ __forceinline__ void p0_prep(const Frame& F, KArgs& a) {
    unsigned char* ws = a.ws;
    LAS float* scr = (LAS float*)(F.lds + F.wave * 17408);
    const int gw = F.vcu * NWAVES + F.wave, NGW = F.G * NWAVES;
    for (int r0 = (a.rep_phase == 101) ? a.rep_n : 0; r0 >= 0; --r0) { constexpr int I_WIN = 16 * 48, I_WOUT = 8 * 32;
      bf16_t* WinT = (bf16_t*)(ws + WS_WIN); bf16_t* W2T = (bf16_t*)(ws + WS_W2);
      for (int it = gw; it < I_WIN + I_WOUT; it += NGW) {
          int r = it;
          if (r < I_WIN) { const int kb = r / 48, nb = r % 48; transpose_item(a.in[2], NPROJ, kb * 64, nb * 32, WinT, DM, nb * 32, a.in[1], scr, F.lane); continue; } r -= I_WIN;
          { const int kb = r / 32, nb = r % 32; transpose_item(a.in[15], DM, kb * 64, nb * 32, W2T, KOUT, nb * 32, nullptr, scr, F.lane); }
      } }
    for (int r0 = (a.rep_phase == 102) ? a.rep_n : 0; r0 >= 0; --r0) { expert_w_items(F, a, 0, gw, NGW); expert_w_items(F, a, 1, gw, NGW); expert_w_items(F, a, 2, gw, NGW, 0, WD_SPLIT); }
    { LAS float* ctab = (LAS float*)(F.lds);
      __syncthreads();
      if (F.tid < 128) ctab[F.tid] = cospif((float)F.tid * (1.0f / 64.0f));
      __syncthreads();
      const float* wout = a.in[15]; bf16_t* W2T = (bf16_t*)(ws + WS_W2);
      for (int it = gw; it < 2048; it += NGW) {
          const int kb = it >> 4, nb = it & 15; const int krow0 = 512 + kb * 8; const int sn = (krow0 >= 1024) ? 1 : 0; const int cg0 = (krow0 - 512 - sn * 512); const int g = cg0 >> 7, c0 = cg0 & 127;
          const int n = nb * 64 + F.lane; float accv[8];
#pragma unroll
          for (int i = 0; i < 8; ++i) accv[i] = 0.f;
          const float* wp = wout + (size_t)(512 + g * 128) * DM + n;
#pragma unroll 1
          for (int jb = 0; jb < 128; jb += 32) { float wv[32];
#pragma unroll
              for (int jj = 0; jj < 32; ++jj) wv[jj] = wp[(size_t)(jb + jj) * DM];
#pragma unroll
              for (int jj = 0; jj < 32; ++jj) { const int j = jb + jj;
#pragma unroll
                  for (int i = 0; i < 8; ++i) { const int ph = (j * (c0 + i) - sn * 32) & 127; accv[i] += ctab[ph] * wv[jj]; } } }
          const float sc = sn ? (-1.0f / 1024.0f) : (1.0f / 1024.0f);
          u32x4 o; o.x = pk2(accv[0] * sc, accv[1] * sc); o.y = pk2(accv[2] * sc, accv[3] * sc); o.z = pk2(accv[4] * sc, accv[5] * sc); o.w = pk2(accv[6] * sc, accv[7] * sc);
          *(u32x4*)(W2T + (size_t)n * KOUT + krow0) = o;
      } }
    { bf16_t* WgT = (bf16_t*)(ws + WS_WGT);
      for (int o = (F.vcu * NTHREADS + F.tid); o < NHEAD * 256 * 64; o += F.G * NTHREADS) {
          const int k = o & 63, n = (o >> 6) & 255, h = o >> 14, mat = n >> 6, j = n & 63;
          const float* W = a.in[mat == 0 ? 5 : mat == 1 ? 7 : mat == 2 ? 10 : 12];
          WgT[o] = (bf16_t)f2bf(W[(h * 64 + k) * 64 + j]);
      } }
    for (int r0 = (a.rep_phase == 100) ? a.rep_n : 0; r0 >= 0; --r0) { const float* x = a.in[0]; bf16_t* xb = (bf16_t*)(ws + WS_XB); float* rstd = (float*)(ws + WS_RSTD1);
      for (int m = gw; m < MTOK; m += 2 * NGW) {
          const int m2 = m + NGW;
          const f32x4* xr = (const f32x4*)(x + (size_t)m * DM) + F.lane; const f32x4* xr2 = (const f32x4*)(x + (size_t)(m2 < MTOK ? m2 : m) * DM) + F.lane; f32x4 v[4], v2[4]; float s = 0.f, s2 = 0.f;
#pragma unroll
          for (int j = 0; j < 4; ++j) { v[j] = xr[64 * j]; v2[j] = xr2[64 * j]; }
#pragma unroll
          for (int j = 0; j < 4; ++j) { s += (v[j].x * v[j].x + v[j].y * v[j].y) + (v[j].z * v[j].z + v[j].w * v[j].w); s2 += (v2[j].x * v2[j].x + v2[j].y * v2[j].y) + (v2[j].z * v2[j].z + v2[j].w * v2[j].w); }
          s = wave_sum(s); s2 = wave_sum(s2);
          if (F.lane == 0) { rstd[m] = 1.0f / sqrtf(s * (1.0f / DM) + EPS); if (m2 < MTOK) rstd[m2] = 1.0f / sqrtf(s2 * (1.0f / DM) + EPS); }
          unsigned long long* o8 = (unsigned long long*)(xb + (size_t)m * DM) + F.lane;
#pragma unroll
          for (int j = 0; j < 4; ++j) o8[64 * j] = (unsigned long long)pk2(v[j].x, v[j].y) | ((unsigned long long)pk2(v[j].z, v[j].w) << 32);
          if (m2 < MTOK) { unsigned long long* o82 = (unsigned long long*)(xb + (size_t)m2 * DM) + F.lane;
#pragma unroll
              for (int j = 0; j < 4; ++j) o82[64 * j] = (unsigned long long)pk2(v2[j].x, v2[j].y) | ((unsigned long long)pk2(v2[j].z, v2[j].w) << 32); }
      } }
}

__device__ constexpr float TWR[32] = {1.000000000e+00f, 9.951847267e-01f, 9.807852804e-01f, 9.569403357e-01f, 9.238795325e-01f, 8.819212643e-01f, 8.314696123e-01f, 7.730104534e-01f, 7.071067812e-01f, 6.343932842e-01f, 5.555702330e-01f, 4.713967368e-01f, 3.826834324e-01f, 2.902846773e-01f, 1.950903220e-01f, 9.801714033e-02f, 0.0f, -9.801714033e-02f, -1.950903220e-01f, -2.902846773e-01f, -3.826834324e-01f, -4.713967368e-01f, -5.555702330e-01f, -6.343932842e-01f, -7.071067812e-01f, -7.730104534e-01f, -8.314696123e-01f, -8.819212643e-01f, -9.238795325e-01f, -9.569403357e-01f, -9.807852804e-01f, -9.951847267e-01f};
__device__ constexpr float TWI[32] = {-0.0f, -9.801714033e-02f, -1.950903220e-01f, -2.902846773e-01f, -3.826834324e-01f, -4.713967368e-01f, -5.555702330e-01f, -6.343932842e-01f, -7.071067812e-01f, -7.730104534e-01f, -8.314696123e-01f, -8.819212643e-01f, -9.238795325e-01f, -9.569403357e-01f, -9.807852804e-01f, -9.951847267e-01f, -1.000000000e+00f, -9.951847267e-01f, -9.807852804e-01f, -9.569403357e-01f, -9.238795325e-01f, -8.819212643e-01f, -8.314696123e-01f, -7.730104534e-01f, -7.071067812e-01f, -6.343932842e-01f, -5.555702330e-01f, -4.713967368e-01f, -3.826834324e-01f, -2.902846773e-01f, -1.950903220e-01f, -9.801714033e-02f};
constexpr int bitrev_c(int i, int n) { int r = 0; for (int b = 0; b < n; ++b) r |= ((i >> b) & 1) << (n - 1 - b); return r; }
template <int N, int ST, int L> struct FftStage {
    static __device__ __forceinline__ void run(float (&re)[N], float (&im)[N]) {
        constexpr int m = 1 << ST, h = m >> 1;
#pragma unroll
        for (int kk = 0; kk < N; kk += m) {
#pragma unroll
            for (int j = 0; j < h; ++j) {
                const float wr = TWR[j * (64 / m)], wi = TWI[j * (64 / m)];
                const float xr = re[kk + j + h], xi = im[kk + j + h];
                const float tr = wr * xr - wi * xi, ti = wr * xi + wi * xr;
                re[kk + j + h] = re[kk + j] - tr; im[kk + j + h] = im[kk + j] - ti;
                re[kk + j] += tr; im[kk + j] += ti;
            }
        }
        if constexpr (ST < L) FftStage<N, ST + 1, L>::run(re, im);
    }
};
template <int N, int L> __device__ __forceinline__ void fft_inreg(float (&re)[N], float (&im)[N]) {
#pragma unroll
    for (int i = 0; i < N; ++i) { const int j = bitrev_c(i, L); if (i < j) { float t = re[i]; re[i] = re[j]; re[j] = t; t = im[i]; im[i] = im[j]; im[j] = t; } }
    FftStage<N, 1, L>::run(re, im);
}

__device__ __forceinline__ void fft1_item(const Frame& F, const bf16_t* P, u32x2* V, int item) {
    const int b = item >> 7, sg = (item >> 3) & 15, cc = item & 7;
    const int s2a = 16 * sg + 2 * F.wave, c = cc * 64 + F.lane;
    float re[32], im[32];
    const bf16_t* src = P + ((size_t)b * SEQ + s2a) * NPROJ + 1024 + c;
#pragma unroll
    for (int i = 0; i < 32; ++i) { re[i] = bf2f(src[(size_t)i * 256 * NPROJ]); im[i] = bf2f(src[(size_t)i * 256 * NPROJ + NPROJ]); }
    fft_inreg<32, 5>(re, im);
    float sa, ca, sb, cb; sincospif((float)s2a * (1.0f / 4096.0f), &sa, &ca); sincospif((float)(s2a + 1) * (1.0f / 4096.0f), &sb, &cb);
    float war = 1.f, wai = 0.f, wbr = 1.f, wbi = 0.f;
    u32x2* dst = V + (((size_t)b * 17) * 128 + (s2a >> 1)) * 512 + c;
#pragma unroll
    for (int k = 0; k <= 16; ++k) {
        const int km = (32 - k) & 31;
        const float ar = 0.5f * (re[k] + re[km]), ai = 0.5f * (im[k] - im[km]), br = 0.5f * (im[k] + im[km]), bi = -0.5f * (re[k] - re[km]);
        f32x2 va, vb; va.x = ar * war - ai * wai; va.y = ar * wai + ai * war; vb.x = br * wbr - bi * wbi; vb.y = br * wbi + bi * wbr;
        dst[(size_t)k * 128 * 512] = (u32x2){pk2(va.x, va.y), pk2(vb.x, vb.y)};
        const float t0 = war * ca + wai * sa; wai = wai * ca - war * sa; war = t0;
        const float t1 = wbr * cb + wbi * sb; wbi = wbi * cb - wbr * sb; wbr = t1;
    }
}
__device__ __forceinline__ void fft2_item(const Frame& F, const u32x2* V, bf16_t* A2, int b, int k1, int cc) {
    const int w = F.wave, c = cc * 64 + F.lane;
    LAS f32x2* T = (LAS f32x2*)F.lds;
    { u32x2 pv[16];
      const u32x2* src = V + (((size_t)b * 17 + k1) * 128 + w) * 512 + c;
#pragma unroll
      for (int j1 = 0; j1 < 16; ++j1) pv[j1] = src[(size_t)j1 * 8 * 512];
#pragma unroll
      for (int jj = 0; jj < 2; ++jj) { const int j2 = 2 * w + jj; float re[16], im[16];
#pragma unroll
          for (int j1 = 0; j1 < 16; ++j1) { const unsigned q = jj ? pv[j1].y : pv[j1].x; re[j1] = bf2f(q & 0xffffu); im[j1] = bf2f(q >> 16); }
          fft_inreg<16, 4>(re, im);
#pragma unroll
          for (int q1 = 0; q1 < 16; ++q1) { float sn, cs; sincospif((float)(q1 * j2) * (1.0f / 128.0f), &sn, &cs);
              f32x2 o; o.x = re[q1] * cs + im[q1] * sn; o.y = im[q1] * cs - re[q1] * sn; T[(q1 * 16 + j2) * 64 + F.lane] = o; } } }
    __syncthreads();
#pragma unroll 1
    for (int qq = 0; qq < 2; ++qq) { const int q1 = 2 * w + qq; float re[16], im[16];
#pragma unroll
        for (int j2 = 0; j2 < 16; ++j2) { const f32x2 v = T[(q1 * 16 + j2) * 64 + F.lane]; re[j2] = v.x; im[j2] = v.y; }
        fft_inreg<16, 4>(re, im);
#pragma unroll
        for (int q2 = 0; q2 < 16; ++q2) { const int k = k1 + 32 * (q1 + 16 * q2);
            bf16_t* d = A2 + ((size_t)b * SEQ + k) * KOUT + 512 + c; d[0] = (bf16_t)f2bf(re[q2]); d[512] = (bf16_t)f2bf(-im[q2]);
            if (k1 != 0 && k1 != 16) { bf16_t* dm = A2 + ((size_t)b * SEQ + (SEQ - k)) * KOUT + 512 + c; dm[0] = (bf16_t)f2bf(re[q2]); dm[512] = (bf16_t)f2bf(im[q2]); } } }
    __syncthreads();
}

constexpr int LRU_WG = 0, LRU_CS = 32768, LRU_CF = 49152, LRU_XT = 81920, LRU_GT = 98816  , LRU_AGW = 115200, LRU_WCAR = 123392, LRU_CARRY = 127488, LRU_CONST = 131584;
static_assert(LRU_XT + 131 * 128 <= LRU_GT && LRU_GT + 16384 <= LRU_AGW && LRU_AGW + 8192 <= LRU_WCAR && LRU_WCAR + 4096 <= LRU_CARRY && LRU_CARRY + 4096 <= LRU_CONST && LRU_CONST + 11 * 256 <= MISC_OFF, "LRU LDS map");
template <int PASS>
__device__ __forceinline__ void lru_super_item(const Frame& F, KArgs& a, int si) {
    const int b = si >> 6, h = (si >> 3) & 7, j0 = (si & 7) * 8;
    const int tid = F.tid, lane = F.lane, w = F.wave, fr = lane & 15, fq = lane >> 4;
    unsigned char* ws = a.ws;
    const bf16_t* P = (const bf16_t*)a.out;
    LAS unsigned char* lds = F.lds;
    f32x2* agg = (f32x2*)(ws + WS_AGG);
    { const bf16_t* WgT = (const bf16_t*)(ws + WS_WGT) + (size_t)h * 256 * 64;
#pragma unroll
      for (int i = 0; i < 4; ++i) { const int q = tid + 512 * i, n = q >> 3, ch = q & 7; const u32x4 v = *(const u32x4*)(WgT + n * 64 + ch * 8); *(LAS u32x4*)(lds + LRU_WG + n * 128 + ((ch ^ (n & 7)) << 4)) = v; } }
    { LAS float* KC = (LAS float*)(lds + LRU_CONST);
      if (tid < 64) { const int ch = h * 64 + tid;
          KC[0 * 64 + tid] = -8.0f * log1pf(expf(-a.in[9][ch])) * 1.4426950408889634f; KC[1 * 64 + tid] = -8.0f * log1pf(expf(-a.in[14][ch])) * 1.4426950408889634f;
          KC[2 * 64 + tid] = a.in[6][ch]; KC[3 * 64 + tid] = a.in[8][ch]; KC[4 * 64 + tid] = a.in[11][ch]; KC[5 * 64 + tid] = a.in[13][ch]; KC[6 * 64 + tid] = a.in[4][ch];
#pragma unroll
          for (int k = 0; k < 4; ++k) KC[(7 + k) * 64 + tid] = a.in[3][k * DLRU + ch]; } }
    const LAS float* KC = (const LAS float*)(lds + LRU_CONST);
    const int ch4 = tid & 15, tq = tid >> 4;
    if (PASS == 2) {
        if (tid < 128) { const int dir = tid >> 6, ch = tid & 63; LAS float* CAR = (LAS float*)(lds + LRU_CARRY);
            float carry = 0.f;
            if (dir == 0) { for (int jj = 0; jj < j0 + 8; ++jj) { if (jj >= j0) CAR[((jj - j0) * 2 + 0) * 64 + ch] = carry; const f32x2 ah = agg[(((size_t)b * 64 + jj) * 2 + 0) * 512 + h * 64 + ch]; carry = ah.x * carry + ah.y; } }
            else { for (int jj = 63; jj >= j0; --jj) { if (jj < j0 + 8) CAR[((jj - j0) * 2 + 1) * 64 + ch] = carry; const f32x2 ah = agg[(((size_t)b * 64 + jj) * 2 + 1) * 512 + h * 64 + ch]; carry = ah.x * carry + ah.y; } }
        }
    }
    __syncthreads();
    u32x4 px[3], pg[2];
#define LRU_LOAD_CHUNK(jj) do { const int _t0 = (jj) * 128; \
        _Pragma("unroll") for (int _i = 0; _i < 3; ++_i) { const int _q = tid + 512 * _i, _r = _q >> 3, _c = _q & 7, _t = _t0 - 2 + _r; px[_i] = (u32x4){0u, 0u, 0u, 0u}; \
            if (_q < 131 * 8 && _t >= 0 && _t < SEQ) px[_i] = *(const u32x4*)(P + ((size_t)b * SEQ + _t) * NPROJ + h * 64 + _c * 8); } \
        if (PASS == 2) { _Pragma("unroll") for (int _i = 0; _i < 2; ++_i) { const int _q = tid + 512 * _i, _r = _q >> 3, _c = _q & 7; pg[_i] = *(const u32x4*)(P + ((size_t)b * SEQ + _t0 + _r) * NPROJ + 512 + h * 64 + _c * 8); } } } while (0)
    LRU_LOAD_CHUNK(j0);
    for (int jl = 0; jl < 8; ++jl) {
        const int j = j0 + jl, t0 = j * 128;
#pragma unroll
        for (int i = 0; i < 3; ++i) { const int q = tid + 512 * i, r = q >> 3, chk = q & 7; if (q < 131 * 8) *(LAS u32x4*)(lds + LRU_XT + r * 128 + chk * 16) = px[i]; }
        if (PASS == 2) {
#pragma unroll
            for (int i = 0; i < 2; ++i) { const int q = tid + 512 * i, r = q >> 3, chk = q & 7; *(LAS u32x4*)(lds + LRU_GT + r * 128 + chk * 16) = pg[i]; } }
        __syncthreads();
        if (jl < 7) LRU_LOAD_CHUNK(j + 1);
        { float xv[7][4]; const f32x4 cbias = *(const LAS f32x4*)(KC + 6 * 64 + ch4 * 4); f32x4 cwv[4];
#pragma unroll
          for (int k = 0; k < 4; ++k) cwv[k] = *(const LAS f32x4*)(KC + (7 + k) * 64 + ch4 * 4);
#pragma unroll
          for (int r = 0; r < 7; ++r) { const u32x2 v = *(const LAS u32x2*)(lds + LRU_XT + (4 * tq + r) * 128 + ch4 * 8); xv[r][0] = bf2f(v.x & 0xffffu); xv[r][1] = bf2f(v.x >> 16); xv[r][2] = bf2f(v.y & 0xffffu); xv[r][3] = bf2f(v.y >> 16); }
#pragma unroll
          for (int tt = 0; tt < 4; ++tt) { const int t = 4 * tq + tt; f32x4 cv;
#pragma unroll
              for (int i = 0; i < 4; ++i) { float s = cbias[i];
#pragma unroll
                  for (int k = 0; k < 4; ++k) s += cwv[k][i] * xv[tt + k][i];
                  cv[i] = s; }
              *(LAS f32x4*)(lds + LRU_CF + t * 256 + ch4 * 16) = cv;
              u32x2 pk; pk.x = pk2(cv[0], cv[1]); pk.y = pk2(cv[2], cv[3]);
              *(LAS u32x2*)(lds + LRU_CS + t * 128 + (((ch4 >> 1) ^ (t & 7)) << 4) + (ch4 & 1) * 8) = pk; } }
        __syncthreads();
        bf16x8 af[2];
        { const int row = 16 * w + fr;
#pragma unroll
          for (int kk = 0; kk < 2; ++kk) af[kk] = *(const LAS bf16x8*)(lds + LRU_CS + row * 128 + (((kk * 4 + fq) ^ (row & 7)) << 4)); }
#pragma unroll 1
        for (int hf = 0; hf < 2; ++hf) {
            float Pf[2][4], Hf[2][4], Pb[2][4], Hb[2][4];
#pragma unroll
            for (int cb = 0; cb < 2; ++cb) { const int cb4 = 2 * hf + cb;
                f32x4 acc[4];
#pragma unroll
                for (int mat = 0; mat < 4; ++mat) { acc[mat] = (f32x4){0.f, 0.f, 0.f, 0.f}; const int n = (mat * 4 + cb4) * 16 + fr;
#pragma unroll
                    for (int kk = 0; kk < 2; ++kk) { const bf16x8 bfr = *(const LAS bf16x8*)(lds + LRU_WG + n * 128 + (((kk * 4 + fq) ^ (n & 7)) << 4)); acc[mat] = __builtin_amdgcn_mfma_f32_16x16x32_bf16(af[kk], bfr, acc[mat], 0, 0, 0); } }
                float af_[4], bf_[4], ab_[4], bb_[4]; const int chl = cb4 * 16 + fr;
                const float k_c8f = KC[chl], k_c8b = KC[64 + chl], k_baf = KC[128 + chl], k_bxf = KC[192 + chl], k_bab = KC[256 + chl], k_bxb = KC[320 + chl];
#pragma unroll
                for (int r = 0; r < 4; ++r) { const int t = 16 * w + 4 * fq + r; const float cval = *(const LAS float*)(lds + LRU_CF + t * 256 + chl * 4);
                    const float rf = fast_sigmoid(acc[0][r] + k_baf), xf = fast_sigmoid(acc[1][r] + k_bxf);
                    const float rb = fast_sigmoid(acc[2][r] + k_bab), xb = fast_sigmoid(acc[3][r] + k_bxb);
                    const float a1 = __builtin_amdgcn_exp2f(k_c8f * rf), a2 = __builtin_amdgcn_exp2f(k_c8b * rb);
                    af_[r] = a1; bf_[r] = __builtin_amdgcn_sqrtf(fmaxf(fmaf(-a1, a1, 1.0f), 0.f)) * xf * cval;
                    ab_[r] = a2; bb_[r] = __builtin_amdgcn_sqrtf(fmaxf(fmaf(-a2, a2, 1.0f), 0.f)) * xb * cval; }
                Pf[cb][0] = af_[0]; Hf[cb][0] = bf_[0];
#pragma unroll
                for (int r = 1; r < 4; ++r) { Pf[cb][r] = af_[r] * Pf[cb][r - 1]; Hf[cb][r] = af_[r] * Hf[cb][r - 1] + bf_[r]; }
                Pb[cb][3] = ab_[3]; Hb[cb][3] = bb_[3];
#pragma unroll
                for (int r = 2; r >= 0; --r) { Pb[cb][r] = ab_[r] * Pb[cb][r + 1]; Hb[cb][r] = ab_[r] * Hb[cb][r + 1] + bb_[r]; }
            }
            float gPf[2], gHf[2], gPb[2], gHb[2];
            { LAS f32x2* AGW = (LAS f32x2*)(lds + LRU_AGW);
#pragma unroll
              for (int cb = 0; cb < 2; ++cb) { const int chl = (2 * hf + cb) * 16 + fr;
                  const bool odd = (fq & 1) != 0, hi = (fq & 2) != 0;
                  { const float A = Pf[cb][3], H = Hf[cb][3];
                    const float A1 = xchg16(A, lane), H1 = xchg16(H, lane);
                    const float pA = odd ? A1 : 1.f, pH = odd ? H1 : 0.f, qA = A * A1, qH = odd ? (A * H1 + H) : (A1 * H + H1);
                    const float QA = xchg32(qA, lane), QH = xchg32(qH, lane);
                    gPf[cb] = hi ? pA * QA : pA; gHf[cb] = hi ? (pA * QH + pH) : pH;
                    if (fq == 0) AGW[(w * 2 + 0) * 64 + chl] = (f32x2){qA * QA, QA * qH + QH}; }
                  { const float A = Pb[cb][0], H = Hb[cb][0];
                    const float A1 = xchg16(A, lane), H1 = xchg16(H, lane);
                    const float pA = odd ? 1.f : A1, pH = odd ? 0.f : H1, qA = A * A1, qH = odd ? (A1 * H + H1) : (A * H1 + H);
                    const float QA = xchg32(qA, lane), QH = xchg32(qH, lane);
                    gPb[cb] = hi ? pA : pA * QA; gHb[cb] = hi ? pH : (pA * QH + pH);
                    if (fq == 0) AGW[(w * 2 + 1) * 64 + chl] = (f32x2){qA * QA, qA * QH + qH}; }
              } }
            __syncthreads();
            if (tid < 64) { const int dir = tid >> 5, ch = hf * 32 + (tid & 31); const LAS f32x2* AGW = (const LAS f32x2*)(lds + LRU_AGW); LAS float* WCAR = (LAS float*)(lds + LRU_WCAR);
                float carry = (PASS == 2) ? ((const LAS float*)(lds + LRU_CARRY))[(jl * 2 + dir) * 64 + ch] : 0.f; float ptot = 1.f;
                if (dir == 0) { for (int ww = 0; ww < 8; ++ww) { WCAR[(ww * 2 + 0) * 64 + ch] = carry; const f32x2 ah = AGW[(ww * 2 + 0) * 64 + ch]; carry = ah.x * carry + ah.y; ptot *= ah.x; } }
                else { for (int ww = 7; ww >= 0; --ww) { WCAR[(ww * 2 + 1) * 64 + ch] = carry; const f32x2 ah = AGW[(ww * 2 + 1) * 64 + ch]; carry = ah.x * carry + ah.y; ptot *= ah.x; } }
                if (PASS == 1) agg[(((size_t)b * 64 + j) * 2 + dir) * 512 + h * 64 + ch] = (f32x2){ptot, carry};
            }
            if (PASS == 2) {
                __syncthreads();
                const LAS float* WCAR = (const LAS float*)(lds + LRU_WCAR);
#pragma unroll
                for (int cb = 0; cb < 2; ++cb) { const int ch = (2 * hf + cb) * 16 + fr;
                    const float cf = gHf[cb] + gPf[cb] * WCAR[(w * 2 + 0) * 64 + ch], cbk = gHb[cb] + gPb[cb] * WCAR[(w * 2 + 1) * 64 + ch];
#pragma unroll
                    for (int r = 0; r < 4; ++r) { const int t = 16 * w + 4 * fq + r; const float hs = (Hf[cb][r] + Pf[cb][r] * cf) + (Hb[cb][r] + Pb[cb][r] * cbk);
                        LAS bf16_t* gp = (LAS bf16_t*)(lds + LRU_GT + t * 128 + ch * 2); const float g = bf2f((unsigned)*gp);
                        const float u = 0.7978845608028654f * (g + 0.044715f * g * g * g); const float th = 1.0f - 2.0f * __builtin_amdgcn_rcpf(1.0f + __builtin_amdgcn_exp2f(2.885390081777927f * u));
                        *gp = (bf16_t)f2bf(0.5f * g * (1.0f + th) * hs); } }
            }
        }
        if (PASS == 2) {
            __syncthreads();
            bf16_t* A2 = (bf16_t*)(ws + WS_A2);
#pragma unroll
            for (int i = 0; i < 2; ++i) { const int q = tid + 512 * i, r = q >> 3, chk = q & 7; const u32x4 v = *(const LAS u32x4*)(lds + LRU_GT + r * 128 + chk * 16);
                *(u32x4*)(A2 + ((size_t)b * SEQ + t0 + r) * KOUT + h * 64 + chk * 8) = v; }
        }
        __syncthreads();
    }
#undef LRU_LOAD_CHUNK
}

constexpr int P5_PITCH = 2048 + 16;
__device__ __forceinline__ void p5_router(const Frame& F, KArgs& a) {
    unsigned char* ws = a.ws;
    LAS unsigned char* WH = F.lds; LAS unsigned char* WL = F.lds + 16 * P5_PITCH;
    { const float* wr = a.in[17];
      for (int o = F.tid; o < DM * NEXP; o += NTHREADS) { const int k = o >> 4, e = o & 15; const float w = wr[o]; const unsigned hi = f2bf(w); const float lo = w - bf2f(hi);
          *(LAS bf16_t*)(WH + e * P5_PITCH + k * 2) = (bf16_t)hi; *(LAS bf16_t*)(WL + e * P5_PITCH + k * 2) = (bf16_t)f2bf(lo); } }
    __syncthreads();
    const bf16_t* xm = (const bf16_t*)(ws + WS_DELTA); const float* g2 = a.in[16];
    unsigned char* h2 = (unsigned char*)(ws + WS_H2); float* scores = (float*)(ws + WS_SCORES); float* rstd2 = (float*)(ws + WS_RSTD1);
    const int gw = F.vcu * NWAVES + F.wave, NGW = F.G * NWAVES, fr = F.lane & 15, fq = F.lane >> 4;
    for (int grp = gw; grp < MTOK / 16; grp += NGW) {
        const int m0 = grp * 16;
        const bf16_t* xrow = xm + (size_t)(m0 + fr) * DM + 16 * fq; unsigned char* hrow = h2 + (size_t)(m0 + fr) * DM + 16 * fq;
        f32x4 acc = (f32x4){0.f, 0.f, 0.f, 0.f}; float ssq = 0.f;
#pragma unroll 2
        for (int kp = 0; kp < 16; ++kp) {
            const u32x4 x0 = *(const u32x4*)(xrow + 64 * kp), x1 = *(const u32x4*)(xrow + 64 * kp + 8); unsigned qq[4];
#pragma unroll
            for (int hh = 0; hh < 2; ++hh) { const u32x4 xv = hh ? x1 : x0; const int k0 = 64 * kp + 16 * fq + 8 * hh;
                f32x4 xa, xb; xa.x = bf2f(xv.x & 0xffffu); xa.y = bf2f(xv.x >> 16); xa.z = bf2f(xv.y & 0xffffu); xa.w = bf2f(xv.y >> 16); xb.x = bf2f(xv.z & 0xffffu); xb.y = bf2f(xv.z >> 16); xb.z = bf2f(xv.w & 0xffffu); xb.w = bf2f(xv.w >> 16);
                const f32x4 ga = *(const f32x4*)(g2 + k0), gb = *(const f32x4*)(g2 + k0 + 4);
                ssq += (xa.x * xa.x + xa.y * xa.y) + (xa.z * xa.z + xa.w * xa.w) + (xb.x * xb.x + xb.y * xb.y) + (xb.z * xb.z + xb.w * xb.w);
                const f32x4 va = xa * ga, vb = xb * gb;
                u32x4 hi, lo;
                hi.x = pk2(va.x, va.y); hi.y = pk2(va.z, va.w); hi.z = pk2(vb.x, vb.y); hi.w = pk2(vb.z, vb.w);
                lo.x = pk2(va.x - bf2f(hi.x & 0xffffu), va.y - bf2f(hi.x >> 16)); lo.y = pk2(va.z - bf2f(hi.y & 0xffffu), va.w - bf2f(hi.y >> 16));
                lo.z = pk2(vb.x - bf2f(hi.z & 0xffffu), vb.y - bf2f(hi.z >> 16)); lo.w = pk2(vb.z - bf2f(hi.w & 0xffffu), vb.w - bf2f(hi.w >> 16));
                const bf16x8 bh = *(const LAS bf16x8*)(WH + fr * P5_PITCH + k0 * 2), bl = *(const LAS bf16x8*)(WL + fr * P5_PITCH + k0 * 2);
                acc = __builtin_amdgcn_mfma_f32_16x16x32_bf16((bf16x8)hi, bh, acc, 0, 0, 0);
                acc = __builtin_amdgcn_mfma_f32_16x16x32_bf16((bf16x8)lo, bh, acc, 0, 0, 0);
                acc = __builtin_amdgcn_mfma_f32_16x16x32_bf16((bf16x8)hi, bl, acc, 0, 0, 0);
                qq[2 * hh] = pk4_fp8(va.x, va.y, va.z, va.w); qq[2 * hh + 1] = pk4_fp8(vb.x, vb.y, vb.z, vb.w); }
            *(u32x4*)(hrow + 64 * kp) = (u32x4){qq[0], qq[1], qq[2], qq[3]};
        }
        ssq += __shfl_xor(ssq, 16); ssq += __shfl_xor(ssq, 32);
        const float rs = 1.0f / sqrtf(ssq * (1.0f / DM) + EPS);
        if (fq == 0) rstd2[m0 + fr] = rs;
        f32x4 sc;
#pragma unroll
        for (int r = 0; r < 4; ++r) { const float l = acc[r] * __shfl(rs, 4 * fq + r);
            float mx = l;
#pragma unroll
            for (int o = 1; o < 16; o <<= 1) mx = fmaxf(mx, __shfl_xor(mx, o));
            const float ex = expf(l - mx); float sm = ex;
#pragma unroll
            for (int o = 1; o < 16; o <<= 1) sm += __shfl_xor(sm, o);
            sc[r] = ex / sm; }
        const int bb = m0 >> 13, s0 = m0 & (SEQ - 1);
        *(f32x4*)(scores + ((size_t)bb * NEXP + fr) * SEQ + s0 + 4 * fq) = sc;
    }
}

__device__ __forceinline__ void p6_topk_item(const Frame& F, KArgs& a, int item) {
    unsigned char* ws = a.ws; const int b = item >> 4, e = item & 15, tid = F.tid;
    const float* sc = (const float*)(ws + WS_SCORES) + (size_t)item * SEQ;
    int* tok = (int*)(ws + WS_TOK) + e * EROWS + b * CAP; float* gate = (float*)(ws + WS_GATE) + e * EROWS + b * CAP; int* inv = (int*)(ws + WS_INV) + (size_t)item * SEQ;
    float* rsl = (float*)(ws + WS_RS) + e * EROWS + b * CAP; const float* rstd2 = (const float*)(ws + WS_RSTD1) + b * SEQ;
    LAS unsigned* hist = (LAS unsigned*)F.lds;
    LAS unsigned* sfx = hist + 256;
    LAS unsigned* bc = hist + 512;
    LAS unsigned* scan = hist + 768;
    unsigned key[16];
    { const u32x4* p = (const u32x4*)(sc + tid * 16);
#pragma unroll
      for (int i = 0; i < 4; ++i) { const u32x4 v = p[i]; key[4 * i] = v.x; key[4 * i + 1] = v.y; key[4 * i + 2] = v.z; key[4 * i + 3] = v.w; } }
    unsigned prefix = 0, need = CAP;
    const int lane = F.lane, wv = F.wave;
    if (tid < 256) hist[tid] = 0u;
    __syncthreads();
#pragma unroll 1
    for (int pass = 0; pass < 4; ++pass) {
        const int shift = 24 - 8 * pass; const unsigned himask = pass == 0 ? 0u : (0xffffffffu << (shift + 8));
#pragma unroll
        for (int i = 0; i < 16; ++i) if ((key[i] & himask) == prefix) __hip_atomic_fetch_add(&hist[(key[i] >> shift) & 255u], 1u, __ATOMIC_RELAXED, __HIP_MEMORY_SCOPE_WORKGROUP);
        __syncthreads();
        unsigned hv = 0u, sv = 0u;
        if (tid < 256) { hv = hist[tid]; hist[tid] = 0u; sv = hv;
#pragma unroll
            for (int d = 1; d < 64; d <<= 1) { const unsigned o = __shfl_down(sv, d); if (lane + d < 64) sv += o; }
            if (lane == 0) sfx[wv] = sv; }
        __syncthreads();
        if (tid < 256) { unsigned ge = sv;
#pragma unroll
            for (int k = 1; k < 4; ++k) if (wv + k < 4) ge += sfx[wv + k];
            const unsigned gt = ge - hv;
            if (ge >= need && gt < need) { bc[0] = prefix | ((unsigned)tid << shift); bc[1] = need - gt; } }
        __syncthreads();
        prefix = bc[0]; need = bc[1];
    }
    const unsigned T = prefix;
    unsigned ngt = 0, neq = 0;
#pragma unroll
    for (int i = 0; i < 16; ++i) { ngt += key[i] > T ? 1u : 0u; neq += key[i] == T ? 1u : 0u; }
    unsigned incl = ngt | (neq << 16);
#pragma unroll
    for (int d = 1; d < 64; d <<= 1) { const unsigned o = __shfl_up(incl, d); if (lane >= d) incl += o; }
    if (lane == 63) scan[wv] = incl;
    __syncthreads();
    unsigned tot = 0u;
#pragma unroll
    for (int k = 0; k < 8; ++k) { const unsigned wt = scan[k]; if (k < wv) incl += wt; tot += wt; }
    const unsigned totgt = tot & 0xffffu;
    unsigned pgt = (incl & 0xffffu) - ngt, peq = (incl >> 16) - neq;
#pragma unroll
    for (int i = 0; i < 16; ++i) { const int s = tid * 16 + i; int slot = -1;
        if (key[i] > T) { slot = (int)pgt; ++pgt; }
        else if (key[i] == T) { if (peq < need) slot = (int)(totgt + peq); ++peq; }
        inv[s] = slot;
        if (slot >= 0) { tok[slot] = b * SEQ + s; gate[slot] = __builtin_bit_cast(float, key[i]); rsl[slot] = rstd2[s]; } }
    __syncthreads();
}

__device__ __forceinline__ void p9_final(const Frame& F, KArgs& a, float* dst) {
    unsigned char* ws = a.ws; const bf16_t* dl = (const bf16_t*)(ws + WS_DELTA); const float* gf = a.in[21]; const unsigned char* eo = (const unsigned char*)(ws + WS_EO); const int* inv = (const int*)(ws + WS_INV);
    const int gw = F.vcu * NWAVES + F.wave, NGW = F.G * NWAVES;
    f32x4 gv[4];
#pragma unroll
    for (int j = 0; j < 4; ++j) gv[j] = ((const f32x4*)gf)[F.lane + 64 * j];
    unsigned long long dn[4]; int slotn = -1;
    { const int m0 = gw < MTOK ? gw : 0; const unsigned long long* dr = (const unsigned long long*)(dl + (size_t)m0 * DM) + F.lane;
#pragma unroll
      for (int j = 0; j < 4; ++j) dn[j] = dr[64 * j];
      if (F.lane < 16) slotn = inv[((size_t)(m0 >> 13) * NEXP + F.lane) * SEQ + (m0 & (SEQ - 1))]; }
    for (int m = gw; m < MTOK; m += NGW) {
        f32x4 v[4]; const int myslot = slotn;
#pragma unroll
        for (int j = 0; j < 4; ++j) { const unsigned lo = (unsigned)dn[j], hi = (unsigned)(dn[j] >> 32); v[j].x = bf2f(lo & 0xffffu); v[j].y = bf2f(lo >> 16); v[j].z = bf2f(hi & 0xffffu); v[j].w = bf2f(hi >> 16); }
        const int bb = m >> 13;
        { const int mn = (m + NGW < MTOK) ? m + NGW : m; const unsigned long long* dr = (const unsigned long long*)(dl + (size_t)mn * DM) + F.lane;
#pragma unroll
          for (int j = 0; j < 4; ++j) dn[j] = dr[64 * j];
          slotn = -1; if (F.lane < 16) slotn = inv[((size_t)(mn >> 13) * NEXP + F.lane) * SEQ + (mn & (SEQ - 1))]; }
#if !DBG_NO_MOE
        unsigned mask = (unsigned)__ballot(myslot >= 0) & 0xffffu;
        while (mask) {
            unsigned q[4][4]; int ne = 0;
#pragma unroll
            for (int t = 0; t < 4; ++t) { if (mask) { const int e = __builtin_ctz(mask); mask &= mask - 1u; const int slot = __builtin_amdgcn_readlane(myslot, e);
                    const unsigned* er = (const unsigned*)(eo + ((size_t)e * EROWS + bb * CAP + slot) * DM) + F.lane;
#pragma unroll
                    for (int j = 0; j < 4; ++j) q[t][j] = er[64 * j];
                    ne = t + 1; } }
#pragma unroll
            for (int t = 0; t < 4; ++t) { if (t < ne) {
#pragma unroll
                    for (int j = 0; j < 4; ++j) { const f32x2 lo = __builtin_amdgcn_cvt_pk_f32_fp8((int)q[t][j], false), hi = __builtin_amdgcn_cvt_pk_f32_fp8((int)q[t][j], true);
                        v[j].x += lo.x * 0.0625f; v[j].y += lo.y * 0.0625f; v[j].z += hi.x * 0.0625f; v[j].w += hi.y * 0.0625f; } } }
        }
#endif
        float s = 0.f;
#pragma unroll
        for (int j = 0; j < 4; ++j) s += (v[j].x * v[j].x + v[j].y * v[j].y) + (v[j].z * v[j].z + v[j].w * v[j].w);
        const float rstd = 1.0f / sqrtf(wave_sum(s) * (1.0f / DM) + EPS);
        f32x4* xw = (f32x4*)(dst + (size_t)m * DM) + F.lane;
#pragma unroll
        for (int j = 0; j < 4; ++j) xw[64 * j] = v[j] * rstd * gv[j];
    }
}

__global__ void __launch_bounds__(NTHREADS, 2) fwd(Args args) {
    extern __shared__ __attribute__((aligned(16))) unsigned char lds_raw[];
    Frame F;
    F.lds = (LAS unsigned char*)lds_raw;
    F.tid = threadIdx.x; F.lane = F.tid & 63; F.wave = __builtin_amdgcn_readfirstlane(F.tid >> 6);
    F.G = gridDim.x; F.bx = blockIdx.x; F.vcu = (F.G % 8 == 0) ? (F.bx % 8) * (F.G / 8) + F.bx / 8 : F.bx;
    volatile LAS unsigned* MISC = (volatile LAS unsigned*)(F.lds + MISC_OFF);
    if (F.tid < 16) MISC[F.tid] = 0u;
    __syncthreads();
    KArgs* kap = (KArgs*)__builtin_amdgcn_kernarg_segment_ptr();
    unsigned char* ws = args.ws;
    unsigned* ctl = (unsigned*)(ws + WS_CTL);
    const int lo = args.ph_lo, hi = args.ph_hi;
    const __amdgpu_buffer_rsrc_t rsrc = __builtin_amdgcn_make_buffer_rsrc((void*)ws, (short)0, (int)0x7fffffff, (int)0x00020000);
#if !N_LAUNCH_PER_PHASE
    XcdBarrier bar = xcd_barrier_post(ctl + 1024, MISC + 8);
#if USE_COOP == 1
    cg::this_grid().sync();
#endif
#define GRID_BAR() xcd_barrier(bar)
#else
#define GRID_BAR() do {} while (0)
#endif
#ifdef ONLY_PHASE
#define IN(k) ((k) == ONLY_PHASE && lo <= (k) && (k) < hi)
#else
#define IN(k) (lo <= (k) && (k) < hi)
#endif
#define REFRESH() int t_ = threadIdx.x; asm volatile("" : "+v"(t_)); F.tid = t_; F.lane = t_ & 63; F.wave = __builtin_amdgcn_readfirstlane(t_ >> 6); KArgs* ap_ = kap; asm volatile("" : "+s"(ap_)); KArgs& A = *ap_
#define REPS(k) for (int rep = (args.rep_phase == (k)) ? args.rep_n : 0; rep >= 0; --rep)
    if (IN(0)) REPS(0) { REFRESH(); p0_prep(F, A); GRID_BAR(); }
    if (IN(1)) REPS(1) { REFRESH();
        pg8::DenseOrder S; S.init(WS_XB, WS_WIN, MTOK, NPROJ, DM, F.G, F.bx);
        pg8::EpiP E{(bf16_t*)A.out, (unsigned)WS_RSTD1};
        pg8::gemm_phase<pg8::EpiP, pg8::DenseOrder, false, false>(F.lds, rsrc, F.tid, DM * 2, S, E);
        GRID_BAR();
    }
    if (IN(2)) REPS(2) { REFRESH();
        for (int r2 = (A.rep_phase == 20) ? A.rep_n : 0; r2 >= 0; --r2)
        for (int si = F.bx; si < 256; si += F.G) lru_super_item<1>(F, A, si);
        for (int r2 = (A.rep_phase == 21) ? A.rep_n : 0; r2 >= 0; --r2)
        for (int it = F.bx; it < 512; it += F.G) fft1_item(F, (const bf16_t*)A.out, (u32x2*)(ws + WS_V), it);
        GRID_BAR();
    }
    if (IN(3)) REPS(3) { REFRESH();
        for (int r2 = (A.rep_phase == 30) ? A.rep_n : 0; r2 >= 0; --r2)
        for (int si = F.bx; si < 256; si += F.G) lru_super_item<2>(F, A, si);
        for (int r2 = (A.rep_phase == 31) ? A.rep_n : 0; r2 >= 0; --r2)
        for (int it = F.bx; it < NB * 16 * 8; it += F.G) { const int cc = it & 7, kk = (it >> 3) & 15, b = it >> 7;
            if (kk == 0) { fft2_item(F, (const u32x2*)(ws + WS_V), (bf16_t*)(ws + WS_A2), b, 0, cc); fft2_item(F, (const u32x2*)(ws + WS_V), (bf16_t*)(ws + WS_A2), b, 16, cc); }
            else fft2_item(F, (const u32x2*)(ws + WS_V), (bf16_t*)(ws + WS_A2), b, kk, cc); }
        GRID_BAR();
    }
    if (IN(4)) REPS(4) { REFRESH();
        pg8::DenseOrder S; S.init(WS_A2, WS_W2, MTOK, DM, KOUT, F.G, F.bx);
        pg8::EpiD E{(bf16_t*)(ws + WS_DELTA), (const bf16_t*)(ws + WS_XB)};
        pg8::gemm_phase<pg8::EpiD, pg8::DenseOrder, false, false>(F.lds, rsrc, F.tid, KOUT * 2, S, E);
        GRID_BAR();
    }
    if (IN(5)) REPS(5) { REFRESH(); p5_router(F, A); GRID_BAR(); }
    if (IN(6)) REPS(6) { REFRESH();
        if (F.G > NB * NEXP) { if (F.bx < NB * NEXP) p6_topk_item(F, A, F.bx); else expert_w_items(F, A, 2, (F.bx - NB * NEXP) * NWAVES + F.wave, (F.G - NB * NEXP) * NWAVES, WD_SPLIT, 8192); }
        else { for (int it = F.bx; it < NB * NEXP; it += F.G) p6_topk_item(F, A, it); expert_w_items(F, A, 2, F.bx * NWAVES + F.wave, F.G * NWAVES, WD_SPLIT, 8192); }
        GRID_BAR(); }
#if !DBG_NO_MOE
    if (IN(7)) REPS(7) { REFRESH();
        pg8::G1Order S{(unsigned)WS_H2, (unsigned)WS_WGU, (const int*)(ws + WS_TOK), F.G, F.bx};
        pg8::EpiH E{(unsigned char*)(ws + WS_H), (unsigned)WS_RS};
        pg8::gemm_phase<pg8::EpiH, pg8::G1Order, true, true>(F.lds, rsrc, F.tid, DM, S, E);
        GRID_BAR();
    }
    if (IN(8)) REPS(8) { REFRESH();
        pg8::G2Order S{(unsigned)WS_H, (unsigned)WS_WD, F.G, F.bx};
        pg8::EpiEo E{(unsigned char*)(ws + WS_EO), (unsigned)WS_GATE};
        pg8::gemm_phase<pg8::EpiEo, pg8::G2Order, false, true>(F.lds, rsrc, F.tid, DFF, S, E);
        GRID_BAR();
    }
#endif
    if (IN(9)) REPS(9) { REFRESH(); p9_final(F, A, rep > 0 ? (float*)(ws + WS_H) : A.out); if (rep > 0) GRID_BAR(); }
#undef IN
}

extern "C" void kernel_launch(void* const* d_in, const int* in_sizes, int n_in, void* d_out, int out_size, void* d_ws, size_t ws_size, hipStream_t stream) {
    static int grid = 0;
    if (grid == 0) {
        if (n_in != 22 || out_size != MTOK * DM || ws_size < WS_END) { fprintf(stderr, "kernel_launch: unexpected problem (n_in %d out %d ws %zu)\n", n_in, out_size, ws_size); grid = -1; return; }
        int dev = 0, cus = 0, per_cu = 0;
        (void)hipGetDevice(&dev);
        (void)hipDeviceGetAttribute(&cus, hipDeviceAttributeMultiprocessorCount, dev);
        (void)hipFuncSetAttribute((const void*)fwd, hipFuncAttributeMaxDynamicSharedMemorySize, LDS_BYTES);
        (void)hipOccupancyMaxActiveBlocksPerMultiprocessor(&per_cu, (const void*)fwd, NTHREADS, LDS_BYTES);
        (void)hipGetLastError();
        if (per_cu < 1) { fprintf(stderr, "kernel_launch: occupancy query says %d workgroups per CU; nothing launched\n", per_cu); grid = -1; return; }
        grid = cus * 1;
    }
    if (grid < 0) return;
    (void)hipMemsetAsync((char*)d_ws + WS_CTL, 0, 65536, stream);
    Args a{};
    for (int i = 0; i < 22; ++i) a.in[i] = (const float*)d_in[i];
    a.out = (float*)d_out; a.ws = (unsigned char*)d_ws; a.rep_phase = REPEAT_PHASE; a.rep_n = REPEAT_N;
#if N_LAUNCH_PER_PHASE
    for (int p = 0; p < 10; ++p) { a.ph_lo = p; a.ph_hi = p + 1; hipLaunchKernelGGL(fwd, dim3(grid), dim3(NTHREADS), LDS_BYTES, stream, a); }
#else
    a.ph_lo = 0; a.ph_hi = 10;
    void* kargs[] = {&a};
#if USE_COOP
    hipError_t e = hipLaunchCooperativeKernel((const void*)fwd, dim3(grid), dim3(NTHREADS), kargs, LDS_BYTES, stream);
    if (e != hipSuccess) fprintf(stderr, "cooperative launch failed: %s (grid %d)\n", hipGetErrorString(e), grid);
#else
    (void)kargs; hipLaunchKernelGGL(fwd, dim3(grid), dim3(NTHREADS), LDS_BYTES, stream, a);
#endif
#endif
}
```

```cpp
#include <hip/hip_runtime.h>
#include <hip/hip_cooperative_groups.h>
#include <cstdio>
#include <cstdint>
namespace cg = cooperative_groups;

#ifndef USE_COOP
#define USE_COOP 2
#endif
#ifndef N_LAUNCH_PER_PHASE
#define N_LAUNCH_PER_PHASE 0
#endif
#ifndef DBG_NO_MOE
#define DBG_NO_MOE 0
#endif

#ifndef REPEAT_PHASE
#define REPEAT_PHASE -1
#endif
#ifndef REPEAT_N
#define REPEAT_N 0
#endif
#define LAS __attribute__((address_space(3)))
typedef unsigned short bf16_t;
typedef short bf16x8 __attribute__((ext_vector_type(8)));
typedef float f32x4 __attribute__((ext_vector_type(4)));
typedef float f32x2 __attribute__((ext_vector_type(2)));
typedef unsigned u32x4 __attribute__((ext_vector_type(4)));
typedef unsigned u32x2 __attribute__((ext_vector_type(2)));
typedef int i32x4 __attribute__((ext_vector_type(4)));
typedef int i32x8 __attribute__((ext_vector_type(8)));

constexpr int NB = 4, SEQ = 8192, DM = 1024, MTOK = NB * SEQ;
constexpr int DLRU = 512, NHEAD = 8, HDIM = 64, NPROJ = 1536, KOUT = 1536;
constexpr int NEXP = 16, CAP = 1024, DFF = 2048, EROWS = NB * CAP;
constexpr float EPS = 1e-6f;
constexpr int NTHREADS = 512, NWAVES = 8;
constexpr int LDS_BYTES = 147456;
constexpr int MISC_OFF = 131072 + 8192;

constexpr size_t KiB = 1024, MiB = 1u << 20;
constexpr size_t WS_CTL = 0;
constexpr size_t WS_RSTD1 = 64 * KiB;
constexpr size_t WS_WGT = 256 * KiB;
constexpr size_t WS_IDX = 512 * KiB;
constexpr size_t WS_GATE = 768 * KiB;
constexpr size_t WS_AGG = 1 * MiB;
constexpr size_t WS_SCORES = 3 * MiB;
constexpr size_t WS_INV = 5 * MiB;
constexpr size_t WS_RS = 7 * MiB;
constexpr size_t WS_TOK = 7 * MiB + 256 * KiB;
constexpr size_t WS_WGU = 8 * MiB;
constexpr size_t WS_EO = 8 * MiB;
constexpr size_t WS_WD = 136 * MiB;
constexpr size_t WS_H = 200 * MiB;
constexpr size_t WS_XB = 436 * MiB;
constexpr size_t WS_V = 200 * MiB;
constexpr size_t WS_A2 = 270 * MiB;
constexpr size_t WS_WIN = 366 * MiB;
constexpr size_t WS_W2 = 369 * MiB;
constexpr size_t WS_DELTA = 372 * MiB;
constexpr size_t WS_H2 = 168 * MiB;
constexpr size_t WS_END = 520 * MiB;

__device__ __forceinline__ unsigned f2bf(float f) { unsigned u = __builtin_bit_cast(unsigned, f); return (u + 0x7fffu + ((u >> 16) & 1u)) >> 16; }
__device__ __forceinline__ unsigned pk2(float lo, float hi) { return f2bf(lo) | (f2bf(hi) << 16); }
__device__ __forceinline__ unsigned cvt_pk_bf16(float lo, float hi) { unsigned r; asm volatile("v_cvt_pk_bf16_f32 %0, %1, %2" : "=v"(r) : "v"(lo), "v"(hi)); return r; }
__device__ __forceinline__ float bf2f(unsigned h) { return __builtin_bit_cast(float, h << 16); }
__device__ __forceinline__ float wave_sum(float v) {
#pragma unroll
    for (int o = 1; o < 64; o <<= 1) v += __shfl_xor(v, o);
    return v;
}
__device__ __forceinline__ float fast_sigmoid(float x) { return __builtin_amdgcn_rcpf(1.0f + __builtin_amdgcn_exp2f(-1.4426950408889634f * x)); }
__device__ __forceinline__ unsigned pk4_fp8(float a, float b, float c, float d) { int w = 0; w = __builtin_amdgcn_cvt_pk_fp8_f32(a, b, w, false); w = __builtin_amdgcn_cvt_pk_fp8_f32(c, d, w, true); return (unsigned)w; }
__device__ __forceinline__ float xchg16(float v, int lane) { const unsigned u = __builtin_bit_cast(unsigned, v); const auto r = __builtin_amdgcn_permlane16_swap(u, u, false, false); return __builtin_bit_cast(float, (lane & 16) ? r[0] : r[1]); }
__device__ __forceinline__ float xchg32(float v, int lane) { const unsigned u = __builtin_bit_cast(unsigned, v); const auto r = __builtin_amdgcn_permlane32_swap(u, u, false, false); return __builtin_bit_cast(float, (lane & 32) ? r[0] : r[1]); }
#define LDS_WAIT() asm volatile("s_waitcnt lgkmcnt(0)" ::: "memory")

#define XB_TMO      128
#define XB_XCNT(j)  (256  + 64 * (j))
#define XB_XSUB(j)  (1280 + 64 * (j))
#define XB_XGEN(j)  (2304 + 64 * (j))
#define XB_TOP      3328
#define XB_TOPGEN   3392
#define XCD_BAR_WORDS 3456
#define XB_SPIN_CAP (1u << 20)
__device__ __forceinline__ unsigned xb_ld(unsigned* p)              { return __hip_atomic_load(p, __ATOMIC_RELAXED, __HIP_MEMORY_SCOPE_AGENT); }
__device__ __forceinline__ unsigned xb_add(unsigned* p, unsigned v) { return __hip_atomic_fetch_add(p, v, __ATOMIC_RELAXED, __HIP_MEMORY_SCOPE_AGENT); }
__device__ __forceinline__ unsigned xb_xcc_id() { return (unsigned)__builtin_amdgcn_s_getreg((3 << 11) | 20) & 0xFu; }
#define XB_SPIN(cond, bar) do { unsigned _sp = 0; while (cond) { __builtin_amdgcn_s_sleep(1); \
    if ((++_sp & 255u) == 0u) { if (xb_ld(&(bar)[XB_TMO])) break; if (_sp > XB_SPIN_CAP) { atomicAdd(&(bar)[XB_TMO], 1u); break; } } } } while (0)
struct XcdBarrier { unsigned* bar; unsigned x; volatile LAS unsigned* st; };
__device__ __forceinline__ XcdBarrier xcd_barrier_post(unsigned* bar, volatile LAS unsigned* st) {
    XcdBarrier b; b.bar = bar; b.x = xb_xcc_id(); b.st = st;
    if (threadIdx.x == 0) (void)xb_add(&bar[XB_XCNT(b.x)], 1u);
    return b;
}
__device__ __forceinline__ void xcd_barrier_complete(unsigned* bar, unsigned x, unsigned& nloc, unsigned& nx) {
    const unsigned G = gridDim.x * gridDim.y * gridDim.z;
    unsigned sum, cnt, mine, sp = 0u;
    for (;;) {
        sum = 0u; cnt = 0u; mine = 0u;
#pragma unroll
        for (unsigned j = 0; j < 16; ++j) { const unsigned c = xb_ld(&bar[XB_XCNT(j)]); sum += c; cnt += (c > 0u) ? 1u : 0u; mine = (j == x) ? c : mine; }
        if (sum == G) break;
        __builtin_amdgcn_s_sleep(1);
        if ((++sp & 255u) == 0u) { if (xb_ld(&bar[XB_TMO])) break; if (sp > XB_SPIN_CAP) { atomicAdd(&bar[XB_TMO], 1u); break; } }
    }
    nloc = mine > 0u ? mine : 1u; nx = cnt > 0u ? cnt : 1u;
}
__device__ __forceinline__ void xcd_barrier(const XcdBarrier& b) {
    asm volatile("s_waitcnt vmcnt(0)" ::: "memory");
    __syncthreads();
    if (threadIdx.x == 0) {
        unsigned* bar = b.bar;
        __builtin_amdgcn_s_waitcnt(0);
        unsigned nloc = b.st[0], nx = b.st[1];
        if (nloc == 0u) { xcd_barrier_complete(bar, b.x, nloc, nx); b.st[0] = nloc; b.st[1] = nx; }
        const unsigned old = xb_add(&bar[XB_XSUB(b.x)], 1u);
        const unsigned gen = old / nloc;
        if (old + 1u == (gen + 1u) * nloc) {
            __builtin_amdgcn_fence(__ATOMIC_RELEASE, "agent");
            asm volatile("s_waitcnt vmcnt(0)" ::: "memory");
            const unsigned og = xb_add(&bar[XB_TOP], 1u);
            const unsigned tg = og / nx;
            if (og + 1u == (tg + 1u) * nx) xb_add(&bar[XB_TOPGEN], 1u);
            else XB_SPIN(xb_ld(&bar[XB_TOPGEN]) == tg, bar);
            __builtin_amdgcn_fence(__ATOMIC_ACQUIRE, "agent");
            xb_add(&bar[XB_XGEN(b.x)], 1u);
            asm volatile("s_waitcnt vmcnt(0)" ::: "memory");
        } else {
            XB_SPIN(xb_ld(&bar[XB_XGEN(b.x)]) == gen, bar);
            __builtin_amdgcn_fence(__ATOMIC_ACQUIRE, "agent");
            asm volatile("s_waitcnt vmcnt(0)" ::: "memory");
        }
    }
    __syncthreads();
}

namespace pg8 {
constexpr int BM = 256, BK = 64, HALF = 128, HTB = HALF * BK * 2, STAGE_BYTES = 8 * HTB, NXCD = 8, WGM = 8;
__host__ __device__ __forceinline__ int lds_byte(int r, int c) { return r * 128 + ((((c >> 3) ^ (r >> 1)) & 7) << 4) + (c & 7) * 2; }
__host__ __device__ __forceinline__ void stage_rc(int b, int& R, int& C) { R = b >> 7; C = ((((b >> 4) ^ (R >> 1)) & 7) << 3); }
__host__ __device__ __forceinline__ int perm32(int rho) { const int n = rho >> 4, i = rho & 15; return 8 * (i >> 2) + 4 * n + (i & 3); }

struct Unit { unsigned a, b; int row0, col0; };

struct DenseOrder {
    unsigned A, Bt; int K, nM, nN, nwg, G, c;
    __device__ void init(size_t A_, size_t Bt_, int M, int N, int K_, int G_, int c_) { A = (unsigned)A_; Bt = (unsigned)Bt_; K = K_; nM = M / BM; nN = N / BM; nwg = nM * nN; G = G_; c = c_; }
    __device__ bool next(int i, Unit& u) const {
        const long L = (long)i * G + c; if (L >= nwg) return false;
        int wgid = (int)L; { const int q = nwg / NXCD, r = nwg % NXCD, xcd = wgid % NXCD, off = wgid / NXCD; wgid = (xcd < r ? xcd * (q + 1) : r * (q + 1) + (xcd - r) * q) + off; }
        const int nig = WGM * nN, gid = wgid / nig, fm = gid * WGM, gsz = (nM - fm) < WGM ? (nM - fm) : WGM;
        const int pm = fm + ((wgid % nig) % gsz), pn = (wgid % nig) / gsz;
        u.a = A + (unsigned)(pm * BM * K * 2); u.b = Bt + (unsigned)(pn * BM * K * 2); u.row0 = pm * BM; u.col0 = pn * BM; return true;
    }
    __device__ __forceinline__ int arow(const Unit&, int) const { return 0; }
    __device__ __forceinline__ unsigned tokoff() const { return 0u; }
};
struct G1Order {
    unsigned h2, wgu; const int* tok; int G, c;
    __device__ bool next(int i, Unit& u) const {
        const long L = (long)i * G + c; if (L >= 4096) return false;
        const int e = (int)(L >> 8), w = (int)(L & 255), xcd = w & 7, l = w >> 3;
        const int pm = 4 * (xcd & 3) + (l & 3), pn = 8 * (xcd >> 2) + (l >> 2);
        u.a = h2; u.b = wgu + (unsigned)((e * 4096 + pn * 256) * DM); u.row0 = e * EROWS + pm * 256; u.col0 = pn * 128; return true;
    }
    __device__ __forceinline__ int arow(const Unit& u, int r) const { return tok[u.row0 + r]; }
    __device__ __forceinline__ unsigned tokoff() const { return (unsigned)WS_TOK; }
};
struct G2Order {
    unsigned H, wd; int G, c;
    __device__ bool next(int i, Unit& u) const {
        const long L = (long)i * G + c; if (L >= 1024) return false;
        const int r4 = (int)(L >> 8), w = (int)(L & 255), xcd = w & 7, l = w >> 3;
        const int e = 4 * r4 + (xcd >> 1), pm = 8 * (xcd & 1) + (l & 7), pn = l >> 3;
        u.a = H + (unsigned)((e * EROWS + pm * 256) * DFF); u.b = wd + (unsigned)((e * DM + pn * 256) * DFF); u.row0 = e * EROWS + pm * 256; u.col0 = pn * 256; return true;
    }
    __device__ __forceinline__ int arow(const Unit&, int) const { return 0; }
    __device__ __forceinline__ unsigned tokoff() const { return 0u; }
};

struct EpiP {
    static constexpr bool PERM = true, HAS_SCALE = true;
    bf16_t* P; unsigned soff;
    __device__ __forceinline__ unsigned scale_off() const { return soff; }
    __device__ __forceinline__ void operator()(const f32x4 (&acc)[2][2][4][2], const Unit& u, int wr, int wc, int fr, int fq, const LAS float* scl) const {
        const int row0 = u.row0 + wr * 64 + fr, col0 = u.col0 + wc * 32 + 8 * fq;
#pragma unroll
        for (int ai = 0; ai < 2; ++ai)
#pragma unroll
            for (int m = 0; m < 4; ++m) { const int r = row0 + ai * HALF + m * 16; const float rs = scl[wr * 64 + fr + ai * HALF + m * 16]; bf16_t* rowp = P + (size_t)r * NPROJ + col0;
#pragma unroll
                for (int bj = 0; bj < 2; ++bj) { const f32x4 v0 = acc[ai][bj][m][0] * rs, v1 = acc[ai][bj][m][1] * rs;
                    u32x4 w; w.x = cvt_pk_bf16(v0[0], v0[1]); w.y = cvt_pk_bf16(v0[2], v0[3]); w.z = cvt_pk_bf16(v1[0], v1[1]); w.w = cvt_pk_bf16(v1[2], v1[3]);
                    *(u32x4*)(rowp + bj * HALF) = w; } }
    }
};
struct EpiD {
    static constexpr bool PERM = true, HAS_SCALE = false;
    bf16_t* O; const bf16_t* XB;
    __device__ __forceinline__ unsigned scale_off() const { return 0u; }
    __device__ __forceinline__ void operator()(const f32x4 (&acc)[2][2][4][2], const Unit& u, int wr, int wc, int fr, int fq, const LAS float*) const {
        const int row0 = u.row0 + wr * 64 + fr, col0 = u.col0 + wc * 32 + 8 * fq;
#pragma unroll
        for (int ai = 0; ai < 2; ++ai) { u32x4 xv[4][2];
#pragma unroll
            for (int m = 0; m < 4; ++m)
#pragma unroll
                for (int bj = 0; bj < 2; ++bj) xv[m][bj] = *(const u32x4*)(XB + (size_t)(row0 + ai * HALF + m * 16) * DM + col0 + bj * HALF);
#pragma unroll
            for (int m = 0; m < 4; ++m) { bf16_t* rowp = O + (size_t)(row0 + ai * HALF + m * 16) * DM + col0;
#pragma unroll
                for (int bj = 0; bj < 2; ++bj) { const f32x4 v0 = acc[ai][bj][m][0], v1 = acc[ai][bj][m][1]; const u32x4 x = xv[m][bj];
                    u32x4 w; w.x = cvt_pk_bf16(v0[0] + bf2f(x.x & 0xffffu), v0[1] + bf2f(x.x >> 16)); w.y = cvt_pk_bf16(v0[2] + bf2f(x.y & 0xffffu), v0[3] + bf2f(x.y >> 16));
                    w.z = cvt_pk_bf16(v1[0] + bf2f(x.z & 0xffffu), v1[1] + bf2f(x.z >> 16)); w.w = cvt_pk_bf16(v1[2] + bf2f(x.w & 0xffffu), v1[3] + bf2f(x.w >> 16));
                    *(u32x4*)(rowp + bj * HALF) = w; } } }
    }
};
struct EpiH {
    static constexpr bool PERM = true, HAS_SCALE = true;
    unsigned char* Hh; unsigned soff;
    __device__ __forceinline__ unsigned scale_off() const { return soff; }
    __device__ __forceinline__ void operator()(const f32x4 (&acc)[2][2][4][2], const Unit& u, int wr, int wc, int fr, int fq, const LAS float* scl) const {
        const int row0 = u.row0 + wr * 64 + fr, col0 = u.col0 + wc * 32 + 8 * fq;
#pragma unroll
        for (int ai = 0; ai < 2; ++ai)
#pragma unroll
            for (int m = 0; m < 4; ++m) { const int r = row0 + ai * HALF + m * 16; unsigned char* rowp = Hh + (size_t)r * DFF + col0; const float rsc = scl[wr * 64 + fr + ai * HALF + m * 16] * 0.03125f;
                float h[8]; const float ke = -1.4426950408889634f * rsc, k2 = rsc * rsc;
#pragma unroll
                for (int n = 0; n < 2; ++n)
#pragma unroll
                    for (int jp = 0; jp < 2; ++jp) { const f32x2 ag = (f32x2){acc[ai][0][m][n][2 * jp], acc[ai][0][m][n][2 * jp + 1]}, au = (f32x2){acc[ai][1][m][n][2 * jp], acc[ai][1][m][n][2 * jp + 1]};
                        const f32x2 ex = ag * ke; f32x2 d; d.x = __builtin_amdgcn_exp2f(ex.x); d.y = __builtin_amdgcn_exp2f(ex.y); d = d + 1.0f;
                        f32x2 rc; rc.x = __builtin_amdgcn_rcpf(d.x); rc.y = __builtin_amdgcn_rcpf(d.y);
                        const f32x2 hv = (ag * au) * k2 * rc; h[n * 4 + 2 * jp] = hv.x; h[n * 4 + 2 * jp + 1] = hv.y; }
                u32x2 w; w.x = pk4_fp8(h[0], h[1], h[2], h[3]); w.y = pk4_fp8(h[4], h[5], h[6], h[7]);
                *(u32x2*)rowp = w; }
    }
};
struct EpiEo {
    static constexpr bool PERM = true, HAS_SCALE = true;
    unsigned char* O; unsigned soff;
    __device__ __forceinline__ unsigned scale_off() const { return soff; }
    __device__ __forceinline__ void operator()(const f32x4 (&acc)[2][2][4][2], const Unit& u, int wr, int wc, int fr, int fq, const LAS float* scl) const {
        const int row0 = u.row0 + wr * 64 + fr, col0 = u.col0 + wc * 32 + 8 * fq;
#pragma unroll
        for (int ai = 0; ai < 2; ++ai)
#pragma unroll
            for (int m = 0; m < 4; ++m) { const int r = row0 + ai * HALF + m * 16; const float gs = scl[wr * 64 + fr + ai * HALF + m * 16] * 0.5f; unsigned char* rowp = O + (size_t)r * DM + col0;
#pragma unroll
                for (int bj = 0; bj < 2; ++bj) { const f32x4 v0 = acc[ai][bj][m][0] * gs, v1 = acc[ai][bj][m][1] * gs;
                    u32x2 w; w.x = pk4_fp8(v0[0], v0[1], v0[2], v0[3]); w.y = pk4_fp8(v1[0], v1[1], v1[2], v1[3]);
                    *(u32x2*)(rowp + bj * HALF) = w; } }
    }
};

template <class Epi, class Sched, bool GATHER, bool FP8>
__device__ __forceinline__ void gemm_phase(LAS unsigned char* lds, const __amdgpu_buffer_rsrc_t rs, const int tid, const int KB, const Sched& S, const Epi& E) {
    const int wid = __builtin_amdgcn_readfirstlane(tid >> 6), lane = tid & 63, wr = wid >> 2, wc = wid & 3, fr = lane & 15, fq = lane >> 4;
    const int nt = KB / 128;
    int RA[2], CA[2];
    unsigned voffA[2][2], voffB[2];
#pragma unroll
    for (int i = 0; i < 2; ++i) { int R, C; stage_rc(tid * 16 + i * 8192, R, C); const int Rb = Epi::PERM ? ((R & ~31) + perm32(R & 31)) : R;
        RA[i] = R; CA[i] = C; voffB[i] = (unsigned)(Rb * KB + C * 2); }
    const unsigned kstep = 128u;
    const unsigned hstep = (unsigned)(HALF * KB);
    const unsigned ldsw = (unsigned)wid * 1024u;
    const int aoff = lds_byte(wr * 64 + fr, fq * 8), boff = lds_byte(wc * 32 + fr, fq * 8);
    const int aoff1 = lds_byte(wr * 64 + fr, 32 + fq * 8), boff1 = lds_byte(wc * 32 + fr, 32 + fq * 8);
#define PG8_SA(b, h) (((b) * 2 + (h)) * HTB)
#define PG8_SB(b, h) ((4 + (b) * 2 + (h)) * HTB)
#define PG8_STAGE(bufoff, gbase, voff) do { _Pragma("unroll") for (int _i = 0; _i < 2; ++_i) \
        __builtin_amdgcn_raw_ptr_buffer_load_lds(rs, (LAS void*)(lds + (bufoff) + ldsw + _i * 8192), 16, (int)(voff)[_i], (int)(gbase), 0, 0); } while (0)
#define PG8_STAGE_A(bufoff, gbase, h) do { if constexpr (GATHER) { PG8_STAGE(bufoff, gbase, voffA[h]); } else { PG8_STAGE(bufoff, (gbase) + (h) * hstep, voffA[0]); } } while (0)
#define PG8_LDA(dst, b, h) do { _Pragma("unroll") for (int m = 0; m < 4; ++m) { const i32x4 _lo = *(const LAS i32x4*)(lds + PG8_SA(b, h) + aoff + m * 2048), _hi = *(const LAS i32x4*)(lds + PG8_SA(b, h) + aoff1 + m * 2048); \
        dst[m] = __builtin_shufflevector(_lo, _hi, 0, 1, 2, 3, 4, 5, 6, 7); } } while (0)
#define PG8_LDB(dst, b, h) do { _Pragma("unroll") for (int n = 0; n < 2; ++n) { const i32x4 _lo = *(const LAS i32x4*)(lds + PG8_SB(b, h) + boff + n * 2048), _hi = *(const LAS i32x4*)(lds + PG8_SB(b, h) + boff1 + n * 2048); \
        dst[n] = __builtin_shufflevector(_lo, _hi, 0, 1, 2, 3, 4, 5, 6, 7); } } while (0)
#define PG8_MMA(ai, bj, At, Bt) do { __builtin_amdgcn_s_setprio(1); _Pragma("unroll") for (int m = 0; m < 4; ++m) _Pragma("unroll") for (int n = 0; n < 2; ++n) { \
        if constexpr (FP8) asm volatile("v_mfma_scale_f32_16x16x128_f8f6f4 %0, %1, %2, %0, %3, %3 op_sel_hi:[0,0,0]" : "+v"(acc[ai][bj][m][n]) : "v"(Bt[n]), "v"(At[m]), "v"(sc1)); \
        else { acc[ai][bj][m][n] = __builtin_amdgcn_mfma_f32_16x16x32_bf16((bf16x8)__builtin_shufflevector(Bt[n], Bt[n], 0, 1, 2, 3), (bf16x8)__builtin_shufflevector(At[m], At[m], 0, 1, 2, 3), acc[ai][bj][m][n], 0, 0, 0); \
               acc[ai][bj][m][n] = __builtin_amdgcn_mfma_f32_16x16x32_bf16((bf16x8)__builtin_shufflevector(Bt[n], Bt[n], 4, 5, 6, 7), (bf16x8)__builtin_shufflevector(At[m], At[m], 4, 5, 6, 7), acc[ai][bj][m][n], 0, 0, 0); } } \
        __builtin_amdgcn_s_setprio(0); } while (0)
#define PG8_WAIT_V(n) asm volatile("s_waitcnt vmcnt(" #n ")" ::: "memory")
#define PG8_WAIT_L(n) asm volatile("s_waitcnt lgkmcnt(" #n ")" ::: "memory")
#define PG8_BAR __builtin_amdgcn_s_barrier()
#define PG8_SCHED __builtin_amdgcn_sched_barrier(0)
#define PG8_SETVOFF(dst, unit) do { _Pragma("unroll") for (int _h = 0; _h < 2; ++_h) _Pragma("unroll") for (int _i = 0; _i < 2; ++_i) { \
        if constexpr (GATHER) dst[_h][_i] = (unsigned)(S.arow(unit, _h * HALF + RA[_i]) * KB + CA[_i] * 2); \
        else dst[_h][_i] = (unsigned)(RA[_i] * KB + CA[_i] * 2); } } while (0)
    Unit cur, nxt; int ui = 0;
    if (!S.next(0, cur)) return;
    int sc1 = 0x7f7f7f7f; asm volatile("" : "+v"(sc1));
    f32x4 acc[2][2][4][2];
#pragma unroll
    for (int a = 0; a < 2; ++a)
#pragma unroll
        for (int b = 0; b < 2; ++b)
#pragma unroll
            for (int m = 0; m < 4; ++m)
#pragma unroll
                for (int n = 0; n < 2; ++n) acc[a][b][m][n] = (f32x4){0.f, 0.f, 0.f, 0.f};
    i32x8 At[4], B0[2], B1[2];
    unsigned cA = cur.a, cB = cur.b;
    PG8_SETVOFF(voffA, cur);
    PG8_STAGE(PG8_SB(0, 0), cB, voffB); PG8_STAGE(PG8_SB(0, 1), cB + hstep, voffB); PG8_STAGE_A(PG8_SA(0, 0), cA, 0); PG8_STAGE_A(PG8_SA(0, 1), cA, 1);
    if (wr == 1) PG8_BAR;
    PG8_WAIT_V(2); PG8_BAR;
    PG8_STAGE(PG8_SB(1, 0), cB + kstep, voffB); PG8_STAGE_A(PG8_SA(1, 0), cA + kstep, 0); PG8_STAGE(PG8_SB(1, 1), cB + hstep + kstep, voffB);
    PG8_WAIT_V(6); PG8_BAR;
    for (;;) {
        const bool has_next = S.next(ui + 1, nxt);
        const unsigned nA = has_next ? nxt.a : cA, nB = has_next ? nxt.b : cB;
#pragma clang loop unroll(disable)
        for (int t = 0; t < nt; t += 2) {
            const bool last = (t == nt - 2);
            const unsigned a1 = cA + (unsigned)(t + 1) * kstep;
            const unsigned a2 = last ? nA : cA + (unsigned)(t + 2) * kstep, b2 = last ? nB : cB + (unsigned)(t + 2) * kstep;
            const unsigned a3 = a2 + kstep, b3 = b2 + kstep;
            unsigned nvoff[2][2];
            if constexpr (Epi::HAS_SCALE) { if (t == 0)
                    __builtin_amdgcn_raw_ptr_buffer_load_lds(rs, (LAS void*)(lds + 133120 + (ui & 1) * 2048 + (wid >> 2) * 1024 + (wid & 3) * 256), 4, (int)(lane * 4), (int)(E.scale_off() + (unsigned)(cur.row0 + (wid & 3) * 64) * 4u), 0, 0); }
            if constexpr (GATHER) {
                if (t == 0 && has_next)
                    __builtin_amdgcn_raw_ptr_buffer_load_lds(rs, (LAS void*)(lds + 131072 + (wid >> 2) * 1024 + (wid & 3) * 256), 4, (int)(lane * 4), (int)(S.tokoff() + (unsigned)(nxt.row0 + (wid & 3) * 64) * 4u), 0, 0);
                if (last && has_next) {
#pragma unroll
                    for (int _h = 0; _h < 2; ++_h)
#pragma unroll
                        for (int _i = 0; _i < 2; ++_i) nvoff[_h][_i] = (unsigned)(*(const LAS int*)(lds + 131072 + (_h * HALF + RA[_i]) * 4) * KB + CA[_i] * 2); } }
            PG8_LDB(B0, 0, 0); PG8_LDB(B1, 0, 1); PG8_SCHED; PG8_LDA(At, 0, 0); PG8_STAGE_A(PG8_SA(1, 1), a1, 1);
            PG8_WAIT_V(8); PG8_WAIT_L(0); PG8_BAR; PG8_MMA(0, 0, At, B0); PG8_MMA(0, 1, At, B1); PG8_BAR; PG8_SCHED;
            if constexpr (GATHER) { if (last && has_next) {
#pragma unroll
                for (int _h = 0; _h < 2; ++_h)
#pragma unroll
                    for (int _i = 0; _i < 2; ++_i) voffA[_h][_i] = nvoff[_h][_i]; } }
            PG8_LDA(At, 0, 1); PG8_STAGE(PG8_SB(0, 0), b2, voffB); PG8_STAGE(PG8_SB(0, 1), b2 + hstep, voffB);
            PG8_WAIT_V(6); PG8_WAIT_L(0); PG8_BAR; PG8_MMA(1, 0, At, B0); PG8_SCHED; PG8_STAGE_A(PG8_SA(0, 0), a2, 0); PG8_SCHED; PG8_MMA(1, 1, At, B1); PG8_BAR; PG8_SCHED;
            PG8_LDB(B0, 1, 0); PG8_LDB(B1, 1, 1); PG8_SCHED; PG8_LDA(At, 1, 0); PG8_STAGE_A(PG8_SA(0, 1), a2, 1);
            PG8_WAIT_V(8); PG8_WAIT_L(0); PG8_BAR; PG8_MMA(0, 0, At, B0); PG8_MMA(0, 1, At, B1); PG8_BAR; PG8_SCHED;
            PG8_LDA(At, 1, 1); PG8_STAGE(PG8_SB(1, 0), b3, voffB); PG8_STAGE(PG8_SB(1, 1), b3 + hstep, voffB);
            PG8_WAIT_V(6); PG8_WAIT_L(0); PG8_BAR; PG8_MMA(1, 0, At, B0); PG8_SCHED; PG8_STAGE_A(PG8_SA(1, 0), a3, 0); PG8_SCHED; PG8_MMA(1, 1, At, B1); PG8_BAR; PG8_SCHED;
        }
        if (wr == 0) PG8_BAR;
        if constexpr (FP8) asm volatile("s_nop 15\n\ts_nop 15" ::: "memory");
        E(acc, cur, wr, wc, fr, fq, (const LAS float*)(lds + 133120 + (ui & 1) * 2048));
        if (!has_next) break;
#pragma unroll
        for (int a = 0; a < 2; ++a)
#pragma unroll
            for (int b = 0; b < 2; ++b)
#pragma unroll
                for (int m = 0; m < 4; ++m)
#pragma unroll
                    for (int n = 0; n < 2; ++n) acc[a][b][m][n] = (f32x4){0.f, 0.f, 0.f, 0.f};
        cur = nxt; cA = nA; cB = nB; ++ui;
        if (wr == 1) PG8_BAR;
    }
    PG8_WAIT_V(0);
    PG8_BAR;
#undef PG8_SA
#undef PG8_SB
#undef PG8_STAGE
#undef PG8_STAGE_A
#undef PG8_LDA
#undef PG8_LDB
#undef PG8_MMA
#undef PG8_WAIT_V
#undef PG8_WAIT_L
#undef PG8_BAR
#undef PG8_SCHED
#undef PG8_SETVOFF
}
}

struct Args { const float* in[22]; float* out; unsigned char* ws; int ph_lo, ph_hi, rep_phase, rep_n; };
typedef const __attribute__((address_space(4))) Args KArgs;
struct Frame {
    LAS unsigned char* lds;
    int tid, lane, wave, G, bx, vcu;
};

__device__ __forceinline__ void transpose_item(const float* W, int N, int k0, int n0, bf16_t* WT, int ldk, int drow0, const float* kscale, LAS float* scr, int lane) {
#pragma unroll 8
    for (int i = 0; i < 32; ++i) { const int kk = 2 * i + (lane >> 5); float v = W[(size_t)(k0 + kk) * N + n0 + (lane & 31)]; if (kscale) v *= kscale[k0 + kk]; scr[kk * 33 + (lane & 31)] = v; }
    LDS_WAIT(); asm volatile("" ::: "memory");
    const int c = lane & 7;
#pragma unroll
    for (int j = 0; j < 4; ++j) { const int n = (lane >> 3) + 8 * j; const LAS float* s = scr + (8 * c) * 33 + n;
        u32x4 o; o.x = pk2(s[0 * 33], s[1 * 33]); o.y = pk2(s[2 * 33], s[3 * 33]); o.z = pk2(s[4 * 33], s[5 * 33]); o.w = pk2(s[6 * 33], s[7 * 33]);
        *(u32x4*)(WT + (size_t)(drow0 + n) * ldk + k0 + 8 * c) = o; }
    LDS_WAIT(); asm volatile("" ::: "memory");
}
struct WItem { const float* src; unsigned char* dst; int N, ldk; };
__device__ __forceinline__ WItem w_item(KArgs& a, int which, int r, int lane) {
    unsigned char* ws = a.ws; WItem it; const int e = r >> 9, q = r & 511; const int kq = lane >> 4, n4 = (lane & 15) * 4;
    if (which < 2) { const int kb = q >> 5, nb = q & 31, n0 = nb * 64; it.N = DFF; it.ldk = DM;
        it.src = a.in[18 + which] + (size_t)e * DM * DFF + (size_t)(kb * 64 + kq) * DFF + n0 + n4;
        it.dst = (unsigned char*)(ws + WS_WGU) + (size_t)e * 4096 * DM + (size_t)((n0 >> 7) * 256 + which * 128 + (n0 & 127)) * DM + kb * 64; }
    else { const int kb = q >> 4, nb = q & 15; it.N = DM; it.ldk = DFF;
        it.src = a.in[20] + (size_t)e * DFF * DM + (size_t)(kb * 64 + kq) * DM + nb * 64 + n4;
        it.dst = (unsigned char*)(ws + WS_WD) + (size_t)e * DM * DFF + (size_t)(nb * 64) * DFF + kb * 64; }
    return it;
}
__device__ __forceinline__ void w_load(const WItem& it, f32x4 (&v)[16]) {
#pragma unroll
    for (int i = 0; i < 16; ++i) v[i] = *(const f32x4*)(it.src + (size_t)(4 * i) * it.N);
}
__device__ __forceinline__ void w_finish(const WItem& it, const f32x4 (&v)[16], LAS float* scr, int lane) {
    const int kq = lane >> 4, n4 = (lane & 15) * 4;
#pragma unroll
    for (int i = 0; i < 16; ++i) { const int kk = kq + 4 * i; *(LAS f32x4*)(scr + kk * 68 + ((n4 + 8 * (kk >> 4)) & 63)) = v[i] * 32.0f; }
    LDS_WAIT(); asm volatile("" ::: "memory");
    const int nl = lane >> 2, j = lane & 3;
#pragma unroll
    for (int p = 0; p < 4; ++p) { const int n = 16 * p + nl; const LAS float* sp = scr + (16 * j) * 68 + ((n + 8 * j) & 63);
        u32x4 o; o.x = pk4_fp8(sp[0 * 68], sp[1 * 68], sp[2 * 68], sp[3 * 68]); o.y = pk4_fp8(sp[4 * 68], sp[5 * 68], sp[6 * 68], sp[7 * 68]);
        o.z = pk4_fp8(sp[8 * 68], sp[9 * 68], sp[10 * 68], sp[11 * 68]); o.w = pk4_fp8(sp[12 * 68], sp[13 * 68], sp[14 * 68], sp[15 * 68]);
        *(u32x4*)(it.dst + (size_t)n * it.ldk + 16 * j) = o; }
    LDS_WAIT(); asm volatile("" ::: "memory");
}
constexpr int WD_SPLIT = 6144;
__device__ __forceinline__ void expert_w_items(const Frame& F, KArgs& a, int which, int gwi, int ngw, int r_lo = 0, int r_hi = 8192) {
    LAS float* scr = (LAS float*)(F.lds + F.wave * 17408);
    for (int r = r_lo + gwi; r < r_hi; r += ngw) { const WItem it = w_item(a, which, r, F.lane); f32x4 v[16]; w_load(it, v); w_finish(it, v, scr, F.lane); }
}
__device__ __forceinline__ void p0_prep(const Frame& F, KArgs& a) {
    unsigned char* ws = a.ws;
    LAS float* scr = (LAS float*)(F.lds + F.wave * 17408);
    const int gw = F.vcu * NWAVES + F.wave, NGW = F.G * NWAVES;
    for (int r0 = (a.rep_phase == 100) ? a.rep_n : 0; r0 >= 0; --r0) { const float* x = a.in[0]; bf16_t* xb = (bf16_t*)(ws + WS_XB); float* rstd = (float*)(ws + WS_RSTD1);
      for (int m = gw; m < MTOK; m += 2 * NGW) {
          const int m2 = m + NGW;
          const f32x4* xr = (const f32x4*)(x + (size_t)m * DM) + F.lane; const f32x4* xr2 = (const f32x4*)(x + (size_t)(m2 < MTOK ? m2 : m) * DM) + F.lane; f32x4 v[4], v2[4]; float s = 0.f, s2 = 0.f;
#pragma unroll
          for (int j = 0; j < 4; ++j) { v[j] = xr[64 * j]; v2[j] = xr2[64 * j]; }
#pragma unroll
          for (int j = 0; j < 4; ++j) { s += (v[j].x * v[j].x + v[j].y * v[j].y) + (v[j].z * v[j].z + v[j].w * v[j].w); s2 += (v2[j].x * v2[j].x + v2[j].y * v2[j].y) + (v2[j].z * v2[j].z + v2[j].w * v2[j].w); }
          s = wave_sum(s); s2 = wave_sum(s2);
          if (F.lane == 0) { rstd[m] = 1.0f / sqrtf(s * (1.0f / DM) + EPS); if (m2 < MTOK) rstd[m2] = 1.0f / sqrtf(s2 * (1.0f / DM) + EPS); }
          unsigned long long* o8 = (unsigned long long*)(xb + (size_t)m * DM) + F.lane;
#pragma unroll
          for (int j = 0; j < 4; ++j) o8[64 * j] = (unsigned long long)pk2(v[j].x, v[j].y) | ((unsigned long long)pk2(v[j].z, v[j].w) << 32);
          if (m2 < MTOK) { unsigned long long* o82 = (unsigned long long*)(xb + (size_t)m2 * DM) + F.lane;
#pragma unroll
              for (int j = 0; j < 4; ++j) o82[64 * j] = (unsigned long long)pk2(v2[j].x, v2[j].y) | ((unsigned long long)pk2(v2[j].z, v2[j].w) << 32); }
      } }
    for (int r0 = (a.rep_phase == 101) ? a.rep_n : 0; r0 >= 0; --r0) { constexpr int I_WIN = 16 * 48, I_WOUT = 8 * 32;
      bf16_t* WinT = (bf16_t*)(ws + WS_WIN); bf16_t* W2T = (bf16_t*)(ws + WS_W2);
      for (int it = gw; it < I_WIN + I_WOUT; it += NGW) {
          int r = it;
          if (r < I_WIN) { const int kb = r / 48, nb = r % 48; transpose_item(a.in[2], NPROJ, kb * 64, nb * 32, WinT, DM, nb * 32, a.in[1], scr, F.lane); continue; } r -= I_WIN;
          { const int kb = r / 32, nb = r % 32; transpose_item(a.in[15], DM, kb * 64, nb * 32, W2T, KOUT, nb * 32, nullptr, scr, F.lane); }
      } }
    for (int r0 = (a.rep_phase == 102) ? a.rep_n : 0; r0 >= 0; --r0) { expert_w_items(F, a, 0, gw, NGW); expert_w_items(F, a, 1, gw, NGW); expert_w_items(F, a, 2, gw, NGW, 0, WD_SPLIT); }
    { LAS float* ctab = (LAS float*)(F.lds);
      __syncthreads();
      if (F.tid < 128) ctab[F.tid] = cospif((float)F.tid * (1.0f / 64.0f));
      __syncthreads();
      const float* wout = a.in[15]; bf16_t* W2T = (bf16_t*)(ws + WS_W2);
      for (int it = gw; it < 2048; it += NGW) {
          const int kb = it >> 4, nb = it & 15; const int krow0 = 512 + kb * 8; const int sn = (krow0 >= 1024) ? 1 : 0; const int cg0 = (krow0 - 512 - sn * 512); const int g = cg0 >> 7, c0 = cg0 & 127;
          const int n = nb * 64 + F.lane; float accv[8];
#pragma unroll
          for (int i = 0; i < 8; ++i) accv[i] = 0.f;
          const float* wp = wout + (size_t)(512 + g * 128) * DM + n;
#pragma unroll 1
          for (int jb = 0; jb < 128; jb += 32) { float wv[32];
#pragma unroll
              for (int jj = 0; jj < 32; ++jj) wv[jj] = wp[(size_t)(jb + jj) * DM];
#pragma unroll
              for (int jj = 0; jj < 32; ++jj) { const int j = jb + jj;
#pragma unroll
                  for (int i = 0; i < 8; ++i) { const int ph = (j * (c0 + i) - sn * 32) & 127; accv[i] += ctab[ph] * wv[jj]; } } }
          const float sc = sn ? (-1.0f / 1024.0f) : (1.0f / 1024.0f);
          u32x4 o; o.x = pk2(accv[0] * sc, accv[1] * sc); o.y = pk2(accv[2] * sc, accv[3] * sc); o.z = pk2(accv[4] * sc, accv[5] * sc); o.w = pk2(accv[6] * sc, accv[7] * sc);
          *(u32x4*)(W2T + (size_t)n * KOUT + krow0) = o;
      } }
    { bf16_t* WgT = (bf16_t*)(ws + WS_WGT);
      for (int o = (F.vcu * NTHREADS + F.tid); o < NHEAD * 256 * 64; o += F.G * NTHREADS) {
          const int k = o & 63, n = (o >> 6) & 255, h = o >> 14, mat = n >> 6, j = n & 63;
          const float* W = a.in[mat == 0 ? 5 : mat == 1 ? 7 : mat == 2 ? 10 : 12];
          WgT[o] = (bf16_t)f2bf(W[(h * 64 + k) * 64 + j]);
      } }
}

__device__ constexpr float TWR[32] = {1.000000000e+00f, 9.951847267e-01f, 9.807852804e-01f, 9.569403357e-01f, 9.238795325e-01f, 8.819212643e-01f, 8.314696123e-01f, 7.730104534e-01f, 7.071067812e-01f, 6.343932842e-01f, 5.555702330e-01f, 4.713967368e-01f, 3.826834324e-01f, 2.902846773e-01f, 1.950903220e-01f, 9.801714033e-02f, 0.0f, -9.801714033e-02f, -1.950903220e-01f, -2.902846773e-01f, -3.826834324e-01f, -4.713967368e-01f, -5.555702330e-01f, -6.343932842e-01f, -7.071067812e-01f, -7.730104534e-01f, -8.314696123e-01f, -8.819212643e-01f, -9.238795325e-01f, -9.569403357e-01f, -9.807852804e-01f, -9.951847267e-01f};
__device__ constexpr float TWI[32] = {-0.0f, -9.801714033e-02f, -1.950903220e-01f, -2.902846773e-01f, -3.826834324e-01f, -4.713967368e-01f, -5.555702330e-01f, -6.343932842e-01f, -7.071067812e-01f, -7.730104534e-01f, -8.314696123e-01f, -8.819212643e-01f, -9.238795325e-01f, -9.569403357e-01f, -9.807852804e-01f, -9.951847267e-01f, -1.000000000e+00f, -9.951847267e-01f, -9.807852804e-01f, -9.569403357e-01f, -9.238795325e-01f, -8.819212643e-01f, -8.314696123e-01f, -7.730104534e-01f, -7.071067812e-01f, -6.343932842e-01f, -5.555702330e-01f, -4.713967368e-01f, -3.826834324e-01f, -2.902846773e-01f, -1.950903220e-01f, -9.801714033e-02f};
constexpr int bitrev_c(int i, int n) { int r = 0; for (int b = 0; b < n; ++b) r |= ((i >> b) & 1) << (n - 1 - b); return r; }
template <int N, int ST, int L> struct FftStage {
    static __device__ __forceinline__ void run(float (&re)[N], float (&im)[N]) {
        constexpr int m = 1 << ST, h = m >> 1;
#pragma unroll
        for (int kk = 0; kk < N; kk += m) {
#pragma unroll
            for (int j = 0; j < h; ++j) {
                const float wr = TWR[j * (64 / m)], wi = TWI[j * (64 / m)];
                const float xr = re[kk + j + h], xi = im[kk + j + h];
                const float tr = wr * xr - wi * xi, ti = wr * xi + wi * xr;
                re[kk + j + h] = re[kk + j] - tr; im[kk + j + h] = im[kk + j] - ti;
                re[kk + j] += tr; im[kk + j] += ti;
            }
        }
        if constexpr (ST < L) FftStage<N, ST + 1, L>::run(re, im);
    }
};
template <int N, int L> __device__ __forceinline__ void fft_inreg(float (&re)[N], float (&im)[N]) {
#pragma unroll
    for (int i = 0; i < N; ++i) { const int j = bitrev_c(i, L); if (i < j) { float t = re[i]; re[i] = re[j]; re[j] = t; t = im[i]; im[i] = im[j]; im[j] = t; } }
    FftStage<N, 1, L>::run(re, im);
}

__device__ __forceinline__ void fft1_item(const Frame& F, const bf16_t* P, u32x2* V, int item) {
    const int b = item >> 7, sg = (item >> 3) & 15, cc = item & 7;
    const int s2a = 16 * sg + 2 * F.wave, c = cc * 64 + F.lane;
    float re[32], im[32];
    const bf16_t* src = P + ((size_t)b * SEQ + s2a) * NPROJ + 1024 + c;
#pragma unroll
    for (int i = 0; i < 32; ++i) { re[i] = bf2f(src[(size_t)i * 256 * NPROJ]); im[i] = bf2f(src[(size_t)i * 256 * NPROJ + NPROJ]); }
    fft_inreg<32, 5>(re, im);
    float sa, ca, sb, cb; sincospif((float)s2a * (1.0f / 4096.0f), &sa, &ca); sincospif((float)(s2a + 1) * (1.0f / 4096.0f), &sb, &cb);
    float war = 1.f, wai = 0.f, wbr = 1.f, wbi = 0.f;
    u32x2* dst = V + (((size_t)b * 17) * 128 + (s2a >> 1)) * 512 + c;
#pragma unroll
    for (int k = 0; k <= 16; ++k) {
        const int km = (32 - k) & 31;
        const float ar = 0.5f * (re[k] + re[km]), ai = 0.5f * (im[k] - im[km]), br = 0.5f * (im[k] + im[km]), bi = -0.5f * (re[k] - re[km]);
        f32x2 va, vb; va.x = ar * war - ai * wai; va.y = ar * wai + ai * war; vb.x = br * wbr - bi * wbi; vb.y = br * wbi + bi * wbr;
        dst[(size_t)k * 128 * 512] = (u32x2){pk2(va.x, va.y), pk2(vb.x, vb.y)};
        const float t0 = war * ca + wai * sa; wai = wai * ca - war * sa; war = t0;
        const float t1 = wbr * cb + wbi * sb; wbi = wbi * cb - wbr * sb; wbr = t1;
    }
}
__device__ __forceinline__ void fft2_item(const Frame& F, const u32x2* V, bf16_t* A2, int b, int k1, int cc) {
    const int w = F.wave, c = cc * 64 + F.lane;
    LAS f32x2* T = (LAS f32x2*)F.lds;
    { u32x2 pv[16];
      const u32x2* src = V + (((size_t)b * 17 + k1) * 128 + w) * 512 + c;
#pragma unroll
      for (int j1 = 0; j1 < 16; ++j1) pv[j1] = src[(size_t)j1 * 8 * 512];
#pragma unroll
      for (int jj = 0; jj < 2; ++jj) { const int j2 = 2 * w + jj; float re[16], im[16];
#pragma unroll
          for (int j1 = 0; j1 < 16; ++j1) { const unsigned q = jj ? pv[j1].y : pv[j1].x; re[j1] = bf2f(q & 0xffffu); im[j1] = bf2f(q >> 16); }
          fft_inreg<16, 4>(re, im);
#pragma unroll
          for (int q1 = 0; q1 < 16; ++q1) { float sn, cs; sincospif((float)(q1 * j2) * (1.0f / 128.0f), &sn, &cs);
              f32x2 o; o.x = re[q1] * cs + im[q1] * sn; o.y = im[q1] * cs - re[q1] * sn; T[(q1 * 16 + j2) * 64 + F.lane] = o; } } }
    __syncthreads();
#pragma unroll 1
    for (int qq = 0; qq < 2; ++qq) { const int q1 = 2 * w + qq; float re[16], im[16];
#pragma unroll
        for (int j2 = 0; j2 < 16; ++j2) { const f32x2 v = T[(q1 * 16 + j2) * 64 + F.lane]; re[j2] = v.x; im[j2] = v.y; }
        fft_inreg<16, 4>(re, im);
#pragma unroll
        for (int q2 = 0; q2 < 16; ++q2) { const int k = k1 + 32 * (q1 + 16 * q2);
            bf16_t* d = A2 + ((size_t)b * SEQ + k) * KOUT + 512 + c; d[0] = (bf16_t)f2bf(re[q2]); d[512] = (bf16_t)f2bf(-im[q2]);
            if (k1 != 0 && k1 != 16) { bf16_t* dm = A2 + ((size_t)b * SEQ + (SEQ - k)) * KOUT + 512 + c; dm[0] = (bf16_t)f2bf(re[q2]); dm[512] = (bf16_t)f2bf(im[q2]); } } }
    __syncthreads();
}

constexpr int LRU_WG = 0, LRU_CS = 32768, LRU_CF = 49152, LRU_XT = 81920, LRU_GT = 98816  , LRU_AGW = 115200, LRU_WCAR = 123392, LRU_CARRY = 127488, LRU_CONST = 131584;
static_assert(LRU_XT + 131 * 128 <= LRU_GT && LRU_GT + 16384 <= LRU_AGW && LRU_AGW + 8192 <= LRU_WCAR && LRU_WCAR + 4096 <= LRU_CARRY && LRU_CARRY + 4096 <= LRU_CONST && LRU_CONST + 11 * 256 <= MISC_OFF, "LRU LDS map");
template <int PASS>
__device__ __forceinline__ void lru_super_item(const Frame& F, KArgs& a, int si) {
    const int b = si >> 6, h = (si >> 3) & 7, j0 = (si & 7) * 8;
    const int tid = F.tid, lane = F.lane, w = F.wave, fr = lane & 15, fq = lane >> 4;
    unsigned char* ws = a.ws;
    const bf16_t* P = (const bf16_t*)a.out;
    LAS unsigned char* lds = F.lds;
    f32x2* agg = (f32x2*)(ws + WS_AGG);
    { const bf16_t* WgT = (const bf16_t*)(ws + WS_WGT) + (size_t)h * 256 * 64;
#pragma unroll
      for (int i = 0; i < 4; ++i) { const int q = tid + 512 * i, n = q >> 3, ch = q & 7; const u32x4 v = *(const u32x4*)(WgT + n * 64 + ch * 8); *(LAS u32x4*)(lds + LRU_WG + n * 128 + ((ch ^ (n & 7)) << 4)) = v; } }
    { LAS float* KC = (LAS float*)(lds + LRU_CONST);
      if (tid < 64) { const int ch = h * 64 + tid;
          KC[0 * 64 + tid] = -8.0f * log1pf(expf(-a.in[9][ch])) * 1.4426950408889634f; KC[1 * 64 + tid] = -8.0f * log1pf(expf(-a.in[14][ch])) * 1.4426950408889634f;
          KC[2 * 64 + tid] = a.in[6][ch]; KC[3 * 64 + tid] = a.in[8][ch]; KC[4 * 64 + tid] = a.in[11][ch]; KC[5 * 64 + tid] = a.in[13][ch]; KC[6 * 64 + tid] = a.in[4][ch];
#pragma unroll
          for (int k = 0; k < 4; ++k) KC[(7 + k) * 64 + tid] = a.in[3][k * DLRU + ch]; } }
    const LAS float* KC = (const LAS float*)(lds + LRU_CONST);
    const int ch4 = tid & 15, tq = tid >> 4;
    if (PASS == 2) {
        if (tid < 128) { const int dir = tid >> 6, ch = tid & 63; LAS float* CAR = (LAS float*)(lds + LRU_CARRY);
            float carry = 0.f;
            if (dir == 0) { for (int jj = 0; jj < j0 + 8; ++jj) { if (jj >= j0) CAR[((jj - j0) * 2 + 0) * 64 + ch] = carry; const f32x2 ah = agg[(((size_t)b * 64 + jj) * 2 + 0) * 512 + h * 64 + ch]; carry = ah.x * carry + ah.y; } }
            else { for (int jj = 63; jj >= j0; --jj) { if (jj < j0 + 8) CAR[((jj - j0) * 2 + 1) * 64 + ch] = carry; const f32x2 ah = agg[(((size_t)b * 64 + jj) * 2 + 1) * 512 + h * 64 + ch]; carry = ah.x * carry + ah.y; } }
        }
    }
    __syncthreads();
    u32x4 px[3], pg[2];
#define LRU_LOAD_CHUNK(jj) do { const int _t0 = (jj) * 128; \
        _Pragma("unroll") for (int _i = 0; _i < 3; ++_i) { const int _q = tid + 512 * _i, _r = _q >> 3, _c = _q & 7, _t = _t0 - 2 + _r; px[_i] = (u32x4){0u, 0u, 0u, 0u}; \
            if (_q < 131 * 8 && _t >= 0 && _t < SEQ) px[_i] = *(const u32x4*)(P + ((size_t)b * SEQ + _t) * NPROJ + h * 64 + _c * 8); } \
        if (PASS == 2) { _Pragma("unroll") for (int _i = 0; _i < 2; ++_i) { const int _q = tid + 512 * _i, _r = _q >> 3, _c = _q & 7; pg[_i] = *(const u32x4*)(P + ((size_t)b * SEQ + _t0 + _r) * NPROJ + 512 + h * 64 + _c * 8); } } } while (0)
    LRU_LOAD_CHUNK(j0);
    for (int jl = 0; jl < 8; ++jl) {
        const int j = j0 + jl, t0 = j * 128;
#pragma unroll
        for (int i = 0; i < 3; ++i) { const int q = tid + 512 * i, r = q >> 3, chk = q & 7; if (q < 131 * 8) *(LAS u32x4*)(lds + LRU_XT + r * 128 + chk * 16) = px[i]; }
        if (PASS == 2) {
#pragma unroll
            for (int i = 0; i < 2; ++i) { const int q = tid + 512 * i, r = q >> 3, chk = q & 7; *(LAS u32x4*)(lds + LRU_GT + r * 128 + chk * 16) = pg[i]; } }
        __syncthreads();
        if (jl < 7) LRU_LOAD_CHUNK(j + 1);
        { float xv[7][4]; const f32x4 cbias = *(const LAS f32x4*)(KC + 6 * 64 + ch4 * 4); f32x4 cwv[4];
#pragma unroll
          for (int k = 0; k < 4; ++k) cwv[k] = *(const LAS f32x4*)(KC + (7 + k) * 64 + ch4 * 4);
#pragma unroll
          for (int r = 0; r < 7; ++r) { const u32x2 v = *(const LAS u32x2*)(lds + LRU_XT + (4 * tq + r) * 128 + ch4 * 8); xv[r][0] = bf2f(v.x & 0xffffu); xv[r][1] = bf2f(v.x >> 16); xv[r][2] = bf2f(v.y & 0xffffu); xv[r][3] = bf2f(v.y >> 16); }
#pragma unroll
          for (int tt = 0; tt < 4; ++tt) { const int t = 4 * tq + tt; f32x4 cv;
#pragma unroll
              for (int i = 0; i < 4; ++i) { float s = cbias[i];
#pragma unroll
                  for (int k = 0; k < 4; ++k) s += cwv[k][i] * xv[tt + k][i];
                  cv[i] = s; }
              *(LAS f32x4*)(lds + LRU_CF + t * 256 + ch4 * 16) = cv;
              u32x2 pk; pk.x = pk2(cv[0], cv[1]); pk.y = pk2(cv[2], cv[3]);
              *(LAS u32x2*)(lds + LRU_CS + t * 128 + (((ch4 >> 1) ^ (t & 7)) << 4) + (ch4 & 1) * 8) = pk; } }
        __syncthreads();
        bf16x8 af[2];
        { const int row = 16 * w + fr;
#pragma unroll
          for (int kk = 0; kk < 2; ++kk) af[kk] = *(const LAS bf16x8*)(lds + LRU_CS + row * 128 + (((kk * 4 + fq) ^ (row & 7)) << 4)); }
#pragma unroll 1
        for (int hf = 0; hf < 2; ++hf) {
            float Pf[2][4], Hf[2][4], Pb[2][4], Hb[2][4];
#pragma unroll
            for (int cb = 0; cb < 2; ++cb) { const int cb4 = 2 * hf + cb;
                f32x4 acc[4];
#pragma unroll
                for (int mat = 0; mat < 4; ++mat) { acc[mat] = (f32x4){0.f, 0.f, 0.f, 0.f}; const int n = (mat * 4 + cb4) * 16 + fr;
#pragma unroll
                    for (int kk = 0; kk < 2; ++kk) { const bf16x8 bfr = *(const LAS bf16x8*)(lds + LRU_WG + n * 128 + (((kk * 4 + fq) ^ (n & 7)) << 4)); acc[mat] = __builtin_amdgcn_mfma_f32_16x16x32_bf16(af[kk], bfr, acc[mat], 0, 0, 0); } }
                float af_[4], bf_[4], ab_[4], bb_[4]; const int chl = cb4 * 16 + fr;
                const float k_c8f = KC[chl], k_c8b = KC[64 + chl], k_baf = KC[128 + chl], k_bxf = KC[192 + chl], k_bab = KC[256 + chl], k_bxb = KC[320 + chl];
#pragma unroll
                for (int r = 0; r < 4; ++r) { const int t = 16 * w + 4 * fq + r; const float cval = *(const LAS float*)(lds + LRU_CF + t * 256 + chl * 4);
                    const float rf = fast_sigmoid(acc[0][r] + k_baf), xf = fast_sigmoid(acc[1][r] + k_bxf);
                    const float rb = fast_sigmoid(acc[2][r] + k_bab), xb = fast_sigmoid(acc[3][r] + k_bxb);
                    const float a1 = __builtin_amdgcn_exp2f(k_c8f * rf), a2 = __builtin_amdgcn_exp2f(k_c8b * rb);
                    af_[r] = a1; bf_[r] = __builtin_amdgcn_sqrtf(fmaxf(fmaf(-a1, a1, 1.0f), 0.f)) * xf * cval;
                    ab_[r] = a2; bb_[r] = __builtin_amdgcn_sqrtf(fmaxf(fmaf(-a2, a2, 1.0f), 0.f)) * xb * cval; }
                Pf[cb][0] = af_[0]; Hf[cb][0] = bf_[0];
#pragma unroll
                for (int r = 1; r < 4; ++r) { Pf[cb][r] = af_[r] * Pf[cb][r - 1]; Hf[cb][r] = af_[r] * Hf[cb][r - 1] + bf_[r]; }
                Pb[cb][3] = ab_[3]; Hb[cb][3] = bb_[3];
#pragma unroll
                for (int r = 2; r >= 0; --r) { Pb[cb][r] = ab_[r] * Pb[cb][r + 1]; Hb[cb][r] = ab_[r] * Hb[cb][r + 1] + bb_[r]; }
            }
            float gPf[2], gHf[2], gPb[2], gHb[2];
            { LAS f32x2* AGW = (LAS f32x2*)(lds + LRU_AGW);
#pragma unroll
              for (int cb = 0; cb < 2; ++cb) { const int chl = (2 * hf + cb) * 16 + fr;
                  const bool odd = (fq & 1) != 0, hi = (fq & 2) != 0;
                  { const float A = Pf[cb][3], H = Hf[cb][3];
                    const float A1 = xchg16(A, lane), H1 = xchg16(H, lane);
                    const float pA = odd ? A1 : 1.f, pH = odd ? H1 : 0.f, qA = A * A1, qH = odd ? (A * H1 + H) : (A1 * H + H1);
                    const float QA = xchg32(qA, lane), QH = xchg32(qH, lane);
                    gPf[cb] = hi ? pA * QA : pA; gHf[cb] = hi ? (pA * QH + pH) : pH;
                    if (fq == 0) AGW[(w * 2 + 0) * 64 + chl] = (f32x2){qA * QA, QA * qH + QH}; }
                  { const float A = Pb[cb][0], H = Hb[cb][0];
                    const float A1 = xchg16(A, lane), H1 = xchg16(H, lane);
                    const float pA = odd ? 1.f : A1, pH = odd ? 0.f : H1, qA = A * A1, qH = odd ? (A1 * H + H1) : (A * H1 + H);
                    const float QA = xchg32(qA, lane), QH = xchg32(qH, lane);
                    gPb[cb] = hi ? pA : pA * QA; gHb[cb] = hi ? pH : (pA * QH + pH);
                    if (fq == 0) AGW[(w * 2 + 1) * 64 + chl] = (f32x2){qA * QA, qA * QH + qH}; }
              } }
            __syncthreads();
            if (tid < 64) { const int dir = tid >> 5, ch = hf * 32 + (tid & 31); const LAS f32x2* AGW = (const LAS f32x2*)(lds + LRU_AGW); LAS float* WCAR = (LAS float*)(lds + LRU_WCAR);
                float carry = (PASS == 2) ? ((const LAS float*)(lds + LRU_CARRY))[(jl * 2 + dir) * 64 + ch] : 0.f; float ptot = 1.f;
                if (dir == 0) { for (int ww = 0; ww < 8; ++ww) { WCAR[(ww * 2 + 0) * 64 + ch] = carry; const f32x2 ah = AGW[(ww * 2 + 0) * 64 + ch]; carry = ah.x * carry + ah.y; ptot *= ah.x; } }
                else { for (int ww = 7; ww >= 0; --ww) { WCAR[(ww * 2 + 1) * 64 + ch] = carry; const f32x2 ah = AGW[(ww * 2 + 1) * 64 + ch]; carry = ah.x * carry + ah.y; ptot *= ah.x; } }
                if (PASS == 1) agg[(((size_t)b * 64 + j) * 2 + dir) * 512 + h * 64 + ch] = (f32x2){ptot, carry};
            }
            if (PASS == 2) {
                __syncthreads();
                const LAS float* WCAR = (const LAS float*)(lds + LRU_WCAR);
#pragma unroll
                for (int cb = 0; cb < 2; ++cb) { const int ch = (2 * hf + cb) * 16 + fr;
                    const float cf = gHf[cb] + gPf[cb] * WCAR[(w * 2 + 0) * 64 + ch], cbk = gHb[cb] + gPb[cb] * WCAR[(w * 2 + 1) * 64 + ch];
#pragma unroll
                    for (int r = 0; r < 4; ++r) { const int t = 16 * w + 4 * fq + r; const float hs = (Hf[cb][r] + Pf[cb][r] * cf) + (Hb[cb][r] + Pb[cb][r] * cbk);
                        LAS bf16_t* gp = (LAS bf16_t*)(lds + LRU_GT + t * 128 + ch * 2); const float g = bf2f((unsigned)*gp);
                        const float u = 0.7978845608028654f * (g + 0.044715f * g * g * g); const float th = 1.0f - 2.0f * __builtin_amdgcn_rcpf(1.0f + __builtin_amdgcn_exp2f(2.885390081777927f * u));
                        *gp = (bf16_t)f2bf(0.5f * g * (1.0f + th) * hs); } }
            }
        }
        if (PASS == 2) {
            __syncthreads();
            bf16_t* A2 = (bf16_t*)(ws + WS_A2);
#pragma unroll
            for (int i = 0; i < 2; ++i) { const int q = tid + 512 * i, r = q >> 3, chk = q & 7; const u32x4 v = *(const LAS u32x4*)(lds + LRU_GT + r * 128 + chk * 16);
                *(u32x4*)(A2 + ((size_t)b * SEQ + t0 + r) * KOUT + h * 64 + chk * 8) = v; }
        }
        __syncthreads();
    }
#undef LRU_LOAD_CHUNK
}

constexpr int P5_PITCH = 2048 + 16;
__device__ __forceinline__ void p5_router(const Frame& F, KArgs& a) {
    unsigned char* ws = a.ws;
    LAS unsigned char* WH = F.lds; LAS unsigned char* WL = F.lds + 16 * P5_PITCH;
    { const float* wr = a.in[17];
      for (int o = F.tid; o < DM * NEXP; o += NTHREADS) { const int k = o >> 4, e = o & 15; const float w = wr[o]; const unsigned hi = f2bf(w); const float lo = w - bf2f(hi);
          *(LAS bf16_t*)(WH + e * P5_PITCH + k * 2) = (bf16_t)hi; *(LAS bf16_t*)(WL + e * P5_PITCH + k * 2) = (bf16_t)f2bf(lo); } }
    __syncthreads();
    const bf16_t* xm = (const bf16_t*)(ws + WS_DELTA); const float* g2 = a.in[16];
    unsigned char* h2 = (unsigned char*)(ws + WS_H2); float* scores = (float*)(ws + WS_SCORES); float* rstd2 = (float*)(ws + WS_RSTD1);
    const int gw = F.vcu * NWAVES + F.wave, NGW = F.G * NWAVES, fr = F.lane & 15, fq = F.lane >> 4;
    for (int grp = gw; grp < MTOK / 16; grp += NGW) {
        const int m0 = grp * 16;
        const bf16_t* xrow = xm + (size_t)(m0 + fr) * DM + 16 * fq; unsigned char* hrow = h2 + (size_t)(m0 + fr) * DM + 16 * fq;
        f32x4 acc = (f32x4){0.f, 0.f, 0.f, 0.f}; float ssq = 0.f;
        u32x4 xq[32];
#pragma unroll
        for (int i = 0; i < 16; ++i) { xq[2 * i] = *(const u32x4*)(xrow + 64 * i); xq[2 * i + 1] = *(const u32x4*)(xrow + 64 * i + 8); }
#pragma unroll
        for (int kp = 0; kp < 16; ++kp) {
            asm volatile("" ::: "memory");
            const u32x4 x0 = xq[2 * kp], x1 = xq[2 * kp + 1]; unsigned qq[4];
#pragma unroll
            for (int hh = 0; hh < 2; ++hh) { const u32x4 xv = hh ? x1 : x0; const int k0 = 64 * kp + 16 * fq + 8 * hh;
                f32x4 xa, xb; xa.x = bf2f(xv.x & 0xffffu); xa.y = bf2f(xv.x >> 16); xa.z = bf2f(xv.y & 0xffffu); xa.w = bf2f(xv.y >> 16); xb.x = bf2f(xv.z & 0xffffu); xb.y = bf2f(xv.z >> 16); xb.z = bf2f(xv.w & 0xffffu); xb.w = bf2f(xv.w >> 16);
                const f32x4 ga = *(const f32x4*)(g2 + k0), gb = *(const f32x4*)(g2 + k0 + 4);
                ssq += (xa.x * xa.x + xa.y * xa.y) + (xa.z * xa.z + xa.w * xa.w) + (xb.x * xb.x + xb.y * xb.y) + (xb.z * xb.z + xb.w * xb.w);
                const f32x4 va = xa * ga, vb = xb * gb;
                u32x4 hi, lo;
                hi.x = pk2(va.x, va.y); hi.y = pk2(va.z, va.w); hi.z = pk2(vb.x, vb.y); hi.w = pk2(vb.z, vb.w);
                lo.x = pk2(va.x - bf2f(hi.x & 0xffffu), va.y - bf2f(hi.x >> 16)); lo.y = pk2(va.z - bf2f(hi.y & 0xffffu), va.w - bf2f(hi.y >> 16));
                lo.z = pk2(vb.x - bf2f(hi.z & 0xffffu), vb.y - bf2f(hi.z >> 16)); lo.w = pk2(vb.z - bf2f(hi.w & 0xffffu), vb.w - bf2f(hi.w >> 16));
                const bf16x8 bh = *(const LAS bf16x8*)(WH + fr * P5_PITCH + k0 * 2), bl = *(const LAS bf16x8*)(WL + fr * P5_PITCH + k0 * 2);
                acc = __builtin_amdgcn_mfma_f32_16x16x32_bf16((bf16x8)hi, bh, acc, 0, 0, 0);
                acc = __builtin_amdgcn_mfma_f32_16x16x32_bf16((bf16x8)lo, bh, acc, 0, 0, 0);
                acc = __builtin_amdgcn_mfma_f32_16x16x32_bf16((bf16x8)hi, bl, acc, 0, 0, 0);
                qq[2 * hh] = pk4_fp8(va.x, va.y, va.z, va.w); qq[2 * hh + 1] = pk4_fp8(vb.x, vb.y, vb.z, vb.w); }
            *(u32x4*)(hrow + 64 * kp) = (u32x4){qq[0], qq[1], qq[2], qq[3]};
        }
        ssq += __shfl_xor(ssq, 16); ssq += __shfl_xor(ssq, 32);
        const float rs = 1.0f / sqrtf(ssq * (1.0f / DM) + EPS);
        if (fq == 0) rstd2[m0 + fr] = rs;
        f32x4 sc;
#pragma unroll
        for (int r = 0; r < 4; ++r) { const float l = acc[r] * __shfl(rs, 4 * fq + r);
            float mx = l;
#pragma unroll
            for (int o = 1; o < 16; o <<= 1) mx = fmaxf(mx, __shfl_xor(mx, o));
            const float ex = expf(l - mx); float sm = ex;
#pragma unroll
            for (int o = 1; o < 16; o <<= 1) sm += __shfl_xor(sm, o);
            sc[r] = ex / sm; }
        const int bb = m0 >> 13, s0 = m0 & (SEQ - 1);
        *(f32x4*)(scores + ((size_t)bb * NEXP + fr) * SEQ + s0 + 4 * fq) = sc;
    }
}

__device__ __forceinline__ void p6_topk_item(const Frame& F, KArgs& a, int item) {
    unsigned char* ws = a.ws; const int b = item >> 4, e = item & 15, tid = F.tid;
    const float* sc = (const float*)(ws + WS_SCORES) + (size_t)item * SEQ;
    int* tok = (int*)(ws + WS_TOK) + e * EROWS + b * CAP; float* gate = (float*)(ws + WS_GATE) + e * EROWS + b * CAP; int* inv = (int*)(ws + WS_INV) + (size_t)item * SEQ;
    float* rsl = (float*)(ws + WS_RS) + e * EROWS + b * CAP; const float* rstd2 = (const float*)(ws + WS_RSTD1) + b * SEQ;
    LAS unsigned* hist = (LAS unsigned*)F.lds;
    LAS unsigned* sfx = hist + 256;
    LAS unsigned* bc = hist + 512;
    LAS unsigned* scan = hist + 768;
    unsigned key[16];
    { const u32x4* p = (const u32x4*)(sc + tid * 16);
#pragma unroll
      for (int i = 0; i < 4; ++i) { const u32x4 v = p[i]; key[4 * i] = v.x; key[4 * i + 1] = v.y; key[4 * i + 2] = v.z; key[4 * i + 3] = v.w; } }
    unsigned prefix = 0, need = CAP;
    const int lane = F.lane, wv = F.wave;
    if (tid < 256) hist[tid] = 0u;
    __syncthreads();
#pragma unroll 1
    for (int pass = 0; pass < 4; ++pass) {
        const int shift = 24 - 8 * pass; const unsigned himask = pass == 0 ? 0u : (0xffffffffu << (shift + 8));
#pragma unroll
        for (int i = 0; i < 16; ++i) if ((key[i] & himask) == prefix) __hip_atomic_fetch_add(&hist[(key[i] >> shift) & 255u], 1u, __ATOMIC_RELAXED, __HIP_MEMORY_SCOPE_WORKGROUP);
        __syncthreads();
        unsigned hv = 0u, sv = 0u;
        if (tid < 256) { hv = hist[tid]; hist[tid] = 0u; sv = hv;
#pragma unroll
            for (int d = 1; d < 64; d <<= 1) { const unsigned o = __shfl_down(sv, d); if (lane + d < 64) sv += o; }
            if (lane == 0) sfx[wv] = sv; }
        __syncthreads();
        if (tid < 256) { unsigned ge = sv;
#pragma unroll
            for (int k = 1; k < 4; ++k) if (wv + k < 4) ge += sfx[wv + k];
            const unsigned gt = ge - hv;
            if (ge >= need && gt < need) { bc[0] = prefix | ((unsigned)tid << shift); bc[1] = need - gt; } }
        __syncthreads();
        prefix = bc[0]; need = bc[1];
    }
    const unsigned T = prefix;
    unsigned ngt = 0, neq = 0;
#pragma unroll
    for (int i = 0; i < 16; ++i) { ngt += key[i] > T ? 1u : 0u; neq += key[i] == T ? 1u : 0u; }
    unsigned incl = ngt | (neq << 16);
#pragma unroll
    for (int d = 1; d < 64; d <<= 1) { const unsigned o = __shfl_up(incl, d); if (lane >= d) incl += o; }
    if (lane == 63) scan[wv] = incl;
    __syncthreads();
    unsigned tot = 0u;
#pragma unroll
    for (int k = 0; k < 8; ++k) { const unsigned wt = scan[k]; if (k < wv) incl += wt; tot += wt; }
    const unsigned totgt = tot & 0xffffu;
    unsigned pgt = (incl & 0xffffu) - ngt, peq = (incl >> 16) - neq;
#pragma unroll
    for (int i = 0; i < 16; ++i) { const int s = tid * 16 + i; int slot = -1;
        if (key[i] > T) { slot = (int)pgt; ++pgt; }
        else if (key[i] == T) { if (peq < need) slot = (int)(totgt + peq); ++peq; }
        inv[s] = slot;
        if (slot >= 0) { tok[slot] = b * SEQ + s; gate[slot] = __builtin_bit_cast(float, key[i]); rsl[slot] = rstd2[s]; } }
    __syncthreads();
}

__device__ __forceinline__ void p9_final(const Frame& F, KArgs& a, float* dst) {
    unsigned char* ws = a.ws; const bf16_t* dl = (const bf16_t*)(ws + WS_DELTA); const float* gf = a.in[21]; const unsigned char* eo = (const unsigned char*)(ws + WS_EO); const int* inv = (const int*)(ws + WS_INV);
    const int gw = F.vcu * NWAVES + F.wave, NGW = F.G * NWAVES;
    f32x4 gv[4];
#pragma unroll
    for (int j = 0; j < 4; ++j) gv[j] = ((const f32x4*)gf)[F.lane + 64 * j];
    unsigned long long dn[4]; int slotn = -1;
    { const int m0 = gw < MTOK ? gw : 0; const unsigned long long* dr = (const unsigned long long*)(dl + (size_t)m0 * DM) + F.lane;
#pragma unroll
      for (int j = 0; j < 4; ++j) dn[j] = dr[64 * j];
      if (F.lane < 16) slotn = inv[((size_t)(m0 >> 13) * NEXP + F.lane) * SEQ + (m0 & (SEQ - 1))]; }
    for (int m = gw; m < MTOK; m += NGW) {
        f32x4 v[4]; const int myslot = slotn;
#pragma unroll
        for (int j = 0; j < 4; ++j) { const unsigned lo = (unsigned)dn[j], hi = (unsigned)(dn[j] >> 32); v[j].x = bf2f(lo & 0xffffu); v[j].y = bf2f(lo >> 16); v[j].z = bf2f(hi & 0xffffu); v[j].w = bf2f(hi >> 16); }
        const int bb = m >> 13;
        { const int mn = (m + NGW < MTOK) ? m + NGW : m; const unsigned long long* dr = (const unsigned long long*)(dl + (size_t)mn * DM) + F.lane;
#pragma unroll
          for (int j = 0; j < 4; ++j) dn[j] = dr[64 * j];
          slotn = -1; if (F.lane < 16) slotn = inv[((size_t)(mn >> 13) * NEXP + F.lane) * SEQ + (mn & (SEQ - 1))]; }
#if !DBG_NO_MOE
        unsigned mask = (unsigned)__ballot(myslot >= 0) & 0xffffu;
        while (mask) {
            unsigned q[4][4]; int ne = 0;
#pragma unroll
            for (int t = 0; t < 4; ++t) { if (mask) { const int e = __builtin_ctz(mask); mask &= mask - 1u; const int slot = __builtin_amdgcn_readlane(myslot, e);
                    const unsigned* er = (const unsigned*)(eo + ((size_t)e * EROWS + bb * CAP + slot) * DM) + F.lane;
#pragma unroll
                    for (int j = 0; j < 4; ++j) q[t][j] = er[64 * j];
                    ne = t + 1; } }
#pragma unroll
            for (int t = 0; t < 4; ++t) { if (t < ne) {
#pragma unroll
                    for (int j = 0; j < 4; ++j) { const f32x2 lo = __builtin_amdgcn_cvt_pk_f32_fp8((int)q[t][j], false), hi = __builtin_amdgcn_cvt_pk_f32_fp8((int)q[t][j], true);
                        v[j].x += lo.x * 0.0625f; v[j].y += lo.y * 0.0625f; v[j].z += hi.x * 0.0625f; v[j].w += hi.y * 0.0625f; } } }
        }
#endif
        float s = 0.f;
#pragma unroll
        for (int j = 0; j < 4; ++j) s += (v[j].x * v[j].x + v[j].y * v[j].y) + (v[j].z * v[j].z + v[j].w * v[j].w);
        const float rstd = 1.0f / sqrtf(wave_sum(s) * (1.0f / DM) + EPS);
        f32x4* xw = (f32x4*)(dst + (size_t)m * DM) + F.lane;
#pragma unroll
        for (int j = 0; j < 4; ++j) xw[64 * j] = v[j] * rstd * gv[j];
    }
}

__global__ void __launch_bounds__(NTHREADS, 2) fwd(Args args) {
    extern __shared__ __attribute__((aligned(16))) unsigned char lds_raw[];
    Frame F;
    F.lds = (LAS unsigned char*)lds_raw;
    F.tid = threadIdx.x; F.lane = F.tid & 63; F.wave = __builtin_amdgcn_readfirstlane(F.tid >> 6);
    F.G = gridDim.x; F.bx = blockIdx.x; F.vcu = (F.G % 8 == 0) ? (F.bx % 8) * (F.G / 8) + F.bx / 8 : F.bx;
    volatile LAS unsigned* MISC = (volatile LAS unsigned*)(F.lds + MISC_OFF);
    if (F.tid < 16) MISC[F.tid] = 0u;
    __syncthreads();
    KArgs* kap = (KArgs*)__builtin_amdgcn_kernarg_segment_ptr();
    unsigned char* ws = args.ws;
    unsigned* ctl = (unsigned*)(ws + WS_CTL);
    const int lo = args.ph_lo, hi = args.ph_hi;
    const __amdgpu_buffer_rsrc_t rsrc = __builtin_amdgcn_make_buffer_rsrc((void*)ws, (short)0, (int)0x7fffffff, (int)0x00020000);
#if !N_LAUNCH_PER_PHASE
    XcdBarrier bar = xcd_barrier_post(ctl + 1024, MISC + 8);
#if USE_COOP == 1
    cg::this_grid().sync();
#endif
#define GRID_BAR() xcd_barrier(bar)
#else
#define GRID_BAR() do {} while (0)
#endif
#ifdef ONLY_PHASE
#define IN(k) ((k) == ONLY_PHASE && lo <= (k) && (k) < hi)
#else
#define IN(k) (lo <= (k) && (k) < hi)
#endif
#define REFRESH() int t_ = threadIdx.x; asm volatile("" : "+v"(t_)); F.tid = t_; F.lane = t_ & 63; F.wave = __builtin_amdgcn_readfirstlane(t_ >> 6); KArgs* ap_ = kap; asm volatile("" : "+s"(ap_)); KArgs& A = *ap_
#define REPS(k) for (int rep = (args.rep_phase == (k)) ? args.rep_n : 0; rep >= 0; --rep)
    if (IN(0)) REPS(0) { REFRESH(); p0_prep(F, A); GRID_BAR(); }
    if (IN(1)) REPS(1) { REFRESH();
        pg8::DenseOrder S; S.init(WS_XB, WS_WIN, MTOK, NPROJ, DM, F.G, F.bx);
        pg8::EpiP E{(bf16_t*)A.out, (unsigned)WS_RSTD1};
        pg8::gemm_phase<pg8::EpiP, pg8::DenseOrder, false, false>(F.lds, rsrc, F.tid, DM * 2, S, E);
        GRID_BAR();
    }
    if (IN(2)) REPS(2) { REFRESH();
        for (int r2 = (A.rep_phase == 20) ? A.rep_n : 0; r2 >= 0; --r2)
        for (int si = F.bx; si < 256; si += F.G) lru_super_item<1>(F, A, si);
        for (int r2 = (A.rep_phase == 21) ? A.rep_n : 0; r2 >= 0; --r2)
        for (int it = F.bx; it < 512; it += F.G) fft1_item(F, (const bf16_t*)A.out, (u32x2*)(ws + WS_V), it);
        GRID_BAR();
    }
    if (IN(3)) REPS(3) { REFRESH();
        for (int r2 = (A.rep_phase == 30) ? A.rep_n : 0; r2 >= 0; --r2)
        for (int si = F.bx; si < 256; si += F.G) lru_super_item<2>(F, A, si);
        for (int r2 = (A.rep_phase == 31) ? A.rep_n : 0; r2 >= 0; --r2)
        for (int it = F.bx; it < NB * 16 * 8; it += F.G) { const int cc = it & 7, kk = (it >> 3) & 15, b = it >> 7;
            if (kk == 0) { fft2_item(F, (const u32x2*)(ws + WS_V), (bf16_t*)(ws + WS_A2), b, 0, cc); fft2_item(F, (const u32x2*)(ws + WS_V), (bf16_t*)(ws + WS_A2), b, 16, cc); }
            else fft2_item(F, (const u32x2*)(ws + WS_V), (bf16_t*)(ws + WS_A2), b, kk, cc); }
        GRID_BAR();
    }
    if (IN(4)) REPS(4) { REFRESH();
        pg8::DenseOrder S; S.init(WS_A2, WS_W2, MTOK, DM, KOUT, F.G, F.bx);
        pg8::EpiD E{(bf16_t*)(ws + WS_DELTA), (const bf16_t*)(ws + WS_XB)};
        pg8::gemm_phase<pg8::EpiD, pg8::DenseOrder, false, false>(F.lds, rsrc, F.tid, KOUT * 2, S, E);
        GRID_BAR();
    }
    if (IN(5)) REPS(5) { REFRESH(); p5_router(F, A); GRID_BAR(); }
    if (IN(6)) REPS(6) { REFRESH();
        if (F.G > NB * NEXP) { if (F.bx < NB * NEXP) p6_topk_item(F, A, F.bx); else expert_w_items(F, A, 2, (F.bx - NB * NEXP) * NWAVES + F.wave, (F.G - NB * NEXP) * NWAVES, WD_SPLIT, 8192); }
        else { for (int it = F.bx; it < NB * NEXP; it += F.G) p6_topk_item(F, A, it); expert_w_items(F, A, 2, F.bx * NWAVES + F.wave, F.G * NWAVES, WD_SPLIT, 8192); }
        GRID_BAR(); }
#if !DBG_NO_MOE
    if (IN(7)) REPS(7) { REFRESH();
        pg8::G1Order S{(unsigned)WS_H2, (unsigned)WS_WGU, (const int*)(ws + WS_TOK), F.G, F.bx};
        pg8::EpiH E{(unsigned char*)(ws + WS_H), (unsigned)WS_RS};
        pg8::gemm_phase<pg8::EpiH, pg8::G1Order, true, true>(F.lds, rsrc, F.tid, DM, S, E);
        GRID_BAR();
    }
    if (IN(8)) REPS(8) { REFRESH();
        pg8::G2Order S{(unsigned)WS_H, (unsigned)WS_WD, F.G, F.bx};
        pg8::EpiEo E{(unsigned char*)(ws + WS_EO), (unsigned)WS_GATE};
        pg8::gemm_phase<pg8::EpiEo, pg8::G2Order, false, true>(F.lds, rsrc, F.tid, DFF, S, E);
        GRID_BAR();
    }
#endif
    if (IN(9)) REPS(9) { REFRESH(); p9_final(F, A, rep > 0 ? (float*)(ws + WS_H) : A.out); if (rep > 0) GRID_BAR(); }
#undef IN
}

extern "C" void kernel_launch(void* const* d_in, const int* in_sizes, int n_in, void* d_out, int out_size, void* d_ws, size_t ws_size, hipStream_t stream) {
    static int grid = 0;
    if (grid == 0) {
        if (n_in != 22 || out_size != MTOK * DM || ws_size < WS_END) { fprintf(stderr, "kernel_launch: unexpected problem (n_in %d out %d ws %zu)\n", n_in, out_size, ws_size); grid = -1; return; }
        int dev = 0, cus = 0, per_cu = 0;
        (void)hipGetDevice(&dev);
        (void)hipDeviceGetAttribute(&cus, hipDeviceAttributeMultiprocessorCount, dev);
        (void)hipFuncSetAttribute((const void*)fwd, hipFuncAttributeMaxDynamicSharedMemorySize, LDS_BYTES);
        (void)hipOccupancyMaxActiveBlocksPerMultiprocessor(&per_cu, (const void*)fwd, NTHREADS, LDS_BYTES);
        (void)hipGetLastError();
        if (per_cu < 1) { fprintf(stderr, "kernel_launch: occupancy query says %d workgroups per CU; nothing launched\n", per_cu); grid = -1; return; }
        grid = cus * 1;
    }
    if (grid < 0) return;
    (void)hipMemsetAsync((char*)d_ws + WS_CTL, 0, 65536, stream);
    Args a{};
    for (int i = 0; i < 22; ++i) a.in[i] = (const float*)d_in[i];
    a.out = (float*)d_out; a.ws = (unsigned char*)d_ws; a.rep_phase = REPEAT_PHASE; a.rep_n = REPEAT_N;
#if N_LAUNCH_PER_PHASE
    for (int p = 0; p < 10; ++p) { a.ph_lo = p; a.ph_hi = p + 1; hipLaunchKernelGGL(fwd, dim3(grid), dim3(NTHREADS), LDS_BYTES, stream, a); }
#else
    a.ph_lo = 0; a.ph_hi = 10;
    void* kargs[] = {&a};
#if USE_COOP
    hipError_t e = hipLaunchCooperativeKernel((const void*)fwd, dim3(grid), dim3(NTHREADS), kargs, LDS_BYTES, stream);
    if (e != hipSuccess) fprintf(stderr, "cooperative launch failed: %s (grid %d)\n", hipGetErrorString(e), grid);
#else
    (void)kargs; hipLaunchKernelGGL(fwd, dim3(grid), dim3(NTHREADS), LDS_BYTES, stream, a);
#endif
#endif
}
```

```cpp
#include <hip/hip_runtime.h>
#include <hip/hip_cooperative_groups.h>
#include <cstdio>
#include <cstdint>
namespace cg = cooperative_groups;

#ifndef USE_COOP
#define USE_COOP 2
#endif
#ifndef N_LAUNCH_PER_PHASE
#define N_LAUNCH_PER_PHASE 0
#endif
#ifndef DBG_NO_MOE
#define DBG_NO_MOE 0
#endif

#ifndef REPEAT_PHASE
#define REPEAT_PHASE -1
#endif
#ifndef REPEAT_N
#define REPEAT_N 0
#endif
#define LAS __attribute__((address_space(3)))
typedef unsigned short bf16_t;
typedef short bf16x8 __attribute__((ext_vector_type(8)));
typedef float f32x4 __attribute__((ext_vector_type(4)));
typedef float f32x2 __attribute__((ext_vector_type(2)));
typedef unsigned u32x4 __attribute__((ext_vector_type(4)));
typedef unsigned u32x2 __attribute__((ext_vector_type(2)));
typedef int i32x4 __attribute__((ext_vector_type(4)));
typedef int i32x8 __attribute__((ext_vector_type(8)));

constexpr int NB = 4, SEQ = 8192, DM = 1024, MTOK = NB * SEQ;
constexpr int DLRU = 512, NHEAD = 8, HDIM = 64, NPROJ = 1536, KOUT = 1536;
constexpr int NEXP = 16, CAP = 1024, DFF = 2048, EROWS = NB * CAP;
constexpr float EPS = 1e-6f;
constexpr int NTHREADS = 512, NWAVES = 8;
constexpr int LDS_BYTES = 147456;
constexpr int MISC_OFF = 131072 + 8192;

constexpr size_t KiB = 1024, MiB = 1u << 20;
constexpr size_t WS_CTL = 0;
constexpr size_t WS_RSTD1 = 64 * KiB;
constexpr size_t WS_WGT = 256 * KiB;
constexpr size_t WS_IDX = 512 * KiB;
constexpr size_t WS_GATE = 768 * KiB;
constexpr size_t WS_AGG = 1 * MiB;
constexpr size_t WS_SCORES = 3 * MiB;
constexpr size_t WS_INV = 5 * MiB;
constexpr size_t WS_RS = 7 * MiB;
constexpr size_t WS_TOK = 7 * MiB + 256 * KiB;
constexpr size_t WS_WGU = 8 * MiB;
constexpr size_t WS_EO = 8 * MiB;
constexpr size_t WS_WD = 136 * MiB;
constexpr size_t WS_H = 200 * MiB;
constexpr size_t WS_XB = 436 * MiB;
constexpr size_t WS_V = 200 * MiB;
constexpr size_t WS_A2 = 270 * MiB;
constexpr size_t WS_WIN = 366 * MiB;
constexpr size_t WS_W2 = 369 * MiB;
constexpr size_t WS_DELTA = 372 * MiB;
constexpr size_t WS_H2 = 168 * MiB;
constexpr size_t WS_END = 520 * MiB;

typedef __bf16 bf16x2_t __attribute__((ext_vector_type(2)));
__device__ __forceinline__ unsigned f2bf(float f) { return (unsigned)__builtin_bit_cast(unsigned short, (__bf16)f); }
__device__ __forceinline__ unsigned pk2(float lo, float hi) { bf16x2_t v; v.x = (__bf16)lo; v.y = (__bf16)hi; return __builtin_bit_cast(unsigned, v); }
__device__ __forceinline__ unsigned cvt_pk_bf16(float lo, float hi) { unsigned r; asm volatile("v_cvt_pk_bf16_f32 %0, %1, %2" : "=v"(r) : "v"(lo), "v"(hi)); return r; }
__device__ __forceinline__ float bf2f(unsigned h) { return __builtin_bit_cast(float, h << 16); }
__device__ __forceinline__ float wave_sum(float v) {
#pragma unroll
    for (int o = 1; o < 64; o <<= 1) v += __shfl_xor(v, o);
    return v;
}
__device__ __forceinline__ float fast_sigmoid(float x) { return __builtin_amdgcn_rcpf(1.0f + __builtin_amdgcn_exp2f(-1.4426950408889634f * x)); }
__device__ __forceinline__ unsigned pk4_fp8(float a, float b, float c, float d) { int w = 0; w = __builtin_amdgcn_cvt_pk_fp8_f32(a, b, w, false); w = __builtin_amdgcn_cvt_pk_fp8_f32(c, d, w, true); return (unsigned)w; }
__device__ __forceinline__ float xchg16(float v, int lane) { const unsigned u = __builtin_bit_cast(unsigned, v); const auto r = __builtin_amdgcn_permlane16_swap(u, u, false, false); return __builtin_bit_cast(float, (lane & 16) ? r[0] : r[1]); }
__device__ __forceinline__ float xchg32(float v, int lane) { const unsigned u = __builtin_bit_cast(unsigned, v); const auto r = __builtin_amdgcn_permlane32_swap(u, u, false, false); return __builtin_bit_cast(float, (lane & 32) ? r[0] : r[1]); }
#define LDS_WAIT() asm volatile("s_waitcnt lgkmcnt(0)" ::: "memory")

#define XB_TMO      128
#define XB_XCNT(j)  (256  + 64 * (j))
#define XB_XSUB(j)  (1280 + 64 * (j))
#define XB_XGEN(j)  (2304 + 64 * (j))
#define XB_TOP      3328
#define XB_TOPGEN   3392
#define XCD_BAR_WORDS 3456
#define XB_SPIN_CAP (1u << 20)
__device__ __forceinline__ unsigned xb_ld(unsigned* p)              { return __hip_atomic_load(p, __ATOMIC_RELAXED, __HIP_MEMORY_SCOPE_AGENT); }
__device__ __forceinline__ unsigned xb_add(unsigned* p, unsigned v) { return __hip_atomic_fetch_add(p, v, __ATOMIC_RELAXED, __HIP_MEMORY_SCOPE_AGENT); }
__device__ __forceinline__ unsigned xb_xcc_id() { return (unsigned)__builtin_amdgcn_s_getreg((3 << 11) | 20) & 0xFu; }
#define XB_SPIN(cond, bar) do { unsigned _sp = 0; while (cond) { __builtin_amdgcn_s_sleep(1); \
    if ((++_sp & 255u) == 0u) { if (xb_ld(&(bar)[XB_TMO])) break; if (_sp > XB_SPIN_CAP) { atomicAdd(&(bar)[XB_TMO], 1u); break; } } } } while (0)
struct XcdBarrier { unsigned* bar; unsigned x; volatile LAS unsigned* st; };
__device__ __forceinline__ XcdBarrier xcd_barrier_post(unsigned* bar, volatile LAS unsigned* st) {
    XcdBarrier b; b.bar = bar; b.x = xb_xcc_id(); b.st = st;
    if (threadIdx.x == 0) (void)xb_add(&bar[XB_XCNT(b.x)], 1u);
    return b;
}
__device__ __forceinline__ void xcd_barrier_complete(unsigned* bar, unsigned x, unsigned& nloc, unsigned& nx) {
    const unsigned G = gridDim.x * gridDim.y * gridDim.z;
    unsigned sum, cnt, mine, sp = 0u;
    for (;;) {
        sum = 0u; cnt = 0u; mine = 0u;
#pragma unroll
        for (unsigned j = 0; j < 16; ++j) { const unsigned c = xb_ld(&bar[XB_XCNT(j)]); sum += c; cnt += (c > 0u) ? 1u : 0u; mine = (j == x) ? c : mine; }
        if (sum == G) break;
        __builtin_amdgcn_s_sleep(1);
        if ((++sp & 255u) == 0u) { if (xb_ld(&bar[XB_TMO])) break; if (sp > XB_SPIN_CAP) { atomicAdd(&bar[XB_TMO], 1u); break; } }
    }
    nloc = mine > 0u ? mine : 1u; nx = cnt > 0u ? cnt : 1u;
}
__device__ __forceinline__ void xcd_barrier(const XcdBarrier& b) {
    asm volatile("s_waitcnt vmcnt(0)" ::: "memory");
    __syncthreads();
    if (threadIdx.x == 0) {
        unsigned* bar = b.bar;
        __builtin_amdgcn_s_waitcnt(0);
        unsigned nloc = b.st[0], nx = b.st[1];
        if (nloc == 0u) { xcd_barrier_complete(bar, b.x, nloc, nx); b.st[0] = nloc; b.st[1] = nx; }
        const unsigned old = xb_add(&bar[XB_XSUB(b.x)], 1u);
        const unsigned gen = old / nloc;
        if (old + 1u == (gen + 1u) * nloc) {
            __builtin_amdgcn_fence(__ATOMIC_RELEASE, "agent");
            asm volatile("s_waitcnt vmcnt(0)" ::: "memory");
            const unsigned og = xb_add(&bar[XB_TOP], 1u);
            const unsigned tg = og / nx;
            if (og + 1u == (tg + 1u) * nx) xb_add(&bar[XB_TOPGEN], 1u);
            else XB_SPIN(xb_ld(&bar[XB_TOPGEN]) == tg, bar);
            __builtin_amdgcn_fence(__ATOMIC_ACQUIRE, "agent");
            xb_add(&bar[XB_XGEN(b.x)], 1u);
            asm volatile("s_waitcnt vmcnt(0)" ::: "memory");
        } else {
            XB_SPIN(xb_ld(&bar[XB_XGEN(b.x)]) == gen, bar);
            __builtin_amdgcn_fence(__ATOMIC_ACQUIRE, "agent");
            asm volatile("s_waitcnt vmcnt(0)" ::: "memory");
        }
    }
    __syncthreads();
}

namespace pg8 {
constexpr int BM = 256, BK = 64, HALF = 128, HTB = HALF * BK * 2, STAGE_BYTES = 8 * HTB, NXCD = 8, WGM = 8;
__host__ __device__ __forceinline__ int lds_byte(int r, int c) { return r * 128 + ((((c >> 3) ^ (r >> 1)) & 7) << 4) + (c & 7) * 2; }
__host__ __device__ __forceinline__ void stage_rc(int b, int& R, int& C) { R = b >> 7; C = ((((b >> 4) ^ (R >> 1)) & 7) << 3); }
__host__ __device__ __forceinline__ int perm32(int rho) { const int n = rho >> 4, i = rho & 15; return 8 * (i >> 2) + 4 * n + (i & 3); }

struct Unit { unsigned a, b; int row0, col0; };

struct DenseOrder {
    unsigned A, Bt; int K, nM, nN, nwg, G, c;
    __device__ void init(size_t A_, size_t Bt_, int M, int N, int K_, int G_, int c_) { A = (unsigned)A_; Bt = (unsigned)Bt_; K = K_; nM = M / BM; nN = N / BM; nwg = nM * nN; G = G_; c = c_; }
    __device__ bool next(int i, Unit& u) const {
        const long L = (long)i * G + c; if (L >= nwg) return false;
        int wgid = (int)L; { const int q = nwg / NXCD, r = nwg % NXCD, xcd = wgid % NXCD, off = wgid / NXCD; wgid = (xcd < r ? xcd * (q + 1) : r * (q + 1) + (xcd - r) * q) + off; }
        const int nig = WGM * nN, gid = wgid / nig, fm = gid * WGM, gsz = (nM - fm) < WGM ? (nM - fm) : WGM;
        const int pm = fm + ((wgid % nig) % gsz), pn = (wgid % nig) / gsz;
        u.a = A + (unsigned)(pm * BM * K * 2); u.b = Bt + (unsigned)(pn * BM * K * 2); u.row0 = pm * BM; u.col0 = pn * BM; return true;
    }
    __device__ __forceinline__ int arow(const Unit&, int) const { return 0; }
    __device__ __forceinline__ unsigned tokoff() const { return 0u; }
};
struct G1Order {
    unsigned h2, wgu; const int* tok; int G, c;
    __device__ bool next(int i, Unit& u) const {
        const long L = (long)i * G + c; if (L >= 4096) return false;
        const int e = (int)(L >> 8), w = (int)(L & 255), xcd = w & 7, l = w >> 3;
        const int pm = 4 * (xcd & 3) + (l & 3), pn = 8 * (xcd >> 2) + (l >> 2);
        u.a = h2; u.b = wgu + (unsigned)((e * 4096 + pn * 256) * DM); u.row0 = e * EROWS + pm * 256; u.col0 = pn * 128; return true;
    }
    __device__ __forceinline__ int arow(const Unit& u, int r) const { return tok[u.row0 + r]; }
    __device__ __forceinline__ unsigned tokoff() const { return (unsigned)WS_TOK; }
};
struct G2Order {
    unsigned H, wd; int G, c;
    __device__ bool next(int i, Unit& u) const {
        const long L = (long)i * G + c; if (L >= 1024) return false;
        const int r4 = (int)(L >> 8), w = (int)(L & 255), xcd = w & 7, l = w >> 3;
        const int e = 4 * r4 + (xcd >> 1), pm = 8 * (xcd & 1) + (l & 7), pn = l >> 3;
        u.a = H + (unsigned)((e * EROWS + pm * 256) * DFF); u.b = wd + (unsigned)((e * DM + pn * 256) * DFF); u.row0 = e * EROWS + pm * 256; u.col0 = pn * 256; return true;
    }
    __device__ __forceinline__ int arow(const Unit&, int) const { return 0; }
    __device__ __forceinline__ unsigned tokoff() const { return 0u; }
};

struct EpiP {
    static constexpr bool PERM = true, HAS_SCALE = true;
    bf16_t* P; unsigned soff;
    __device__ __forceinline__ unsigned scale_off() const { return soff; }
    __device__ __forceinline__ void operator()(const f32x4 (&acc)[2][2][4][2], const Unit& u, int wr, int wc, int fr, int fq, const LAS float* scl) const {
        const int row0 = u.row0 + wr * 64 + fr, col0 = u.col0 + wc * 32 + 8 * fq;
#pragma unroll
        for (int ai = 0; ai < 2; ++ai)
#pragma unroll
            for (int m = 0; m < 4; ++m) { const int r = row0 + ai * HALF + m * 16; const float rs = scl[wr * 64 + fr + ai * HALF + m * 16]; bf16_t* rowp = P + (size_t)r * NPROJ + col0;
#pragma unroll
                for (int bj = 0; bj < 2; ++bj) { const f32x4 v0 = acc[ai][bj][m][0] * rs, v1 = acc[ai][bj][m][1] * rs;
                    u32x4 w; w.x = cvt_pk_bf16(v0[0], v0[1]); w.y = cvt_pk_bf16(v0[2], v0[3]); w.z = cvt_pk_bf16(v1[0], v1[1]); w.w = cvt_pk_bf16(v1[2], v1[3]);
                    *(u32x4*)(rowp + bj * HALF) = w; } }
    }
};
struct EpiD {
    static constexpr bool PERM = true, HAS_SCALE = false;
    bf16_t* O; const bf16_t* XB;
    __device__ __forceinline__ unsigned scale_off() const { return 0u; }
    __device__ __forceinline__ void operator()(const f32x4 (&acc)[2][2][4][2], const Unit& u, int wr, int wc, int fr, int fq, const LAS float*) const {
        const int row0 = u.row0 + wr * 64 + fr, col0 = u.col0 + wc * 32 + 8 * fq;
#pragma unroll
        for (int ai = 0; ai < 2; ++ai) { u32x4 xv[4][2];
#pragma unroll
            for (int m = 0; m < 4; ++m)
#pragma unroll
                for (int bj = 0; bj < 2; ++bj) xv[m][bj] = *(const u32x4*)(XB + (size_t)(row0 + ai * HALF + m * 16) * DM + col0 + bj * HALF);
#pragma unroll
            for (int m = 0; m < 4; ++m) { bf16_t* rowp = O + (size_t)(row0 + ai * HALF + m * 16) * DM + col0;
#pragma unroll
                for (int bj = 0; bj < 2; ++bj) { const f32x4 v0 = acc[ai][bj][m][0], v1 = acc[ai][bj][m][1]; const u32x4 x = xv[m][bj];
                    u32x4 w; w.x = cvt_pk_bf16(v0[0] + bf2f(x.x & 0xffffu), v0[1] + bf2f(x.x >> 16)); w.y = cvt_pk_bf16(v0[2] + bf2f(x.y & 0xffffu), v0[3] + bf2f(x.y >> 16));
                    w.z = cvt_pk_bf16(v1[0] + bf2f(x.z & 0xffffu), v1[1] + bf2f(x.z >> 16)); w.w = cvt_pk_bf16(v1[2] + bf2f(x.w & 0xffffu), v1[3] + bf2f(x.w >> 16));
                    *(u32x4*)(rowp + bj * HALF) = w; } } }
    }
};
struct EpiH {
    static constexpr bool PERM = true, HAS_SCALE = true;
    unsigned char* Hh; unsigned soff;
    __device__ __forceinline__ unsigned scale_off() const { return soff; }
    __device__ __forceinline__ void operator()(const f32x4 (&acc)[2][2][4][2], const Unit& u, int wr, int wc, int fr, int fq, const LAS float* scl) const {
        const int row0 = u.row0 + wr * 64 + fr, col0 = u.col0 + wc * 32 + 8 * fq;
#pragma unroll
        for (int ai = 0; ai < 2; ++ai)
#pragma unroll
            for (int m = 0; m < 4; ++m) { const int r = row0 + ai * HALF + m * 16; unsigned char* rowp = Hh + (size_t)r * DFF + col0; const float rsc = scl[wr * 64 + fr + ai * HALF + m * 16] * 0.03125f;
                float h[8]; const float ke = -1.4426950408889634f * rsc, k2 = rsc * rsc;
#pragma unroll
                for (int n = 0; n < 2; ++n)
#pragma unroll
                    for (int jp = 0; jp < 2; ++jp) { const f32x2 ag = (f32x2){acc[ai][0][m][n][2 * jp], acc[ai][0][m][n][2 * jp + 1]}, au = (f32x2){acc[ai][1][m][n][2 * jp], acc[ai][1][m][n][2 * jp + 1]};
                        const f32x2 ex = ag * ke; f32x2 d; d.x = __builtin_amdgcn_exp2f(ex.x); d.y = __builtin_amdgcn_exp2f(ex.y); d = d + 1.0f;
                        f32x2 rc; rc.x = __builtin_amdgcn_rcpf(d.x); rc.y = __builtin_amdgcn_rcpf(d.y);
                        const f32x2 hv = (ag * au) * k2 * rc; h[n * 4 + 2 * jp] = hv.x; h[n * 4 + 2 * jp + 1] = hv.y; }
                u32x2 w; w.x = pk4_fp8(h[0], h[1], h[2], h[3]); w.y = pk4_fp8(h[4], h[5], h[6], h[7]);
                *(u32x2*)rowp = w; }
    }
};
struct EpiEo {
    static constexpr bool PERM = true, HAS_SCALE = true;
    unsigned char* O; unsigned soff;
    __device__ __forceinline__ unsigned scale_off() const { return soff; }
    __device__ __forceinline__ void operator()(const f32x4 (&acc)[2][2][4][2], const Unit& u, int wr, int wc, int fr, int fq, const LAS float* scl) const {
        const int row0 = u.row0 + wr * 64 + fr, col0 = u.col0 + wc * 32 + 8 * fq;
#pragma unroll
        for (int ai = 0; ai < 2; ++ai)
#pragma unroll
            for (int m = 0; m < 4; ++m) { const int r = row0 + ai * HALF + m * 16; const float gs = scl[wr * 64 + fr + ai * HALF + m * 16] * 0.5f; unsigned char* rowp = O + (size_t)r * DM + col0;
#pragma unroll
                for (int bj = 0; bj < 2; ++bj) { const f32x4 v0 = acc[ai][bj][m][0] * gs, v1 = acc[ai][bj][m][1] * gs;
                    u32x2 w; w.x = pk4_fp8(v0[0], v0[1], v0[2], v0[3]); w.y = pk4_fp8(v1[0], v1[1], v1[2], v1[3]);
                    *(u32x2*)(rowp + bj * HALF) = w; } }
    }
};

template <class Epi, class Sched, bool GATHER, bool FP8>
__device__ __forceinline__ void gemm_phase(LAS unsigned char* lds, const __amdgpu_buffer_rsrc_t rs, const int tid, const int KB, const Sched& S, const Epi& E) {
    const int wid = __builtin_amdgcn_readfirstlane(tid >> 6), lane = tid & 63, wr = wid >> 2, wc = wid & 3, fr = lane & 15, fq = lane >> 4;
    const int nt = KB / 128;
    int RA[2], CA[2];
    unsigned voffA[2][2], voffB[2];
#pragma unroll
    for (int i = 0; i < 2; ++i) { int R, C; stage_rc(tid * 16 + i * 8192, R, C); const int Rb = Epi::PERM ? ((R & ~31) + perm32(R & 31)) : R;
        RA[i] = R; CA[i] = C; voffB[i] = (unsigned)(Rb * KB + C * 2); }
    const unsigned kstep = 128u;
    const unsigned hstep = (unsigned)(HALF * KB);
    const unsigned ldsw = (unsigned)wid * 1024u;
    const int aoff = lds_byte(wr * 64 + fr, fq * 8), boff = lds_byte(wc * 32 + fr, fq * 8);
    const int aoff1 = lds_byte(wr * 64 + fr, 32 + fq * 8), boff1 = lds_byte(wc * 32 + fr, 32 + fq * 8);
#define PG8_SA(b, h) (((b) * 2 + (h)) * HTB)
#define PG8_SB(b, h) ((4 + (b) * 2 + (h)) * HTB)
#define PG8_STAGE(bufoff, gbase, voff) do { _Pragma("unroll") for (int _i = 0; _i < 2; ++_i) \
        __builtin_amdgcn_raw_ptr_buffer_load_lds(rs, (LAS void*)(lds + (bufoff) + ldsw + _i * 8192), 16, (int)(voff)[_i], (int)(gbase), 0, 0); } while (0)
#define PG8_STAGE_A(bufoff, gbase, h) do { if constexpr (GATHER) { PG8_STAGE(bufoff, gbase, voffA[h]); } else { PG8_STAGE(bufoff, (gbase) + (h) * hstep, voffA[0]); } } while (0)
#define PG8_LDA(dst, b, h) do { _Pragma("unroll") for (int m = 0; m < 4; ++m) { const i32x4 _lo = *(const LAS i32x4*)(lds + PG8_SA(b, h) + aoff + m * 2048), _hi = *(const LAS i32x4*)(lds + PG8_SA(b, h) + aoff1 + m * 2048); \
        dst[m] = __builtin_shufflevector(_lo, _hi, 0, 1, 2, 3, 4, 5, 6, 7); } } while (0)
#define PG8_LDB(dst, b, h) do { _Pragma("unroll") for (int n = 0; n < 2; ++n) { const i32x4 _lo = *(const LAS i32x4*)(lds + PG8_SB(b, h) + boff + n * 2048), _hi = *(const LAS i32x4*)(lds + PG8_SB(b, h) + boff1 + n * 2048); \
        dst[n] = __builtin_shufflevector(_lo, _hi, 0, 1, 2, 3, 4, 5, 6, 7); } } while (0)
#define PG8_MMA(ai, bj, At, Bt) do { __builtin_amdgcn_s_setprio(1); _Pragma("unroll") for (int m = 0; m < 4; ++m) _Pragma("unroll") for (int n = 0; n < 2; ++n) { \
        if constexpr (FP8) asm volatile("v_mfma_scale_f32_16x16x128_f8f6f4 %0, %1, %2, %0, %3, %3 op_sel_hi:[0,0,0]" : "+v"(acc[ai][bj][m][n]) : "v"(Bt[n]), "v"(At[m]), "v"(sc1)); \
        else { acc[ai][bj][m][n] = __builtin_amdgcn_mfma_f32_16x16x32_bf16((bf16x8)__builtin_shufflevector(Bt[n], Bt[n], 0, 1, 2, 3), (bf16x8)__builtin_shufflevector(At[m], At[m], 0, 1, 2, 3), acc[ai][bj][m][n], 0, 0, 0); \
               acc[ai][bj][m][n] = __builtin_amdgcn_mfma_f32_16x16x32_bf16((bf16x8)__builtin_shufflevector(Bt[n], Bt[n], 4, 5, 6, 7), (bf16x8)__builtin_shufflevector(At[m], At[m], 4, 5, 6, 7), acc[ai][bj][m][n], 0, 0, 0); } } \
        __builtin_amdgcn_s_setprio(0); } while (0)
#define PG8_WAIT_V(n) asm volatile("s_waitcnt vmcnt(" #n ")" ::: "memory")
#define PG8_WAIT_L(n) asm volatile("s_waitcnt lgkmcnt(" #n ")" ::: "memory")
#define PG8_BAR __builtin_amdgcn_s_barrier()
#define PG8_SCHED __builtin_amdgcn_sched_barrier(0)
#define PG8_SETVOFF(dst, unit) do { _Pragma("unroll") for (int _h = 0; _h < 2; ++_h) _Pragma("unroll") for (int _i = 0; _i < 2; ++_i) { \
        if constexpr (GATHER) dst[_h][_i] = (unsigned)(S.arow(unit, _h * HALF + RA[_i]) * KB + CA[_i] * 2); \
        else dst[_h][_i] = (unsigned)(RA[_i] * KB + CA[_i] * 2); } } while (0)
    Unit cur, nxt; int ui = 0;
    if (!S.next(0, cur)) return;
    int sc1 = 0x7f7f7f7f; asm volatile("" : "+v"(sc1));
    f32x4 acc[2][2][4][2];
#pragma unroll
    for (int a = 0; a < 2; ++a)
#pragma unroll
        for (int b = 0; b < 2; ++b)
#pragma unroll
            for (int m = 0; m < 4; ++m)
#pragma unroll
                for (int n = 0; n < 2; ++n) acc[a][b][m][n] = (f32x4){0.f, 0.f, 0.f, 0.f};
    i32x8 At[4], B0[2], B1[2];
    unsigned cA = cur.a, cB = cur.b;
    PG8_SETVOFF(voffA, cur);
    PG8_STAGE(PG8_SB(0, 0), cB, voffB); PG8_STAGE(PG8_SB(0, 1), cB + hstep, voffB); PG8_STAGE_A(PG8_SA(0, 0), cA, 0); PG8_STAGE_A(PG8_SA(0, 1), cA, 1);
    if (wr == 1) PG8_BAR;
    PG8_WAIT_V(2); PG8_BAR;
    PG8_STAGE(PG8_SB(1, 0), cB + kstep, voffB); PG8_STAGE_A(PG8_SA(1, 0), cA + kstep, 0); PG8_STAGE(PG8_SB(1, 1), cB + hstep + kstep, voffB);
    PG8_WAIT_V(6); PG8_BAR;
    for (;;) {
        const bool has_next = S.next(ui + 1, nxt);
        const unsigned nA = has_next ? nxt.a : cA, nB = has_next ? nxt.b : cB;
#pragma clang loop unroll(disable)
        for (int t = 0; t < nt; t += 2) {
            const bool last = (t == nt - 2);
            const unsigned a1 = cA + (unsigned)(t + 1) * kstep;
            const unsigned a2 = last ? nA : cA + (unsigned)(t + 2) * kstep, b2 = last ? nB : cB + (unsigned)(t + 2) * kstep;
            const unsigned a3 = a2 + kstep, b3 = b2 + kstep;
            unsigned nvoff[2][2];
            if constexpr (Epi::HAS_SCALE) { if (t == 0)
                    __builtin_amdgcn_raw_ptr_buffer_load_lds(rs, (LAS void*)(lds + 133120 + (ui & 1) * 2048 + (wid >> 2) * 1024 + (wid & 3) * 256), 4, (int)(lane * 4), (int)(E.scale_off() + (unsigned)(cur.row0 + (wid & 3) * 64) * 4u), 0, 0); }
            if constexpr (GATHER) {
                if (t == 0 && has_next)
                    __builtin_amdgcn_raw_ptr_buffer_load_lds(rs, (LAS void*)(lds + 131072 + (wid >> 2) * 1024 + (wid & 3) * 256), 4, (int)(lane * 4), (int)(S.tokoff() + (unsigned)(nxt.row0 + (wid & 3) * 64) * 4u), 0, 0);
                if (last && has_next) {
#pragma unroll
                    for (int _h = 0; _h < 2; ++_h)
#pragma unroll
                        for (int _i = 0; _i < 2; ++_i) nvoff[_h][_i] = (unsigned)(*(const LAS int*)(lds + 131072 + (_h * HALF + RA[_i]) * 4) * KB + CA[_i] * 2); } }
            PG8_LDB(B0, 0, 0); PG8_LDB(B1, 0, 1); PG8_SCHED; PG8_LDA(At, 0, 0); PG8_STAGE_A(PG8_SA(1, 1), a1, 1);
            PG8_WAIT_V(8); PG8_WAIT_L(0); PG8_BAR; PG8_MMA(0, 0, At, B0); PG8_MMA(0, 1, At, B1); PG8_BAR; PG8_SCHED;
            if constexpr (GATHER) { if (last && has_next) {
#pragma unroll
                for (int _h = 0; _h < 2; ++_h)
#pragma unroll
                    for (int _i = 0; _i < 2; ++_i) voffA[_h][_i] = nvoff[_h][_i]; } }
            PG8_LDA(At, 0, 1); PG8_STAGE(PG8_SB(0, 0), b2, voffB); PG8_STAGE(PG8_SB(0, 1), b2 + hstep, voffB);
            PG8_WAIT_V(6); PG8_WAIT_L(0); PG8_BAR; PG8_MMA(1, 0, At, B0); PG8_SCHED; PG8_STAGE_A(PG8_SA(0, 0), a2, 0); PG8_SCHED; PG8_MMA(1, 1, At, B1); PG8_BAR; PG8_SCHED;
            PG8_LDB(B0, 1, 0); PG8_LDB(B1, 1, 1); PG8_SCHED; PG8_LDA(At, 1, 0); PG8_STAGE_A(PG8_SA(0, 1), a2, 1);
            PG8_WAIT_V(8); PG8_WAIT_L(0); PG8_BAR; PG8_MMA(0, 0, At, B0); PG8_MMA(0, 1, At, B1); PG8_BAR; PG8_SCHED;
            PG8_LDA(At, 1, 1); PG8_STAGE(PG8_SB(1, 0), b3, voffB); PG8_STAGE(PG8_SB(1, 1), b3 + hstep, voffB);
            PG8_WAIT_V(6); PG8_WAIT_L(0); PG8_BAR; PG8_MMA(1, 0, At, B0); PG8_SCHED; PG8_STAGE_A(PG8_SA(1, 0), a3, 0); PG8_SCHED; PG8_MMA(1, 1, At, B1); PG8_BAR; PG8_SCHED;
        }
        if (wr == 0) PG8_BAR;
        if constexpr (FP8) asm volatile("s_nop 15\n\ts_nop 15" ::: "memory");
        E(acc, cur, wr, wc, fr, fq, (const LAS float*)(lds + 133120 + (ui & 1) * 2048));
        if (!has_next) break;
#pragma unroll
        for (int a = 0; a < 2; ++a)
#pragma unroll
            for (int b = 0; b < 2; ++b)
#pragma unroll
                for (int m = 0; m < 4; ++m)
#pragma unroll
                    for (int n = 0; n < 2; ++n) acc[a][b][m][n] = (f32x4){0.f, 0.f, 0.f, 0.f};
        cur = nxt; cA = nA; cB = nB; ++ui;
        if (wr == 1) PG8_BAR;
    }
    PG8_WAIT_V(0);
    PG8_BAR;
#undef PG8_SA
#undef PG8_SB
#undef PG8_STAGE
#undef PG8_STAGE_A
#undef PG8_LDA
#undef PG8_LDB
#undef PG8_MMA
#undef PG8_WAIT_V
#undef PG8_WAIT_L
#undef PG8_BAR
#undef PG8_SCHED
#undef PG8_SETVOFF
}
}

struct Args { const float* in[22]; float* out; unsigned char* ws; int ph_lo, ph_hi, rep_phase, rep_n; };
typedef const __attribute__((address_space(4))) Args KArgs;
struct Frame {
    LAS unsigned char* lds;
    int tid, lane, wave, G, bx, vcu;
};

__device__ __forceinline__ void transpose_item(const float* W, int N, int k0, int n0, bf16_t* WT, int ldk, int drow0, const float* kscale, LAS float* scr, int lane) {
#pragma unroll 8
    for (int i = 0; i < 32; ++i) { const int kk = 2 * i + (lane >> 5); float v = W[(size_t)(k0 + kk) * N + n0 + (lane & 31)]; if (kscale) v *= kscale[k0 + kk]; scr[kk * 33 + (lane & 31)] = v; }
    LDS_WAIT(); asm volatile("" ::: "memory");
    const int c = lane & 7;
#pragma unroll
    for (int j = 0; j < 4; ++j) { const int n = (lane >> 3) + 8 * j; const LAS float* s = scr + (8 * c) * 33 + n;
        u32x4 o; o.x = pk2(s[0 * 33], s[1 * 33]); o.y = pk2(s[2 * 33], s[3 * 33]); o.z = pk2(s[4 * 33], s[5 * 33]); o.w = pk2(s[6 * 33], s[7 * 33]);
        *(u32x4*)(WT + (size_t)(drow0 + n) * ldk + k0 + 8 * c) = o; }
    LDS_WAIT(); asm volatile("" ::: "memory");
}
struct WItem { const float* src; unsigned char* dst; int N, ldk; };
__device__ __forceinline__ WItem w_item(KArgs& a, int which, int r, int lane) {
    unsigned char* ws = a.ws; WItem it; const int e = r >> 9, q = r & 511; const int kq = lane >> 4, n4 = (lane & 15) * 4;
    if (which < 2) { const int kb = q >> 5, nb = q & 31, n0 = nb * 64; it.N = DFF; it.ldk = DM;
        it.src = a.in[18 + which] + (size_t)e * DM * DFF + (size_t)(kb * 64 + kq) * DFF + n0 + n4;
        it.dst = (unsigned char*)(ws + WS_WGU) + (size_t)e * 4096 * DM + (size_t)((n0 >> 7) * 256 + which * 128 + (n0 & 127)) * DM + kb * 64; }
    else { const int kb = q >> 4, nb = q & 15; it.N = DM; it.ldk = DFF;
        it.src = a.in[20] + (size_t)e * DFF * DM + (size_t)(kb * 64 + kq) * DM + nb * 64 + n4;
        it.dst = (unsigned char*)(ws + WS_WD) + (size_t)e * DM * DFF + (size_t)(nb * 64) * DFF + kb * 64; }
    return it;
}
__device__ __forceinline__ void w_load(const WItem& it, f32x4 (&v)[16]) {
#pragma unroll
    for (int i = 0; i < 16; ++i) v[i] = *(const f32x4*)(it.src + (size_t)(4 * i) * it.N);
}
__device__ __forceinline__ void w_finish(const WItem& it, const f32x4 (&v)[16], LAS float* scr, int lane) {
    const int kq = lane >> 4, n4 = (lane & 15) * 4;
#pragma unroll
    for (int i = 0; i < 16; ++i) { const int kk = kq + 4 * i; *(LAS f32x4*)(scr + kk * 68 + ((n4 + 8 * (kk >> 4)) & 63)) = v[i] * 32.0f; }
    LDS_WAIT(); asm volatile("" ::: "memory");
    const int nl = lane >> 2, j = lane & 3;
#pragma unroll
    for (int p = 0; p < 4; ++p) { const int n = 16 * p + nl; const LAS float* sp = scr + (16 * j) * 68 + ((n + 8 * j) & 63);
        u32x4 o; o.x = pk4_fp8(sp[0 * 68], sp[1 * 68], sp[2 * 68], sp[3 * 68]); o.y = pk4_fp8(sp[4 * 68], sp[5 * 68], sp[6 * 68], sp[7 * 68]);
        o.z = pk4_fp8(sp[8 * 68], sp[9 * 68], sp[10 * 68], sp[11 * 68]); o.w = pk4_fp8(sp[12 * 68], sp[13 * 68], sp[14 * 68], sp[15 * 68]);
        *(u32x4*)(it.dst + (size_t)n * it.ldk + 16 * j) = o; }
    LDS_WAIT(); asm volatile("" ::: "memory");
}
constexpr int WD_SPLIT = 6144;
__device__ __forceinline__ void expert_w_items(const Frame& F, KArgs& a, int which, int gwi, int ngw, int r_lo = 0, int r_hi = 8192) {
    LAS float* scr = (LAS float*)(F.lds + F.wave * 17408);
    for (int r = r_lo + gwi; r < r_hi; r += ngw) { const WItem it = w_item(a, which, r, F.lane); f32x4 v[16]; w_load(it, v); w_finish(it, v, scr, F.lane); }
}
__device__ __forceinline__ void p0_prep(const Frame& F, KArgs& a) {
    unsigned char* ws = a.ws;
    LAS float* scr = (LAS float*)(F.lds + F.wave * 17408);
    const int gw = F.vcu * NWAVES + F.wave, NGW = F.G * NWAVES;
    for (int r0 = (a.rep_phase == 100) ? a.rep_n : 0; r0 >= 0; --r0) { const float* x = a.in[0]; bf16_t* xb = (bf16_t*)(ws + WS_XB); float* rstd = (float*)(ws + WS_RSTD1);
      for (int m = gw; m < MTOK; m += 2 * NGW) {
          const int m2 = m + NGW;
          const f32x4* xr = (const f32x4*)(x + (size_t)m * DM) + F.lane; const f32x4* xr2 = (const f32x4*)(x + (size_t)(m2 < MTOK ? m2 : m) * DM) + F.lane; f32x4 v[4], v2[4]; float s = 0.f, s2 = 0.f;
#pragma unroll
          for (int j = 0; j < 4; ++j) { v[j] = xr[64 * j]; v2[j] = xr2[64 * j]; }
#pragma unroll
          for (int j = 0; j < 4; ++j) { s += (v[j].x * v[j].x + v[j].y * v[j].y) + (v[j].z * v[j].z + v[j].w * v[j].w); s2 += (v2[j].x * v2[j].x + v2[j].y * v2[j].y) + (v2[j].z * v2[j].z + v2[j].w * v2[j].w); }
          s = wave_sum(s); s2 = wave_sum(s2);
          if (F.lane == 0) { rstd[m] = 1.0f / sqrtf(s * (1.0f / DM) + EPS); if (m2 < MTOK) rstd[m2] = 1.0f / sqrtf(s2 * (1.0f / DM) + EPS); }
          unsigned long long* o8 = (unsigned long long*)(xb + (size_t)m * DM) + F.lane;
#pragma unroll
          for (int j = 0; j < 4; ++j) o8[64 * j] = (unsigned long long)pk2(v[j].x, v[j].y) | ((unsigned long long)pk2(v[j].z, v[j].w) << 32);
          if (m2 < MTOK) { unsigned long long* o82 = (unsigned long long*)(xb + (size_t)m2 * DM) + F.lane;
#pragma unroll
              for (int j = 0; j < 4; ++j) o82[64 * j] = (unsigned long long)pk2(v2[j].x, v2[j].y) | ((unsigned long long)pk2(v2[j].z, v2[j].w) << 32); }
      } }
    for (int r0 = (a.rep_phase == 101) ? a.rep_n : 0; r0 >= 0; --r0) { constexpr int I_WIN = 16 * 48, I_WOUT = 8 * 32;
      bf16_t* WinT = (bf16_t*)(ws + WS_WIN); bf16_t* W2T = (bf16_t*)(ws + WS_W2);
      for (int it = gw; it < I_WIN + I_WOUT; it += NGW) {
          int r = it;
          if (r < I_WIN) { const int kb = r / 48, nb = r % 48; transpose_item(a.in[2], NPROJ, kb * 64, nb * 32, WinT, DM, nb * 32, a.in[1], scr, F.lane); continue; } r -= I_WIN;
          { const int kb = r / 32, nb = r % 32; transpose_item(a.in[15], DM, kb * 64, nb * 32, W2T, KOUT, nb * 32, nullptr, scr, F.lane); }
      } }
    for (int r0 = (a.rep_phase == 102) ? a.rep_n : 0; r0 >= 0; --r0) { expert_w_items(F, a, 0, gw, NGW); expert_w_items(F, a, 1, gw, NGW); expert_w_items(F, a, 2, gw, NGW, 0, WD_SPLIT); }
    { LAS float* ctab = (LAS float*)(F.lds);
      __syncthreads();
      if (F.tid < 128) ctab[F.tid] = cospif((float)F.tid * (1.0f / 64.0f));
      __syncthreads();
      const float* wout = a.in[15]; bf16_t* W2T = (bf16_t*)(ws + WS_W2);
      for (int it = gw; it < 2048; it += NGW) {
          const int kb = it >> 4, nb = it & 15; const int krow0 = 512 + kb * 8; const int sn = (krow0 >= 1024) ? 1 : 0; const int cg0 = (krow0 - 512 - sn * 512); const int g = cg0 >> 7, c0 = cg0 & 127;
          const int n = nb * 64 + F.lane; float accv[8];
#pragma unroll
          for (int i = 0; i < 8; ++i) accv[i] = 0.f;
          const float* wp = wout + (size_t)(512 + g * 128) * DM + n;
#pragma unroll 1
          for (int jb = 0; jb < 128; jb += 32) { float wv[32];
#pragma unroll
              for (int jj = 0; jj < 32; ++jj) wv[jj] = wp[(size_t)(jb + jj) * DM];
#pragma unroll
              for (int jj = 0; jj < 32; ++jj) { const int j = jb + jj;
#pragma unroll
                  for (int i = 0; i < 8; ++i) { const int ph = (j * (c0 + i) - sn * 32) & 127; accv[i] += ctab[ph] * wv[jj]; } } }
          const float sc = sn ? (-1.0f / 1024.0f) : (1.0f / 1024.0f);
          u32x4 o; o.x = pk2(accv[0] * sc, accv[1] * sc); o.y = pk2(accv[2] * sc, accv[3] * sc); o.z = pk2(accv[4] * sc, accv[5] * sc); o.w = pk2(accv[6] * sc, accv[7] * sc);
          *(u32x4*)(W2T + (size_t)n * KOUT + krow0) = o;
      } }
    { bf16_t* WgT = (bf16_t*)(ws + WS_WGT);
      for (int o = (F.vcu * NTHREADS + F.tid); o < NHEAD * 256 * 64; o += F.G * NTHREADS) {
          const int k = o & 63, n = (o >> 6) & 255, h = o >> 14, mat = n >> 6, j = n & 63;
          const float* W = a.in[mat == 0 ? 5 : mat == 1 ? 7 : mat == 2 ? 10 : 12];
          WgT[o] = (bf16_t)f2bf(W[(h * 64 + k) * 64 + j]);
      } }
}

__device__ constexpr float TWR[32] = {1.000000000e+00f, 9.951847267e-01f, 9.807852804e-01f, 9.569403357e-01f, 9.238795325e-01f, 8.819212643e-01f, 8.314696123e-01f, 7.730104534e-01f, 7.071067812e-01f, 6.343932842e-01f, 5.555702330e-01f, 4.713967368e-01f, 3.826834324e-01f, 2.902846773e-01f, 1.950903220e-01f, 9.801714033e-02f, 0.0f, -9.801714033e-02f, -1.950903220e-01f, -2.902846773e-01f, -3.826834324e-01f, -4.713967368e-01f, -5.555702330e-01f, -6.343932842e-01f, -7.071067812e-01f, -7.730104534e-01f, -8.314696123e-01f, -8.819212643e-01f, -9.238795325e-01f, -9.569403357e-01f, -9.807852804e-01f, -9.951847267e-01f};
__device__ constexpr float TWI[32] = {-0.0f, -9.801714033e-02f, -1.950903220e-01f, -2.902846773e-01f, -3.826834324e-01f, -4.713967368e-01f, -5.555702330e-01f, -6.343932842e-01f, -7.071067812e-01f, -7.730104534e-01f, -8.314696123e-01f, -8.819212643e-01f, -9.238795325e-01f, -9.569403357e-01f, -9.807852804e-01f, -9.951847267e-01f, -1.000000000e+00f, -9.951847267e-01f, -9.807852804e-01f, -9.569403357e-01f, -9.238795325e-01f, -8.819212643e-01f, -8.314696123e-01f, -7.730104534e-01f, -7.071067812e-01f, -6.343932842e-01f, -5.555702330e-01f, -4.713967368e-01f, -3.826834324e-01f, -2.902846773e-01f, -1.950903220e-01f, -9.801714033e-02f};
constexpr int bitrev_c(int i, int n) { int r = 0; for (int b = 0; b < n; ++b) r |= ((i >> b) & 1) << (n - 1 - b); return r; }
template <int N, int ST, int L> struct FftStage {
    static __device__ __forceinline__ void run(float (&re)[N], float (&im)[N]) {
        constexpr int m = 1 << ST, h = m >> 1;
#pragma unroll
        for (int kk = 0; kk < N; kk += m) {
#pragma unroll
            for (int j = 0; j < h; ++j) {
                const float wr = TWR[j * (64 / m)], wi = TWI[j * (64 / m)];
                const float xr = re[kk + j + h], xi = im[kk + j + h];
                const float tr = wr * xr - wi * xi, ti = wr * xi + wi * xr;
                re[kk + j + h] = re[kk + j] - tr; im[kk + j + h] = im[kk + j] - ti;
                re[kk + j] += tr; im[kk + j] += ti;
            }
        }
        if constexpr (ST < L) FftStage<N, ST + 1, L>::run(re, im);
    }
};
template <int N, int L> __device__ __forceinline__ void fft_inreg(float (&re)[N], float (&im)[N]) {
#pragma unroll
    for (int i = 0; i < N; ++i) { const int j = bitrev_c(i, L); if (i < j) { float t = re[i]; re[i] = re[j]; re[j] = t; t = im[i]; im[i] = im[j]; im[j] = t; } }
    FftStage<N, 1, L>::run(re, im);
}

__device__ __forceinline__ void fft1_item(const Frame& F, const bf16_t* P, u32x2* V, int item) {
    const int b = item >> 7, sg = (item >> 3) & 15, cc = item & 7;
    const int s2a = 16 * sg + 2 * F.wave, c = cc * 64 + F.lane;
    float re[32], im[32];
    const bf16_t* src = P + ((size_t)b * SEQ + s2a) * NPROJ + 1024 + c;
#pragma unroll
    for (int i = 0; i < 32; ++i) { re[i] = bf2f(src[(size_t)i * 256 * NPROJ]); im[i] = bf2f(src[(size_t)i * 256 * NPROJ + NPROJ]); }
    fft_inreg<32, 5>(re, im);
    float sa, ca, sb, cb; sincospif((float)s2a * (1.0f / 4096.0f), &sa, &ca); sincospif((float)(s2a + 1) * (1.0f / 4096.0f), &sb, &cb);
    float war = 1.f, wai = 0.f, wbr = 1.f, wbi = 0.f;
    u32x2* dst = V + (((size_t)b * 17) * 128 + (s2a >> 1)) * 512 + c;
#pragma unroll
    for (int k = 0; k <= 16; ++k) {
        const int km = (32 - k) & 31;
        const float ar = 0.5f * (re[k] + re[km]), ai = 0.5f * (im[k] - im[km]), br = 0.5f * (im[k] + im[km]), bi = -0.5f * (re[k] - re[km]);
        f32x2 va, vb; va.x = ar * war - ai * wai; va.y = ar * wai + ai * war; vb.x = br * wbr - bi * wbi; vb.y = br * wbi + bi * wbr;
        dst[(size_t)k * 128 * 512] = (u32x2){pk2(va.x, va.y), pk2(vb.x, vb.y)};
        const float t0 = war * ca + wai * sa; wai = wai * ca - war * sa; war = t0;
        const float t1 = wbr * cb + wbi * sb; wbi = wbi * cb - wbr * sb; wbr = t1;
    }
}
__device__ __forceinline__ void fft2_item(const Frame& F, const u32x2* V, bf16_t* A2, int b, int k1, int cc) {
    const int w = F.wave, c = cc * 64 + F.lane;
    LAS f32x2* T = (LAS f32x2*)F.lds;
    { u32x2 pv[16];
      const u32x2* src = V + (((size_t)b * 17 + k1) * 128 + w) * 512 + c;
#pragma unroll
      for (int j1 = 0; j1 < 16; ++j1) pv[j1] = src[(size_t)j1 * 8 * 512];
#pragma unroll
      for (int jj = 0; jj < 2; ++jj) { const int j2 = 2 * w + jj; float re[16], im[16];
#pragma unroll
          for (int j1 = 0; j1 < 16; ++j1) { const unsigned q = jj ? pv[j1].y : pv[j1].x; re[j1] = bf2f(q & 0xffffu); im[j1] = bf2f(q >> 16); }
          fft_inreg<16, 4>(re, im);
#pragma unroll
          for (int q1 = 0; q1 < 16; ++q1) { float sn, cs; sincospif((float)(q1 * j2) * (1.0f / 128.0f), &sn, &cs);
              f32x2 o; o.x = re[q1] * cs + im[q1] * sn; o.y = im[q1] * cs - re[q1] * sn; T[(q1 * 16 + j2) * 64 + F.lane] = o; } } }
    __syncthreads();
#pragma unroll 1
    for (int qq = 0; qq < 2; ++qq) { const int q1 = 2 * w + qq; float re[16], im[16];
#pragma unroll
        for (int j2 = 0; j2 < 16; ++j2) { const f32x2 v = T[(q1 * 16 + j2) * 64 + F.lane]; re[j2] = v.x; im[j2] = v.y; }
        fft_inreg<16, 4>(re, im);
#pragma unroll
        for (int q2 = 0; q2 < 16; ++q2) { const int k = k1 + 32 * (q1 + 16 * q2);
            bf16_t* d = A2 + ((size_t)b * SEQ + k) * KOUT + 512 + c; d[0] = (bf16_t)f2bf(re[q2]); d[512] = (bf16_t)f2bf(-im[q2]);
            if (k1 != 0 && k1 != 16) { bf16_t* dm = A2 + ((size_t)b * SEQ + (SEQ - k)) * KOUT + 512 + c; dm[0] = (bf16_t)f2bf(re[q2]); dm[512] = (bf16_t)f2bf(im[q2]); } } }
    __syncthreads();
}

constexpr int LRU_WG = 0, LRU_CS = 32768, LRU_CF = 49152, LRU_XT = 81920, LRU_GT = 98816  , LRU_AGW = 115200, LRU_WCAR = 123392, LRU_CARRY = 127488, LRU_CONST = 131584;
static_assert(LRU_XT + 131 * 128 <= LRU_GT && LRU_GT + 16384 <= LRU_AGW && LRU_AGW + 8192 <= LRU_WCAR && LRU_WCAR + 4096 <= LRU_CARRY && LRU_CARRY + 4096 <= LRU_CONST && LRU_CONST + 11 * 256 <= MISC_OFF, "LRU LDS map");
template <int PASS>
__device__ __forceinline__ void lru_super_item(const Frame& F, KArgs& a, int si) {
    const int b = si >> 6, h = (si >> 3) & 7, j0 = (si & 7) * 8;
    const int tid = F.tid, lane = F.lane, w = F.wave, fr = lane & 15, fq = lane >> 4;
    unsigned char* ws = a.ws;
    const bf16_t* P = (const bf16_t*)a.out;
    LAS unsigned char* lds = F.lds;
    f32x2* agg = (f32x2*)(ws + WS_AGG);
    { const bf16_t* WgT = (const bf16_t*)(ws + WS_WGT) + (size_t)h * 256 * 64;
#pragma unroll
      for (int i = 0; i < 4; ++i) { const int q = tid + 512 * i, n = q >> 3, ch = q & 7; const u32x4 v = *(const u32x4*)(WgT + n * 64 + ch * 8); *(LAS u32x4*)(lds + LRU_WG + n * 128 + ((ch ^ (n & 7)) << 4)) = v; } }
    { LAS float* KC = (LAS float*)(lds + LRU_CONST);
      if (tid < 64) { const int ch = h * 64 + tid;
          KC[0 * 64 + tid] = -8.0f * log1pf(expf(-a.in[9][ch])) * 1.4426950408889634f; KC[1 * 64 + tid] = -8.0f * log1pf(expf(-a.in[14][ch])) * 1.4426950408889634f;
          KC[2 * 64 + tid] = a.in[6][ch]; KC[3 * 64 + tid] = a.in[8][ch]; KC[4 * 64 + tid] = a.in[11][ch]; KC[5 * 64 + tid] = a.in[13][ch]; KC[6 * 64 + tid] = a.in[4][ch];
#pragma unroll
          for (int k = 0; k < 4; ++k) KC[(7 + k) * 64 + tid] = a.in[3][k * DLRU + ch]; } }
    const LAS float* KC = (const LAS float*)(lds + LRU_CONST);
    const int ch4 = tid & 15, tq = tid >> 4;
    if (PASS == 2) {
        if (tid < 128) { const int dir = tid >> 6, ch = tid & 63; LAS float* CAR = (LAS float*)(lds + LRU_CARRY);
            float carry = 0.f;
            if (dir == 0) { for (int jj = 0; jj < j0 + 8; ++jj) { if (jj >= j0) CAR[((jj - j0) * 2 + 0) * 64 + ch] = carry; const f32x2 ah = agg[(((size_t)b * 64 + jj) * 2 + 0) * 512 + h * 64 + ch]; carry = ah.x * carry + ah.y; } }
            else { for (int jj = 63; jj >= j0; --jj) { if (jj < j0 + 8) CAR[((jj - j0) * 2 + 1) * 64 + ch] = carry; const f32x2 ah = agg[(((size_t)b * 64 + jj) * 2 + 1) * 512 + h * 64 + ch]; carry = ah.x * carry + ah.y; } }
        }
    }
    __syncthreads();
    u32x4 px[3], pg[2];
#define LRU_LOAD_CHUNK(jj) do { const int _t0 = (jj) * 128; \
        _Pragma("unroll") for (int _i = 0; _i < 3; ++_i) { const int _q = tid + 512 * _i, _r = _q >> 3, _c = _q & 7, _t = _t0 - 2 + _r; px[_i] = (u32x4){0u, 0u, 0u, 0u}; \
            if (_q < 131 * 8 && _t >= 0 && _t < SEQ) px[_i] = *(const u32x4*)(P + ((size_t)b * SEQ + _t) * NPROJ + h * 64 + _c * 8); } \
        if (PASS == 2) { _Pragma("unroll") for (int _i = 0; _i < 2; ++_i) { const int _q = tid + 512 * _i, _r = _q >> 3, _c = _q & 7; pg[_i] = *(const u32x4*)(P + ((size_t)b * SEQ + _t0 + _r) * NPROJ + 512 + h * 64 + _c * 8); } } } while (0)
    LRU_LOAD_CHUNK(j0);
    for (int jl = 0; jl < 8; ++jl) {
        const int j = j0 + jl, t0 = j * 128;
#pragma unroll
        for (int i = 0; i < 3; ++i) { const int q = tid + 512 * i, r = q >> 3, chk = q & 7; if (q < 131 * 8) *(LAS u32x4*)(lds + LRU_XT + r * 128 + chk * 16) = px[i]; }
        if (PASS == 2) {
#pragma unroll
            for (int i = 0; i < 2; ++i) { const int q = tid + 512 * i, r = q >> 3, chk = q & 7; *(LAS u32x4*)(lds + LRU_GT + r * 128 + chk * 16) = pg[i]; } }
        __syncthreads();
        if (jl < 7) LRU_LOAD_CHUNK(j + 1);
        { float xv[7][4]; const f32x4 cbias = *(const LAS f32x4*)(KC + 6 * 64 + ch4 * 4); f32x4 cwv[4];
#pragma unroll
          for (int k = 0; k < 4; ++k) cwv[k] = *(const LAS f32x4*)(KC + (7 + k) * 64 + ch4 * 4);
#pragma unroll
          for (int r = 0; r < 7; ++r) { const u32x2 v = *(const LAS u32x2*)(lds + LRU_XT + (4 * tq + r) * 128 + ch4 * 8); xv[r][0] = bf2f(v.x & 0xffffu); xv[r][1] = bf2f(v.x >> 16); xv[r][2] = bf2f(v.y & 0xffffu); xv[r][3] = bf2f(v.y >> 16); }
#pragma unroll
          for (int tt = 0; tt < 4; ++tt) { const int t = 4 * tq + tt; f32x4 cv;
#pragma unroll
              for (int i = 0; i < 4; ++i) { float s = cbias[i];
#pragma unroll
                  for (int k = 0; k < 4; ++k) s += cwv[k][i] * xv[tt + k][i];
                  cv[i] = s; }
              *(LAS f32x4*)(lds + LRU_CF + t * 256 + ch4 * 16) = cv;
              u32x2 pk; pk.x = pk2(cv[0], cv[1]); pk.y = pk2(cv[2], cv[3]);
              *(LAS u32x2*)(lds + LRU_CS + t * 128 + (((ch4 >> 1) ^ (t & 7)) << 4) + (ch4 & 1) * 8) = pk; } }
        __syncthreads();
        bf16x8 af[2];
        { const int row = 16 * w + fr;
#pragma unroll
          for (int kk = 0; kk < 2; ++kk) af[kk] = *(const LAS bf16x8*)(lds + LRU_CS + row * 128 + (((kk * 4 + fq) ^ (row & 7)) << 4)); }
#pragma unroll 1
        for (int hf = 0; hf < 2; ++hf) {
            float Pf[2][4], Hf[2][4], Pb[2][4], Hb[2][4];
#pragma unroll
            for (int cb = 0; cb < 2; ++cb) { const int cb4 = 2 * hf + cb;
                f32x4 acc[4];
#pragma unroll
                for (int mat = 0; mat < 4; ++mat) { acc[mat] = (f32x4){0.f, 0.f, 0.f, 0.f}; const int n = (mat * 4 + cb4) * 16 + fr;
#pragma unroll
                    for (int kk = 0; kk < 2; ++kk) { const bf16x8 bfr = *(const LAS bf16x8*)(lds + LRU_WG + n * 128 + (((kk * 4 + fq) ^ (n & 7)) << 4)); acc[mat] = __builtin_amdgcn_mfma_f32_16x16x32_bf16(af[kk], bfr, acc[mat], 0, 0, 0); } }
                float af_[4], bf_[4], ab_[4], bb_[4]; const int chl = cb4 * 16 + fr;
                const float k_c8f = KC[chl], k_c8b = KC[64 + chl], k_baf = KC[128 + chl], k_bxf = KC[192 + chl], k_bab = KC[256 + chl], k_bxb = KC[320 + chl];
#pragma unroll
                for (int r = 0; r < 4; ++r) { const int t = 16 * w + 4 * fq + r; const float cval = *(const LAS float*)(lds + LRU_CF + t * 256 + chl * 4);
                    const float rf = fast_sigmoid(acc[0][r] + k_baf), xf = fast_sigmoid(acc[1][r] + k_bxf);
                    const float rb = fast_sigmoid(acc[2][r] + k_bab), xb = fast_sigmoid(acc[3][r] + k_bxb);
                    const float a1 = __builtin_amdgcn_exp2f(k_c8f * rf), a2 = __builtin_amdgcn_exp2f(k_c8b * rb);
                    af_[r] = a1; bf_[r] = __builtin_amdgcn_sqrtf(fmaxf(fmaf(-a1, a1, 1.0f), 0.f)) * xf * cval;
                    ab_[r] = a2; bb_[r] = __builtin_amdgcn_sqrtf(fmaxf(fmaf(-a2, a2, 1.0f), 0.f)) * xb * cval; }
                Pf[cb][0] = af_[0]; Hf[cb][0] = bf_[0];
#pragma unroll
                for (int r = 1; r < 4; ++r) { Pf[cb][r] = af_[r] * Pf[cb][r - 1]; Hf[cb][r] = af_[r] * Hf[cb][r - 1] + bf_[r]; }
                Pb[cb][3] = ab_[3]; Hb[cb][3] = bb_[3];
#pragma unroll
                for (int r = 2; r >= 0; --r) { Pb[cb][r] = ab_[r] * Pb[cb][r + 1]; Hb[cb][r] = ab_[r] * Hb[cb][r + 1] + bb_[r]; }
            }
            float gPf[2], gHf[2], gPb[2], gHb[2];
            { LAS f32x2* AGW = (LAS f32x2*)(lds + LRU_AGW);
#pragma unroll
              for (int cb = 0; cb < 2; ++cb) { const int chl = (2 * hf + cb) * 16 + fr;
                  const bool odd = (fq & 1) != 0, hi = (fq & 2) != 0;
                  { const float A = Pf[cb][3], H = Hf[cb][3];
                    const float A1 = xchg16(A, lane), H1 = xchg16(H, lane);
                    const float pA = odd ? A1 : 1.f, pH = odd ? H1 : 0.f, qA = A * A1, qH = odd ? (A * H1 + H) : (A1 * H + H1);
                    const float QA = xchg32(qA, lane), QH = xchg32(qH, lane);
                    gPf[cb] = hi ? pA * QA : pA; gHf[cb] = hi ? (pA * QH + pH) : pH;
                    if (fq == 0) AGW[(w * 2 + 0) * 64 + chl] = (f32x2){qA * QA, QA * qH + QH}; }
                  { const float A = Pb[cb][0], H = Hb[cb][0];
                    const float A1 = xchg16(A, lane), H1 = xchg16(H, lane);
                    const float pA = odd ? 1.f : A1, pH = odd ? 0.f : H1, qA = A * A1, qH = odd ? (A1 * H + H1) : (A * H1 + H);
                    const float QA = xchg32(qA, lane), QH = xchg32(qH, lane);
                    gPb[cb] = hi ? pA : pA * QA; gHb[cb] = hi ? pH : (pA * QH + pH);
                    if (fq == 0) AGW[(w * 2 + 1) * 64 + chl] = (f32x2){qA * QA, qA * QH + qH}; }
              } }
            __syncthreads();
            if (tid < 64) { const int dir = tid >> 5, ch = hf * 32 + (tid & 31); const LAS f32x2* AGW = (const LAS f32x2*)(lds + LRU_AGW); LAS float* WCAR = (LAS float*)(lds + LRU_WCAR);
                float carry = (PASS == 2) ? ((const LAS float*)(lds + LRU_CARRY))[(jl * 2 + dir) * 64 + ch] : 0.f; float ptot = 1.f;
                if (dir == 0) { for (int ww = 0; ww < 8; ++ww) { WCAR[(ww * 2 + 0) * 64 + ch] = carry; const f32x2 ah = AGW[(ww * 2 + 0) * 64 + ch]; carry = ah.x * carry + ah.y; ptot *= ah.x; } }
                else { for (int ww = 7; ww >= 0; --ww) { WCAR[(ww * 2 + 1) * 64 + ch] = carry; const f32x2 ah = AGW[(ww * 2 + 1) * 64 + ch]; carry = ah.x * carry + ah.y; ptot *= ah.x; } }
                if (PASS == 1) agg[(((size_t)b * 64 + j) * 2 + dir) * 512 + h * 64 + ch] = (f32x2){ptot, carry};
            }
            if (PASS == 2) {
                __syncthreads();
                const LAS float* WCAR = (const LAS float*)(lds + LRU_WCAR);
#pragma unroll
                for (int cb = 0; cb < 2; ++cb) { const int ch = (2 * hf + cb) * 16 + fr;
                    const float cf = gHf[cb] + gPf[cb] * WCAR[(w * 2 + 0) * 64 + ch], cbk = gHb[cb] + gPb[cb] * WCAR[(w * 2 + 1) * 64 + ch];
#pragma unroll
                    for (int r = 0; r < 4; ++r) { const int t = 16 * w + 4 * fq + r; const float hs = (Hf[cb][r] + Pf[cb][r] * cf) + (Hb[cb][r] + Pb[cb][r] * cbk);
                        LAS bf16_t* gp = (LAS bf16_t*)(lds + LRU_GT + t * 128 + ch * 2); const float g = bf2f((unsigned)*gp);
                        const float u = 0.7978845608028654f * (g + 0.044715f * g * g * g); const float th = 1.0f - 2.0f * __builtin_amdgcn_rcpf(1.0f + __builtin_amdgcn_exp2f(2.885390081777927f * u));
                        *gp = (bf16_t)f2bf(0.5f * g * (1.0f + th) * hs); } }
            }
        }
        if (PASS == 2) {
            __syncthreads();
            bf16_t* A2 = (bf16_t*)(ws + WS_A2);
#pragma unroll
            for (int i = 0; i < 2; ++i) { const int q = tid + 512 * i, r = q >> 3, chk = q & 7; const u32x4 v = *(const LAS u32x4*)(lds + LRU_GT + r * 128 + chk * 16);
                *(u32x4*)(A2 + ((size_t)b * SEQ + t0 + r) * KOUT + h * 64 + chk * 8) = v; }
        }
        __syncthreads();
    }
#undef LRU_LOAD_CHUNK
}

constexpr int P5_PITCH = 2048 + 16;
__device__ __forceinline__ void p5_router(const Frame& F, KArgs& a) {
    unsigned char* ws = a.ws;
    LAS unsigned char* WH = F.lds; LAS unsigned char* WL = F.lds + 16 * P5_PITCH;
    { const float* wr = a.in[17];
      for (int o = F.tid; o < DM * NEXP; o += NTHREADS) { const int k = o >> 4, e = o & 15; const float w = wr[o]; const unsigned hi = f2bf(w); const float lo = w - bf2f(hi);
          *(LAS bf16_t*)(WH + e * P5_PITCH + k * 2) = (bf16_t)hi; *(LAS bf16_t*)(WL + e * P5_PITCH + k * 2) = (bf16_t)f2bf(lo); } }
    __syncthreads();
    const bf16_t* xm = (const bf16_t*)(ws + WS_DELTA); const float* g2 = a.in[16];
    unsigned char* h2 = (unsigned char*)(ws + WS_H2); float* scores = (float*)(ws + WS_SCORES); float* rstd2 = (float*)(ws + WS_RSTD1);
    const int gw = F.vcu * NWAVES + F.wave, NGW = F.G * NWAVES, fr = F.lane & 15, fq = F.lane >> 4;
    for (int grp = gw; grp < MTOK / 16; grp += NGW) {
        const int m0 = grp * 16;
        const bf16_t* xrow = xm + (size_t)(m0 + fr) * DM + 16 * fq; unsigned char* hrow = h2 + (size_t)(m0 + fr) * DM + 16 * fq;
        f32x4 acc = (f32x4){0.f, 0.f, 0.f, 0.f}; float ssq = 0.f;
#pragma unroll 2
        for (int kp = 0; kp < 16; ++kp) {
            const u32x4 x0 = *(const u32x4*)(xrow + 64 * kp), x1 = *(const u32x4*)(xrow + 64 * kp + 8); unsigned qq[4];
#pragma unroll
            for (int hh = 0; hh < 2; ++hh) { const u32x4 xv = hh ? x1 : x0; const int k0 = 64 * kp + 16 * fq + 8 * hh;
                f32x4 xa, xb; xa.x = bf2f(xv.x & 0xffffu); xa.y = bf2f(xv.x >> 16); xa.z = bf2f(xv.y & 0xffffu); xa.w = bf2f(xv.y >> 16); xb.x = bf2f(xv.z & 0xffffu); xb.y = bf2f(xv.z >> 16); xb.z = bf2f(xv.w & 0xffffu); xb.w = bf2f(xv.w >> 16);
                const f32x4 ga = *(const f32x4*)(g2 + k0), gb = *(const f32x4*)(g2 + k0 + 4);
                ssq += (xa.x * xa.x + xa.y * xa.y) + (xa.z * xa.z + xa.w * xa.w) + (xb.x * xb.x + xb.y * xb.y) + (xb.z * xb.z + xb.w * xb.w);
                const f32x4 va = xa * ga, vb = xb * gb;
                u32x4 hi, lo;
                hi.x = pk2(va.x, va.y); hi.y = pk2(va.z, va.w); hi.z = pk2(vb.x, vb.y); hi.w = pk2(vb.z, vb.w);
                lo.x = pk2(va.x - bf2f(hi.x & 0xffffu), va.y - bf2f(hi.x >> 16)); lo.y = pk2(va.z - bf2f(hi.y & 0xffffu), va.w - bf2f(hi.y >> 16));
                lo.z = pk2(vb.x - bf2f(hi.z & 0xffffu), vb.y - bf2f(hi.z >> 16)); lo.w = pk2(vb.z - bf2f(hi.w & 0xffffu), vb.w - bf2f(hi.w >> 16));
                const bf16x8 bh = *(const LAS bf16x8*)(WH + fr * P5_PITCH + k0 * 2), bl = *(const LAS bf16x8*)(WL + fr * P5_PITCH + k0 * 2);
                acc = __builtin_amdgcn_mfma_f32_16x16x32_bf16((bf16x8)hi, bh, acc, 0, 0, 0);
                acc = __builtin_amdgcn_mfma_f32_16x16x32_bf16((bf16x8)lo, bh, acc, 0, 0, 0);
                acc = __builtin_amdgcn_mfma_f32_16x16x32_bf16((bf16x8)hi, bl, acc, 0, 0, 0);
                qq[2 * hh] = pk4_fp8(va.x, va.y, va.z, va.w); qq[2 * hh + 1] = pk4_fp8(vb.x, vb.y, vb.z, vb.w); }
            *(u32x4*)(hrow + 64 * kp) = (u32x4){qq[0], qq[1], qq[2], qq[3]};
        }
        ssq += __shfl_xor(ssq, 16); ssq += __shfl_xor(ssq, 32);
        const float rs = 1.0f / sqrtf(ssq * (1.0f / DM) + EPS);
        if (fq == 0) rstd2[m0 + fr] = rs;
        f32x4 sc;
#pragma unroll
        for (int r = 0; r < 4; ++r) { const float l = acc[r] * __shfl(rs, 4 * fq + r);
            float mx = l;
#pragma unroll
            for (int o = 1; o < 16; o <<= 1) mx = fmaxf(mx, __shfl_xor(mx, o));
            const float ex = expf(l - mx); float sm = ex;
#pragma unroll
            for (int o = 1; o < 16; o <<= 1) sm += __shfl_xor(sm, o);
            sc[r] = ex / sm; }
        const int bb = m0 >> 13, s0 = m0 & (SEQ - 1);
        *(f32x4*)(scores + ((size_t)bb * NEXP + fr) * SEQ + s0 + 4 * fq) = sc;
    }
}

__device__ __forceinline__ void p6_topk_item(const Frame& F, KArgs& a, int item) {
    unsigned char* ws = a.ws; const int b = item >> 4, e = item & 15, tid = F.tid;
    const float* sc = (const float*)(ws + WS_SCORES) + (size_t)item * SEQ;
    int* tok = (int*)(ws + WS_TOK) + e * EROWS + b * CAP; float* gate = (float*)(ws + WS_GATE) + e * EROWS + b * CAP; int* inv = (int*)(ws + WS_INV) + (size_t)item * SEQ;
    float* rsl = (float*)(ws + WS_RS) + e * EROWS + b * CAP; const float* rstd2 = (const float*)(ws + WS_RSTD1) + b * SEQ;
    LAS unsigned* hist = (LAS unsigned*)F.lds;
    LAS unsigned* sfx = hist + 256;
    LAS unsigned* bc = hist + 512;
    LAS unsigned* scan = hist + 768;
    unsigned key[16];
    { const u32x4* p = (const u32x4*)(sc + tid * 16);
#pragma unroll
      for (int i = 0; i < 4; ++i) { const u32x4 v = p[i]; key[4 * i] = v.x; key[4 * i + 1] = v.y; key[4 * i + 2] = v.z; key[4 * i + 3] = v.w; } }
    unsigned prefix = 0, need = CAP;
    const int lane = F.lane, wv = F.wave;
    if (tid < 256) hist[tid] = 0u;
    __syncthreads();
#pragma unroll 1
    for (int pass = 0; pass < 4; ++pass) {
        const int shift = 24 - 8 * pass; const unsigned himask = pass == 0 ? 0u : (0xffffffffu << (shift + 8));
#pragma unroll
        for (int i = 0; i < 16; ++i) if ((key[i] & himask) == prefix) __hip_atomic_fetch_add(&hist[(key[i] >> shift) & 255u], 1u, __ATOMIC_RELAXED, __HIP_MEMORY_SCOPE_WORKGROUP);
        __syncthreads();
        unsigned hv = 0u, sv = 0u;
        if (tid < 256) { hv = hist[tid]; hist[tid] = 0u; sv = hv;
#pragma unroll
            for (int d = 1; d < 64; d <<= 1) { const unsigned o = __shfl_down(sv, d); if (lane + d < 64) sv += o; }
            if (lane == 0) sfx[wv] = sv; }
        __syncthreads();
        if (tid < 256) { unsigned ge = sv;
#pragma unroll
            for (int k = 1; k < 4; ++k) if (wv + k < 4) ge += sfx[wv + k];
            const unsigned gt = ge - hv;
            if (ge >= need && gt < need) { bc[0] = prefix | ((unsigned)tid << shift); bc[1] = need - gt; } }
        __syncthreads();
        prefix = bc[0]; need = bc[1];
    }
    const unsigned T = prefix;
    unsigned ngt = 0, neq = 0;
#pragma unroll
    for (int i = 0; i < 16; ++i) { ngt += key[i] > T ? 1u : 0u; neq += key[i] == T ? 1u : 0u; }
    unsigned incl = ngt | (neq << 16);
#pragma unroll
    for (int d = 1; d < 64; d <<= 1) { const unsigned o = __shfl_up(incl, d); if (lane >= d) incl += o; }
    if (lane == 63) scan[wv] = incl;
    __syncthreads();
    unsigned tot = 0u;
#pragma unroll
    for (int k = 0; k < 8; ++k) { const unsigned wt = scan[k]; if (k < wv) incl += wt; tot += wt; }
    const unsigned totgt = tot & 0xffffu;
    unsigned pgt = (incl & 0xffffu) - ngt, peq = (incl >> 16) - neq;
#pragma unroll
    for (int i = 0; i < 16; ++i) { const int s = tid * 16 + i; int slot = -1;
        if (key[i] > T) { slot = (int)pgt; ++pgt; }
        else if (key[i] == T) { if (peq < need) slot = (int)(totgt + peq); ++peq; }
        inv[s] = slot;
        if (slot >= 0) { tok[slot] = b * SEQ + s; gate[slot] = __builtin_bit_cast(float, key[i]); rsl[slot] = rstd2[s]; } }
    __syncthreads();
}

__device__ __forceinline__ void p9_final(const Frame& F, KArgs& a, float* dst) {
    unsigned char* ws = a.ws; const bf16_t* dl = (const bf16_t*)(ws + WS_DELTA); const float* gf = a.in[21]; const unsigned char* eo = (const unsigned char*)(ws + WS_EO); const int* inv = (const int*)(ws + WS_INV);
    const int gw = F.vcu * NWAVES + F.wave, NGW = F.G * NWAVES;
    f32x4 gv[4];
#pragma unroll
    for (int j = 0; j < 4; ++j) gv[j] = ((const f32x4*)gf)[F.lane + 64 * j];
    unsigned long long dn[4]; int slotn = -1;
    { const int m0 = gw < MTOK ? gw : 0; const unsigned long long* dr = (const unsigned long long*)(dl + (size_t)m0 * DM) + F.lane;
#pragma unroll
      for (int j = 0; j < 4; ++j) dn[j] = dr[64 * j];
      if (F.lane < 16) slotn = inv[((size_t)(m0 >> 13) * NEXP + F.lane) * SEQ + (m0 & (SEQ - 1))]; }
    for (int m = gw; m < MTOK; m += NGW) {
        f32x4 v[4]; const int myslot = slotn;
#pragma unroll
        for (int j = 0; j < 4; ++j) { const unsigned lo = (unsigned)dn[j], hi = (unsigned)(dn[j] >> 32); v[j].x = bf2f(lo & 0xffffu); v[j].y = bf2f(lo >> 16); v[j].z = bf2f(hi & 0xffffu); v[j].w = bf2f(hi >> 16); }
        const int bb = m >> 13;
        { const int mn = (m + NGW < MTOK) ? m + NGW : m; const unsigned long long* dr = (const unsigned long long*)(dl + (size_t)mn * DM) + F.lane;
#pragma unroll
          for (int j = 0; j < 4; ++j) dn[j] = dr[64 * j];
          slotn = -1; if (F.lane < 16) slotn = inv[((size_t)(mn >> 13) * NEXP + F.lane) * SEQ + (mn & (SEQ - 1))]; }
#if !DBG_NO_MOE
        unsigned mask = (unsigned)__ballot(myslot >= 0) & 0xffffu;
        while (mask) {
            unsigned q[4][4]; int ne = 0;
#pragma unroll
            for (int t = 0; t < 4; ++t) { if (mask) { const int e = __builtin_ctz(mask); mask &= mask - 1u; const int slot = __builtin_amdgcn_readlane(myslot, e);
                    const unsigned* er = (const unsigned*)(eo + ((size_t)e * EROWS + bb * CAP + slot) * DM) + F.lane;
#pragma unroll
                    for (int j = 0; j < 4; ++j) q[t][j] = er[64 * j];
                    ne = t + 1; } }
#pragma unroll
            for (int t = 0; t < 4; ++t) { if (t < ne) {
#pragma unroll
                    for (int j = 0; j < 4; ++j) { const f32x2 lo = __builtin_amdgcn_cvt_pk_f32_fp8((int)q[t][j], false), hi = __builtin_amdgcn_cvt_pk_f32_fp8((int)q[t][j], true);
                        v[j].x += lo.x * 0.0625f; v[j].y += lo.y * 0.0625f; v[j].z += hi.x * 0.0625f; v[j].w += hi.y * 0.0625f; } } }
        }
#endif
        float s = 0.f;
#pragma unroll
        for (int j = 0; j < 4; ++j) s += (v[j].x * v[j].x + v[j].y * v[j].y) + (v[j].z * v[j].z + v[j].w * v[j].w);
        const float rstd = 1.0f / sqrtf(wave_sum(s) * (1.0f / DM) + EPS);
        f32x4* xw = (f32x4*)(dst + (size_t)m * DM) + F.lane;
#pragma unroll
        for (int j = 0; j < 4; ++j) xw[64 * j] = v[j] * rstd * gv[j];
    }
}

__global__ void __launch_bounds__(NTHREADS, 2) fwd(Args args) {
    extern __shared__ __attribute__((aligned(16))) unsigned char lds_raw[];
    Frame F;
    F.lds = (LAS unsigned char*)lds_raw;
    F.tid = threadIdx.x; F.lane = F.tid & 63; F.wave = __builtin_amdgcn_readfirstlane(F.tid >> 6);
    F.G = gridDim.x; F.bx = blockIdx.x; F.vcu = (F.G % 8 == 0) ? (F.bx % 8) * (F.G / 8) + F.bx / 8 : F.bx;
    volatile LAS unsigned* MISC = (volatile LAS unsigned*)(F.lds + MISC_OFF);
    if (F.tid < 16) MISC[F.tid] = 0u;
    __syncthreads();
    KArgs* kap = (KArgs*)__builtin_amdgcn_kernarg_segment_ptr();
    unsigned char* ws = args.ws;
    unsigned* ctl = (unsigned*)(ws + WS_CTL);
    const int lo = args.ph_lo, hi = args.ph_hi;
    const __amdgpu_buffer_rsrc_t rsrc = __builtin_amdgcn_make_buffer_rsrc((void*)ws, (short)0, (int)0x7fffffff, (int)0x00020000);
#if !N_LAUNCH_PER_PHASE
    XcdBarrier bar = xcd_barrier_post(ctl + 1024, MISC + 8);
#if USE_COOP == 1
    cg::this_grid().sync();
#endif
#define GRID_BAR() xcd_barrier(bar)
#else
#define GRID_BAR() do {} while (0)
#endif
#ifdef ONLY_PHASE
#define IN(k) ((k) == ONLY_PHASE && lo <= (k) && (k) < hi)
#else
#define IN(k) (lo <= (k) && (k) < hi)
#endif
#define REFRESH() int t_ = threadIdx.x; asm volatile("" : "+v"(t_)); F.tid = t_; F.lane = t_ & 63; F.wave = __builtin_amdgcn_readfirstlane(t_ >> 6); KArgs* ap_ = kap; asm volatile("" : "+s"(ap_)); KArgs& A = *ap_
#define REPS(k) for (int rep = (args.rep_phase == (k)) ? args.rep_n : 0; rep >= 0; --rep)
    if (IN(0)) REPS(0) { REFRESH(); p0_prep(F, A); GRID_BAR(); }
    if (IN(1)) REPS(1) { REFRESH();
        pg8::DenseOrder S; S.init(WS_XB, WS_WIN, MTOK, NPROJ, DM, F.G, F.bx);
        pg8::EpiP E{(bf16_t*)A.out, (unsigned)WS_RSTD1};
        pg8::gemm_phase<pg8::EpiP, pg8::DenseOrder, false, false>(F.lds, rsrc, F.tid, DM * 2, S, E);
        GRID_BAR();
    }
    if (IN(2)) REPS(2) { REFRESH();
        for (int r2 = (A.rep_phase == 20) ? A.rep_n : 0; r2 >= 0; --r2)
        for (int si = F.bx; si < 256; si += F.G) lru_super_item<1>(F, A, si);
        for (int r2 = (A.rep_phase == 21) ? A.rep_n : 0; r2 >= 0; --r2)
        for (int it = F.bx; it < 512; it += F.G) fft1_item(F, (const bf16_t*)A.out, (u32x2*)(ws + WS_V), it);
        GRID_BAR();
    }
    if (IN(3)) REPS(3) { REFRESH();
        for (int r2 = (A.rep_phase == 30) ? A.rep_n : 0; r2 >= 0; --r2)
        for (int si = F.bx; si < 256; si += F.G) lru_super_item<2>(F, A, si);
        for (int r2 = (A.rep_phase == 31) ? A.rep_n : 0; r2 >= 0; --r2)
        for (int it = F.bx; it < NB * 16 * 8; it += F.G) { const int cc = it & 7, kk = (it >> 3) & 15, b = it >> 7;
            if (kk == 0) { fft2_item(F, (const u32x2*)(ws + WS_V), (bf16_t*)(ws + WS_A2), b, 0, cc); fft2_item(F, (const u32x2*)(ws + WS_V), (bf16_t*)(ws + WS_A2), b, 16, cc); }
            else fft2_item(F, (const u32x2*)(ws + WS_V), (bf16_t*)(ws + WS_A2), b, kk, cc); }
        GRID_BAR();
    }
    if (IN(4)) REPS(4) { REFRESH();
        pg8::DenseOrder S; S.init(WS_A2, WS_W2, MTOK, DM, KOUT, F.G, F.bx);
        pg8::EpiD E{(bf16_t*)(ws + WS_DELTA), (const bf16_t*)(ws + WS_XB)};
        pg8::gemm_phase<pg8::EpiD, pg8::DenseOrder, false, false>(F.lds, rsrc, F.tid, KOUT * 2, S, E);
        GRID_BAR();
    }
    if (IN(5)) REPS(5) { REFRESH(); p5_router(F, A); GRID_BAR(); }
    if (IN(6)) REPS(6) { REFRESH();
        if (F.G > NB * NEXP) { if (F.bx < NB * NEXP) p6_topk_item(F, A, F.bx); else expert_w_items(F, A, 2, (F.bx - NB * NEXP) * NWAVES + F.wave, (F.G - NB * NEXP) * NWAVES, WD_SPLIT, 8192); }
        else { for (int it = F.bx; it < NB * NEXP; it += F.G) p6_topk_item(F, A, it); expert_w_items(F, A, 2, F.bx * NWAVES + F.wave, F.G * NWAVES, WD_SPLIT, 8192); }
        GRID_BAR(); }
#if !DBG_NO_MOE
    if (IN(7)) REPS(7) { REFRESH();
        pg8::G1Order S{(unsigned)WS_H2, (unsigned)WS_WGU, (const int*)(ws + WS_TOK), F.G, F.bx};
        pg8::EpiH E{(unsigned char*)(ws + WS_H), (unsigned)WS_RS};
        pg8::gemm_phase<pg8::EpiH, pg8::G1Order, true, true>(F.lds, rsrc, F.tid, DM, S, E);
        GRID_BAR();
    }
    if (IN(8)) REPS(8) { REFRESH();
        pg8::G2Order S{(unsigned)WS_H, (unsigned)WS_WD, F.G, F.bx};
        pg8::EpiEo E{(unsigned char*)(ws + WS_EO), (unsigned)WS_GATE};
        pg8::gemm_phase<pg8::EpiEo, pg8::G2Order, false, true>(F.lds, rsrc, F.tid, DFF, S, E);
        GRID_BAR();
    }
#endif
    if (IN(9)) REPS(9) { REFRESH(); p9_final(F, A, rep > 0 ? (float*)(ws + WS_H) : A.out); if (rep > 0) GRID_BAR(); }
#undef IN
}

extern "C" void kernel_launch(void* const* d_in, const int* in_sizes, int n_in, void* d_out, int out_size, void* d_ws, size_t ws_size, hipStream_t stream) {
    static int grid = 0;
    if (grid == 0) {
        if (n_in != 22 || out_size != MTOK * DM || ws_size < WS_END) { fprintf(stderr, "kernel_launch: unexpected problem (n_in %d out %d ws %zu)\n", n_in, out_size, ws_size); grid = -1; return; }
        int dev = 0, cus = 0, per_cu = 0;
        (void)hipGetDevice(&dev);
        (void)hipDeviceGetAttribute(&cus, hipDeviceAttributeMultiprocessorCount, dev);
        (void)hipFuncSetAttribute((const void*)fwd, hipFuncAttributeMaxDynamicSharedMemorySize, LDS_BYTES);
        (void)hipOccupancyMaxActiveBlocksPerMultiprocessor(&per_cu, (const void*)fwd, NTHREADS, LDS_BYTES);
        (void)hipGetLastError();
        if (per_cu < 1) { fprintf(stderr, "kernel_launch: occupancy query says %d workgroups per CU; nothing launched\n", per_cu); grid = -1; return; }
        grid = cus * 1;
    }
    if (grid < 0) return;
    (void)hipMemsetAsync((char*)d_ws + WS_CTL, 0, 65536, stream);
    Args a{};
    for (int i = 0; i < 22; ++i) a.in[i] = (const float*)d_in[i];
    a.out = (float*)d_out; a.ws = (unsigned char*)d_ws; a.rep_phase = REPEAT_PHASE; a.rep_n = REPEAT_N;
#if N_LAUNCH_PER_PHASE
    for (int p = 0; p < 10; ++p) { a.ph_lo = p; a.ph_hi = p + 1; hipLaunchKernelGGL(fwd, dim3(grid), dim3(NTHREADS), LDS_BYTES, stream, a); }
#else
    a.ph_lo = 0; a.ph_hi = 10;
    void* kargs[] = {&a};
#if USE_COOP
    hipError_t e = hipLaunchCooperativeKernel((const void*)fwd, dim3(grid), dim3(NTHREADS), kargs, LDS_BYTES, stream);
    if (e != hipSuccess) fprintf(stderr, "cooperative launch failed: %s (grid %d)\n", hipGetErrorString(e), grid);
#else
    (void)kargs; hipLaunchKernelGGL(fwd, dim3(grid), dim3(NTHREADS), LDS_BYTES, stream, a);
#endif
#endif
}
```

```cpp
#include <hip/hip_runtime.h>
#include <hip/hip_cooperative_groups.h>
#include <cstdio>
#include <cstdint>
namespace cg = cooperative_groups;

#ifndef USE_COOP
#define USE_COOP 2
#endif
#ifndef N_LAUNCH_PER_PHASE
#define N_LAUNCH_PER_PHASE 0
#endif
#ifndef DBG_NO_MOE
#define DBG_NO_MOE 0
#endif

#ifndef REPEAT_PHASE
#define REPEAT_PHASE -1
#endif
#ifndef REPEAT_N
#define REPEAT_N 0
#endif
#define LAS __attribute__((address_space(3)))
typedef unsigned short bf16_t;
typedef short bf16x8 __attribute__((ext_vector_type(8)));
typedef float f32x4 __attribute__((ext_vector_type(4)));
typedef float f32x2 __attribute__((ext_vector_type(2)));
typedef unsigned u32x4 __attribute__((ext_vector_type(4)));
typedef unsigned u32x2 __attribute__((ext_vector_type(2)));
typedef int i32x4 __attribute__((ext_vector_type(4)));
typedef int i32x8 __attribute__((ext_vector_type(8)));

constexpr int NB = 4, SEQ = 8192, DM = 1024, MTOK = NB * SEQ;
constexpr int DLRU = 512, NHEAD = 8, HDIM = 64, NPROJ = 1536, KOUT = 1536;
constexpr int NEXP = 16, CAP = 1024, DFF = 2048, EROWS = NB * CAP;
constexpr float EPS = 1e-6f;
constexpr int NTHREADS = 512, NWAVES = 8;
constexpr int LDS_BYTES = 147456;
constexpr int MISC_OFF = 131072 + 8192;

constexpr size_t KiB = 1024, MiB = 1u << 20;
constexpr size_t WS_CTL = 0;
constexpr size_t WS_RSTD1 = 64 * KiB;
constexpr size_t WS_WGT = 256 * KiB;
constexpr size_t WS_IDX = 512 * KiB;
constexpr size_t WS_GATE = 768 * KiB;
constexpr size_t WS_AGG = 1 * MiB;
constexpr size_t WS_SCORES = 3 * MiB;
constexpr size_t WS_INV = 5 * MiB;
constexpr size_t WS_RS = 7 * MiB;
constexpr size_t WS_TOK = 7 * MiB + 256 * KiB;
constexpr size_t WS_WGU = 8 * MiB;
constexpr size_t WS_EO = 8 * MiB;
constexpr size_t WS_WD = 136 * MiB;
constexpr size_t WS_H = 200 * MiB;
constexpr size_t WS_XB = 436 * MiB;
constexpr size_t WS_V = 200 * MiB;
constexpr size_t WS_A2 = 270 * MiB;
constexpr size_t WS_WIN = 366 * MiB;
constexpr size_t WS_W2 = 369 * MiB;
constexpr size_t WS_DELTA = 372 * MiB;
constexpr size_t WS_H2 = 168 * MiB;
constexpr size_t WS_END = 520 * MiB;

typedef __bf16 bf16x2_t __attribute__((ext_vector_type(2)));
__device__ __forceinline__ unsigned f2bf(float f) { return (unsigned)__builtin_bit_cast(unsigned short, (__bf16)f); }
__device__ __forceinline__ unsigned pk2(float lo, float hi) { bf16x2_t v; v.x = (__bf16)lo; v.y = (__bf16)hi; return __builtin_bit_cast(unsigned, v); }
__device__ __forceinline__ unsigned cvt_pk_bf16(float lo, float hi) { unsigned r; asm volatile("v_cvt_pk_bf16_f32 %0, %1, %2" : "=v"(r) : "v"(lo), "v"(hi)); return r; }
__device__ __forceinline__ float bf2f(unsigned h) { return __builtin_bit_cast(float, h << 16); }
__device__ __forceinline__ float wave_sum(float v) {
#pragma unroll
    for (int o = 1; o < 64; o <<= 1) v += __shfl_xor(v, o);
    return v;
}
__device__ __forceinline__ float fast_sigmoid(float x) { return __builtin_amdgcn_rcpf(1.0f + __builtin_amdgcn_exp2f(-1.4426950408889634f * x)); }
__device__ __forceinline__ unsigned pk4_fp8(float a, float b, float c, float d) { int w = 0; w = __builtin_amdgcn_cvt_pk_fp8_f32(a, b, w, false); w = __builtin_amdgcn_cvt_pk_fp8_f32(c, d, w, true); return (unsigned)w; }
__device__ __forceinline__ float xchg16(float v, int lane) { const unsigned u = __builtin_bit_cast(unsigned, v); const auto r = __builtin_amdgcn_permlane16_swap(u, u, false, false); return __builtin_bit_cast(float, (lane & 16) ? r[0] : r[1]); }
__device__ __forceinline__ float xchg32(float v, int lane) { const unsigned u = __builtin_bit_cast(unsigned, v); const auto r = __builtin_amdgcn_permlane32_swap(u, u, false, false); return __builtin_bit_cast(float, (lane & 32) ? r[0] : r[1]); }
#define LDS_WAIT() asm volatile("s_waitcnt lgkmcnt(0)" ::: "memory")

#define XB_TMO      128
#define XB_XCNT(j)  (256  + 64 * (j))
#define XB_XSUB(j)  (1280 + 64 * (j))
#define XB_XGEN(j)  (2304 + 64 * (j))
#define XB_TOP      3328
#define XB_TOPGEN   3392
#define XCD_BAR_WORDS 3456
#define XB_SPIN_CAP (1u << 20)
__device__ __forceinline__ unsigned xb_ld(unsigned* p)              { return __hip_atomic_load(p, __ATOMIC_RELAXED, __HIP_MEMORY_SCOPE_AGENT); }
__device__ __forceinline__ unsigned xb_add(unsigned* p, unsigned v) { return __hip_atomic_fetch_add(p, v, __ATOMIC_RELAXED, __HIP_MEMORY_SCOPE_AGENT); }
__device__ __forceinline__ unsigned xb_xcc_id() { return (unsigned)__builtin_amdgcn_s_getreg((3 << 11) | 20) & 0xFu; }
#define XB_SPIN(cond, bar) do { unsigned _sp = 0; while (cond) { __builtin_amdgcn_s_sleep(1); \
    if ((++_sp & 255u) == 0u) { if (xb_ld(&(bar)[XB_TMO])) break; if (_sp > XB_SPIN_CAP) { atomicAdd(&(bar)[XB_TMO], 1u); break; } } } } while (0)
struct XcdBarrier { unsigned* bar; unsigned x; volatile LAS unsigned* st; };
__device__ __forceinline__ XcdBarrier xcd_barrier_post(unsigned* bar, volatile LAS unsigned* st) {
    XcdBarrier b; b.bar = bar; b.x = xb_xcc_id(); b.st = st;
    if (threadIdx.x == 0) (void)xb_add(&bar[XB_XCNT(b.x)], 1u);
    return b;
}
__device__ __forceinline__ void xcd_barrier_complete(unsigned* bar, unsigned x, unsigned& nloc, unsigned& nx) {
    const unsigned G = gridDim.x * gridDim.y * gridDim.z;
    unsigned sum, cnt, mine, sp = 0u;
    for (;;) {
        sum = 0u; cnt = 0u; mine = 0u;
#pragma unroll
        for (unsigned j = 0; j < 16; ++j) { const unsigned c = xb_ld(&bar[XB_XCNT(j)]); sum += c; cnt += (c > 0u) ? 1u : 0u; mine = (j == x) ? c : mine; }
        if (sum == G) break;
        __builtin_amdgcn_s_sleep(1);
        if ((++sp & 255u) == 0u) { if (xb_ld(&bar[XB_TMO])) break; if (sp > XB_SPIN_CAP) { atomicAdd(&bar[XB_TMO], 1u); break; } }
    }
    nloc = mine > 0u ? mine : 1u; nx = cnt > 0u ? cnt : 1u;
}
__device__ __forceinline__ void xcd_barrier(const XcdBarrier& b) {
    asm volatile("s_waitcnt vmcnt(0)" ::: "memory");
    __syncthreads();
    if (threadIdx.x == 0) {
        unsigned* bar = b.bar;
        __builtin_amdgcn_s_waitcnt(0);
        unsigned nloc = b.st[0], nx = b.st[1];
        if (nloc == 0u) { xcd_barrier_complete(bar, b.x, nloc, nx); b.st[0] = nloc; b.st[1] = nx; }
        const unsigned old = xb_add(&bar[XB_XSUB(b.x)], 1u);
        const unsigned gen = old / nloc;
        if (old + 1u == (gen + 1u) * nloc) {
            __builtin_amdgcn_fence(__ATOMIC_RELEASE, "agent");
            asm volatile("s_waitcnt vmcnt(0)" ::: "memory");
            const unsigned og = xb_add(&bar[XB_TOP], 1u);
            const unsigned tg = og / nx;
            if (og + 1u == (tg + 1u) * nx) xb_add(&bar[XB_TOPGEN], 1u);
            else XB_SPIN(xb_ld(&bar[XB_TOPGEN]) == tg, bar);
            __builtin_amdgcn_fence(__ATOMIC_ACQUIRE, "agent");
            xb_add(&bar[XB_XGEN(b.x)], 1u);
            asm volatile("s_waitcnt vmcnt(0)" ::: "memory");
        } else {
            XB_SPIN(xb_ld(&bar[XB_XGEN(b.x)]) == gen, bar);
            __builtin_amdgcn_fence(__ATOMIC_ACQUIRE, "agent");
            asm volatile("s_waitcnt vmcnt(0)" ::: "memory");
        }
    }
    __syncthreads();
}

namespace pg8 {
constexpr int BM = 256, BK = 64, HALF = 128, HTB = HALF * BK * 2, STAGE_BYTES = 8 * HTB, NXCD = 8, WGM = 8;
__host__ __device__ __forceinline__ int lds_byte(int r, int c) { return r * 128 + ((((c >> 3) ^ (r >> 1)) & 7) << 4) + (c & 7) * 2; }
__host__ __device__ __forceinline__ void stage_rc(int b, int& R, int& C) { R = b >> 7; C = ((((b >> 4) ^ (R >> 1)) & 7) << 3); }
__host__ __device__ __forceinline__ int perm32(int rho) { const int n = rho >> 4, i = rho & 15; return 8 * (i >> 2) + 4 * n + (i & 3); }

struct Unit { unsigned a, b; int row0, col0; };

struct DenseOrder {
    unsigned A, Bt; int K, nM, nN, nwg, G, c;
    __device__ void init(size_t A_, size_t Bt_, int M, int N, int K_, int G_, int c_) { A = (unsigned)A_; Bt = (unsigned)Bt_; K = K_; nM = M / BM; nN = N / BM; nwg = nM * nN; G = G_; c = c_; }
    __device__ bool next(int i, Unit& u) const {
        const long L = (long)i * G + c; if (L >= nwg) return false;
        int wgid = (int)L; { const int q = nwg / NXCD, r = nwg % NXCD, xcd = wgid % NXCD, off = wgid / NXCD; wgid = (xcd < r ? xcd * (q + 1) : r * (q + 1) + (xcd - r) * q) + off; }
        const int nig = WGM * nN, gid = wgid / nig, fm = gid * WGM, gsz = (nM - fm) < WGM ? (nM - fm) : WGM;
        const int pm = fm + ((wgid % nig) % gsz), pn = (wgid % nig) / gsz;
        u.a = A + (unsigned)(pm * BM * K * 2); u.b = Bt + (unsigned)(pn * BM * K * 2); u.row0 = pm * BM; u.col0 = pn * BM; return true;
    }
    __device__ __forceinline__ int arow(const Unit&, int) const { return 0; }
    __device__ __forceinline__ unsigned tokoff() const { return 0u; }
};
struct G1Order {
    unsigned h2, wgu; const int* tok; int G, c;
    __device__ bool next(int i, Unit& u) const {
        const long L = (long)i * G + c; if (L >= 4096) return false;
        const int e = (int)(L >> 8), w = (int)(L & 255), xcd = w & 7, l = w >> 3;
        const int pm = 4 * (xcd & 3) + (l & 3), pn = 8 * (xcd >> 2) + (l >> 2);
        u.a = h2; u.b = wgu + (unsigned)((e * 4096 + pn * 256) * DM); u.row0 = e * EROWS + pm * 256; u.col0 = pn * 128; return true;
    }
    __device__ __forceinline__ int arow(const Unit& u, int r) const { return tok[u.row0 + r]; }
    __device__ __forceinline__ unsigned tokoff() const { return (unsigned)WS_TOK; }
};
struct G2Order {
    unsigned H, wd; int G, c;
    __device__ bool next(int i, Unit& u) const {
        const long L = (long)i * G + c; if (L >= 1024) return false;
        const int r4 = (int)(L >> 8), w = (int)(L & 255), xcd = w & 7, l = w >> 3;
        const int e = 4 * r4 + (xcd >> 1), pm = 8 * (xcd & 1) + (l & 7), pn = l >> 3;
        u.a = H + (unsigned)((e * EROWS + pm * 256) * DFF); u.b = wd + (unsigned)((e * DM + pn * 256) * DFF); u.row0 = e * EROWS + pm * 256; u.col0 = pn * 256; return true;
    }
    __device__ __forceinline__ int arow(const Unit&, int) const { return 0; }
    __device__ __forceinline__ unsigned tokoff() const { return 0u; }
};

struct EpiP {
    static constexpr bool PERM = true, HAS_SCALE = true;
    bf16_t* P; unsigned soff;
    __device__ __forceinline__ unsigned scale_off() const { return soff; }
    __device__ __forceinline__ void operator()(const f32x4 (&acc)[2][2][4][2], const Unit& u, int wr, int wc, int fr, int fq, const LAS float* scl) const {
        const int row0 = u.row0 + wr * 64 + fr, col0 = u.col0 + wc * 32 + 8 * fq;
#pragma unroll
        for (int ai = 0; ai < 2; ++ai)
#pragma unroll
            for (int m = 0; m < 4; ++m) { const int r = row0 + ai * HALF + m * 16; const float rs = scl[wr * 64 + fr + ai * HALF + m * 16]; bf16_t* rowp = P + (size_t)r * NPROJ + col0;
#pragma unroll
                for (int bj = 0; bj < 2; ++bj) { const f32x4 v0 = acc[ai][bj][m][0] * rs, v1 = acc[ai][bj][m][1] * rs;
                    u32x4 w; w.x = cvt_pk_bf16(v0[0], v0[1]); w.y = cvt_pk_bf16(v0[2], v0[3]); w.z = cvt_pk_bf16(v1[0], v1[1]); w.w = cvt_pk_bf16(v1[2], v1[3]);
                    *(u32x4*)(rowp + bj * HALF) = w; } }
    }
};
struct EpiD {
    static constexpr bool PERM = true, HAS_SCALE = false;
    bf16_t* O; const bf16_t* XB;
    __device__ __forceinline__ unsigned scale_off() const { return 0u; }
    __device__ __forceinline__ void operator()(const f32x4 (&acc)[2][2][4][2], const Unit& u, int wr, int wc, int fr, int fq, const LAS float*) const {
        const int row0 = u.row0 + wr * 64 + fr, col0 = u.col0 + wc * 32 + 8 * fq;
#pragma unroll
        for (int ai = 0; ai < 2; ++ai) { u32x4 xv[4][2];
#pragma unroll
            for (int m = 0; m < 4; ++m)
#pragma unroll
                for (int bj = 0; bj < 2; ++bj) xv[m][bj] = *(const u32x4*)(XB + (size_t)(row0 + ai * HALF + m * 16) * DM + col0 + bj * HALF);
#pragma unroll
            for (int m = 0; m < 4; ++m) { bf16_t* rowp = O + (size_t)(row0 + ai * HALF + m * 16) * DM + col0;
#pragma unroll
                for (int bj = 0; bj < 2; ++bj) { const f32x4 v0 = acc[ai][bj][m][0], v1 = acc[ai][bj][m][1]; const u32x4 x = xv[m][bj];
                    u32x4 w; w.x = cvt_pk_bf16(v0[0] + bf2f(x.x & 0xffffu), v0[1] + bf2f(x.x >> 16)); w.y = cvt_pk_bf16(v0[2] + bf2f(x.y & 0xffffu), v0[3] + bf2f(x.y >> 16));
                    w.z = cvt_pk_bf16(v1[0] + bf2f(x.z & 0xffffu), v1[1] + bf2f(x.z >> 16)); w.w = cvt_pk_bf16(v1[2] + bf2f(x.w & 0xffffu), v1[3] + bf2f(x.w >> 16));
                    *(u32x4*)(rowp + bj * HALF) = w; } } }
    }
};
struct EpiH {
    static constexpr bool PERM = true, HAS_SCALE = true;
    unsigned char* Hh; unsigned soff;
    __device__ __forceinline__ unsigned scale_off() const { return soff; }
    __device__ __forceinline__ void operator()(const f32x4 (&acc)[2][2][4][2], const Unit& u, int wr, int wc, int fr, int fq, const LAS float* scl) const {
        const int row0 = u.row0 + wr * 64 + fr, col0 = u.col0 + wc * 32 + 8 * fq;
#pragma unroll
        for (int ai = 0; ai < 2; ++ai)
#pragma unroll
            for (int m = 0; m < 4; ++m) { const int r = row0 + ai * HALF + m * 16; unsigned char* rowp = Hh + (size_t)r * DFF + col0; const float rsc = scl[wr * 64 + fr + ai * HALF + m * 16] * 0.03125f;
                float h[8]; const float ke = -1.4426950408889634f * rsc, k2 = rsc * rsc;
#pragma unroll
                for (int n = 0; n < 2; ++n)
#pragma unroll
                    for (int jp = 0; jp < 2; ++jp) { const f32x2 ag = (f32x2){acc[ai][0][m][n][2 * jp], acc[ai][0][m][n][2 * jp + 1]}, au = (f32x2){acc[ai][1][m][n][2 * jp], acc[ai][1][m][n][2 * jp + 1]};
                        const f32x2 ex = ag * ke; f32x2 d; d.x = __builtin_amdgcn_exp2f(ex.x); d.y = __builtin_amdgcn_exp2f(ex.y); d = d + 1.0f;
                        f32x2 rc; rc.x = __builtin_amdgcn_rcpf(d.x); rc.y = __builtin_amdgcn_rcpf(d.y);
                        const f32x2 hv = (ag * au) * k2 * rc; h[n * 4 + 2 * jp] = hv.x; h[n * 4 + 2 * jp + 1] = hv.y; }
                u32x2 w; w.x = pk4_fp8(h[0], h[1], h[2], h[3]); w.y = pk4_fp8(h[4], h[5], h[6], h[7]);
                *(u32x2*)rowp = w; }
    }
};
struct EpiEo {
    static constexpr bool PERM = true, HAS_SCALE = true;
    unsigned char* O; unsigned soff;
    __device__ __forceinline__ unsigned scale_off() const { return soff; }
    __device__ __forceinline__ void operator()(const f32x4 (&acc)[2][2][4][2], const Unit& u, int wr, int wc, int fr, int fq, const LAS float* scl) const {
        const int row0 = u.row0 + wr * 64 + fr, col0 = u.col0 + wc * 32 + 8 * fq;
#pragma unroll
        for (int ai = 0; ai < 2; ++ai)
#pragma unroll
            for (int m = 0; m < 4; ++m) { const int r = row0 + ai * HALF + m * 16; const float gs = scl[wr * 64 + fr + ai * HALF + m * 16] * 0.5f; unsigned char* rowp = O + (size_t)r * DM + col0;
#pragma unroll
                for (int bj = 0; bj < 2; ++bj) { const f32x4 v0 = acc[ai][bj][m][0] * gs, v1 = acc[ai][bj][m][1] * gs;
                    u32x2 w; w.x = pk4_fp8(v0[0], v0[1], v0[2], v0[3]); w.y = pk4_fp8(v1[0], v1[1], v1[2], v1[3]);
                    *(u32x2*)(rowp + bj * HALF) = w; } }
    }
};

template <class Epi, class Sched, bool GATHER, bool FP8>
__device__ __forceinline__ void gemm_phase(LAS unsigned char* lds, const __amdgpu_buffer_rsrc_t rs, const int tid, const int KB, const Sched& S, const Epi& E) {
    const int wid = __builtin_amdgcn_readfirstlane(tid >> 6), lane = tid & 63, wr = wid >> 2, wc = wid & 3, fr = lane & 15, fq = lane >> 4;
    const int nt = KB / 128;
    int RA[2], CA[2];
    unsigned voffA[2][2], voffB[2];
#pragma unroll
    for (int i = 0; i < 2; ++i) { int R, C; stage_rc(tid * 16 + i * 8192, R, C); const int Rb = Epi::PERM ? ((R & ~31) + perm32(R & 31)) : R;
        RA[i] = R; CA[i] = C; voffB[i] = (unsigned)(Rb * KB + C * 2); }
    const unsigned kstep = 128u;
    const unsigned hstep = (unsigned)(HALF * KB);
    const unsigned ldsw = (unsigned)wid * 1024u;
    const int aoff = lds_byte(wr * 64 + fr, fq * 8), boff = lds_byte(wc * 32 + fr, fq * 8);
    const int aoff1 = lds_byte(wr * 64 + fr, 32 + fq * 8), boff1 = lds_byte(wc * 32 + fr, 32 + fq * 8);
#define PG8_SA(b, h) (((b) * 2 + (h)) * HTB)
#define PG8_SB(b, h) ((4 + (b) * 2 + (h)) * HTB)
#define PG8_STAGE(bufoff, gbase, voff) do { _Pragma("unroll") for (int _i = 0; _i < 2; ++_i) \
        __builtin_amdgcn_raw_ptr_buffer_load_lds(rs, (LAS void*)(lds + (bufoff) + ldsw + _i * 8192), 16, (int)(voff)[_i], (int)(gbase), 0, 0); } while (0)
#define PG8_STAGE_A(bufoff, gbase, h) do { if constexpr (GATHER) { PG8_STAGE(bufoff, gbase, voffA[h]); } else { PG8_STAGE(bufoff, (gbase) + (h) * hstep, voffA[0]); } } while (0)
#define PG8_LDA(dst, b, h) do { _Pragma("unroll") for (int m = 0; m < 4; ++m) { const i32x4 _lo = *(const LAS i32x4*)(lds + PG8_SA(b, h) + aoff + m * 2048), _hi = *(const LAS i32x4*)(lds + PG8_SA(b, h) + aoff1 + m * 2048); \
        dst[m] = __builtin_shufflevector(_lo, _hi, 0, 1, 2, 3, 4, 5, 6, 7); } } while (0)
#define PG8_LDB(dst, b, h) do { _Pragma("unroll") for (int n = 0; n < 2; ++n) { const i32x4 _lo = *(const LAS i32x4*)(lds + PG8_SB(b, h) + boff + n * 2048), _hi = *(const LAS i32x4*)(lds + PG8_SB(b, h) + boff1 + n * 2048); \
        dst[n] = __builtin_shufflevector(_lo, _hi, 0, 1, 2, 3, 4, 5, 6, 7); } } while (0)
#define PG8_MMA(ai, bj, At, Bt) do { __builtin_amdgcn_s_setprio(1); _Pragma("unroll") for (int m = 0; m < 4; ++m) _Pragma("unroll") for (int n = 0; n < 2; ++n) { \
        if constexpr (FP8) asm volatile("v_mfma_scale_f32_16x16x128_f8f6f4 %0, %1, %2, %0, %3, %3 op_sel_hi:[0,0,0]" : "+v"(acc[ai][bj][m][n]) : "v"(Bt[n]), "v"(At[m]), "v"(sc1)); \
        else { acc[ai][bj][m][n] = __builtin_amdgcn_mfma_f32_16x16x32_bf16((bf16x8)__builtin_shufflevector(Bt[n], Bt[n], 0, 1, 2, 3), (bf16x8)__builtin_shufflevector(At[m], At[m], 0, 1, 2, 3), acc[ai][bj][m][n], 0, 0, 0); \
               acc[ai][bj][m][n] = __builtin_amdgcn_mfma_f32_16x16x32_bf16((bf16x8)__builtin_shufflevector(Bt[n], Bt[n], 4, 5, 6, 7), (bf16x8)__builtin_shufflevector(At[m], At[m], 4, 5, 6, 7), acc[ai][bj][m][n], 0, 0, 0); } } \
        __builtin_amdgcn_s_setprio(0); } while (0)
#define PG8_WAIT_V(n) asm volatile("s_waitcnt vmcnt(" #n ")" ::: "memory")
#define PG8_WAIT_L(n) asm volatile("s_waitcnt lgkmcnt(" #n ")" ::: "memory")
#define PG8_BAR __builtin_amdgcn_s_barrier()
#define PG8_SCHED __builtin_amdgcn_sched_barrier(0)
#define PG8_SETVOFF(dst, unit) do { _Pragma("unroll") for (int _h = 0; _h < 2; ++_h) _Pragma("unroll") for (int _i = 0; _i < 2; ++_i) { \
        if constexpr (GATHER) dst[_h][_i] = (unsigned)(S.arow(unit, _h * HALF + RA[_i]) * KB + CA[_i] * 2); \
        else dst[_h][_i] = (unsigned)(RA[_i] * KB + CA[_i] * 2); } } while (0)
    Unit cur, nxt; int ui = 0;
    if (!S.next(0, cur)) return;
    int sc1 = 0x7f7f7f7f; asm volatile("" : "+v"(sc1));
    f32x4 acc[2][2][4][2];
#pragma unroll
    for (int a = 0; a < 2; ++a)
#pragma unroll
        for (int b = 0; b < 2; ++b)
#pragma unroll
            for (int m = 0; m < 4; ++m)
#pragma unroll
                for (int n = 0; n < 2; ++n) acc[a][b][m][n] = (f32x4){0.f, 0.f, 0.f, 0.f};
    i32x8 At[4], B0[2], B1[2];
    unsigned cA = cur.a, cB = cur.b;
    PG8_SETVOFF(voffA, cur);
    PG8_STAGE(PG8_SB(0, 0), cB, voffB); PG8_STAGE(PG8_SB(0, 1), cB + hstep, voffB); PG8_STAGE_A(PG8_SA(0, 0), cA, 0); PG8_STAGE_A(PG8_SA(0, 1), cA, 1);
    if (wr == 1) PG8_BAR;
    PG8_WAIT_V(2); PG8_BAR;
    PG8_STAGE(PG8_SB(1, 0), cB + kstep, voffB); PG8_STAGE_A(PG8_SA(1, 0), cA + kstep, 0); PG8_STAGE(PG8_SB(1, 1), cB + hstep + kstep, voffB);
    PG8_WAIT_V(6); PG8_BAR;
    for (;;) {
        const bool has_next = S.next(ui + 1, nxt);
        const unsigned nA = has_next ? nxt.a : cA, nB = has_next ? nxt.b : cB;
#pragma clang loop unroll(disable)
        for (int t = 0; t < nt; t += 2) {
            const bool last = (t == nt - 2);
            const unsigned a1 = cA + (unsigned)(t + 1) * kstep;
            const unsigned a2 = last ? nA : cA + (unsigned)(t + 2) * kstep, b2 = last ? nB : cB + (unsigned)(t + 2) * kstep;
            const unsigned a3 = a2 + kstep, b3 = b2 + kstep;
            unsigned nvoff[2][2];
            if constexpr (Epi::HAS_SCALE) { if (t == 0)
                    __builtin_amdgcn_raw_ptr_buffer_load_lds(rs, (LAS void*)(lds + 133120 + (ui & 1) * 2048 + (wid >> 2) * 1024 + (wid & 3) * 256), 4, (int)(lane * 4), (int)(E.scale_off() + (unsigned)(cur.row0 + (wid & 3) * 64) * 4u), 0, 0); }
            if constexpr (GATHER) {
                if (t == 0 && has_next)
                    __builtin_amdgcn_raw_ptr_buffer_load_lds(rs, (LAS void*)(lds + 131072 + (wid >> 2) * 1024 + (wid & 3) * 256), 4, (int)(lane * 4), (int)(S.tokoff() + (unsigned)(nxt.row0 + (wid & 3) * 64) * 4u), 0, 0);
                if (last && has_next) {
#pragma unroll
                    for (int _h = 0; _h < 2; ++_h)
#pragma unroll
                        for (int _i = 0; _i < 2; ++_i) nvoff[_h][_i] = (unsigned)(*(const LAS int*)(lds + 131072 + (_h * HALF + RA[_i]) * 4) * KB + CA[_i] * 2); } }
            PG8_LDB(B0, 0, 0); PG8_LDB(B1, 0, 1); PG8_SCHED; PG8_LDA(At, 0, 0); PG8_STAGE_A(PG8_SA(1, 1), a1, 1);
            PG8_WAIT_V(8); PG8_WAIT_L(0); PG8_BAR; PG8_MMA(0, 0, At, B0); PG8_MMA(0, 1, At, B1); PG8_BAR; PG8_SCHED;
            if constexpr (GATHER) { if (last && has_next) {
#pragma unroll
                for (int _h = 0; _h < 2; ++_h)
#pragma unroll
                    for (int _i = 0; _i < 2; ++_i) voffA[_h][_i] = nvoff[_h][_i]; } }
            PG8_LDA(At, 0, 1); PG8_STAGE(PG8_SB(0, 0), b2, voffB); PG8_STAGE(PG8_SB(0, 1), b2 + hstep, voffB);
            PG8_WAIT_V(6); PG8_WAIT_L(0); PG8_BAR; PG8_MMA(1, 0, At, B0); PG8_SCHED; PG8_STAGE_A(PG8_SA(0, 0), a2, 0); PG8_SCHED; PG8_MMA(1, 1, At, B1); PG8_BAR; PG8_SCHED;
            PG8_LDB(B0, 1, 0); PG8_LDB(B1, 1, 1); PG8_SCHED; PG8_LDA(At, 1, 0); PG8_STAGE_A(PG8_SA(0, 1), a2, 1);
            PG8_WAIT_V(8); PG8_WAIT_L(0); PG8_BAR; PG8_MMA(0, 0, At, B0); PG8_MMA(0, 1, At, B1); PG8_BAR; PG8_SCHED;
            PG8_LDA(At, 1, 1); PG8_STAGE(PG8_SB(1, 0), b3, voffB); PG8_STAGE(PG8_SB(1, 1), b3 + hstep, voffB);
            PG8_WAIT_V(6); PG8_WAIT_L(0); PG8_BAR; PG8_MMA(1, 0, At, B0); PG8_SCHED; PG8_STAGE_A(PG8_SA(1, 0), a3, 0); PG8_SCHED; PG8_MMA(1, 1, At, B1); PG8_BAR; PG8_SCHED;
        }
        if (wr == 0) PG8_BAR;
        if constexpr (FP8) asm volatile("s_nop 15\n\ts_nop 15" ::: "memory");
        E(acc, cur, wr, wc, fr, fq, (const LAS float*)(lds + 133120 + (ui & 1) * 2048));
        if (!has_next) break;
#pragma unroll
        for (int a = 0; a < 2; ++a)
#pragma unroll
            for (int b = 0; b < 2; ++b)
#pragma unroll
                for (int m = 0; m < 4; ++m)
#pragma unroll
                    for (int n = 0; n < 2; ++n) acc[a][b][m][n] = (f32x4){0.f, 0.f, 0.f, 0.f};
        cur = nxt; cA = nA; cB = nB; ++ui;
        if (wr == 1) PG8_BAR;
    }
    PG8_WAIT_V(0);
    PG8_BAR;
#undef PG8_SA
#undef PG8_SB
#undef PG8_STAGE
#undef PG8_STAGE_A
#undef PG8_LDA
#undef PG8_LDB
#undef PG8_MMA
#undef PG8_WAIT_V
#undef PG8_WAIT_L
#undef PG8_BAR
#undef PG8_SCHED
#undef PG8_SETVOFF
}
}

struct Args { const float* in[22]; float* out; unsigned char* ws; int ph_lo, ph_hi, rep_phase, rep_n; };
typedef const __attribute__((address_space(4))) Args KArgs;
struct Frame {
    LAS unsigned char* lds;
    int tid, lane, wave, G, bx, vcu;
};

__device__ __forceinline__ void transpose_item(const float* W, int N, int k0, int n0, bf16_t* WT, int ldk, int drow0, const float* kscale, LAS float* scr, int lane) {
#pragma unroll 8
    for (int i = 0; i < 32; ++i) { const int kk = 2 * i + (lane >> 5); float v = W[(size_t)(k0 + kk) * N + n0 + (lane & 31)]; if (kscale) v *= kscale[k0 + kk]; scr[kk * 33 + (lane & 31)] = v; }
    LDS_WAIT(); asm volatile("" ::: "memory");
    const int c = lane & 7;
#pragma unroll
    for (int j = 0; j < 4; ++j) { const int n = (lane >> 3) + 8 * j; const LAS float* s = scr + (8 * c) * 33 + n;
        u32x4 o; o.x = pk2(s[0 * 33], s[1 * 33]); o.y = pk2(s[2 * 33], s[3 * 33]); o.z = pk2(s[4 * 33], s[5 * 33]); o.w = pk2(s[6 * 33], s[7 * 33]);
        *(u32x4*)(WT + (size_t)(drow0 + n) * ldk + k0 + 8 * c) = o; }
    LDS_WAIT(); asm volatile("" ::: "memory");
}
struct WItem { const float* src; unsigned char* dst; int N, ldk; };
__device__ __forceinline__ WItem w_item(KArgs& a, int which, int r, int lane) {
    unsigned char* ws = a.ws; WItem it; const int e = r >> 9, q = r & 511; const int kq = lane >> 4, n4 = (lane & 15) * 4;
    if (which < 2) { const int kb = q >> 5, nb = q & 31, n0 = nb * 64; it.N = DFF; it.ldk = DM;
        it.src = a.in[18 + which] + (size_t)e * DM * DFF + (size_t)(kb * 64 + kq) * DFF + n0 + n4;
        it.dst = (unsigned char*)(ws + WS_WGU) + (size_t)e * 4096 * DM + (size_t)((n0 >> 7) * 256 + which * 128 + (n0 & 127)) * DM + kb * 64; }
    else { const int kb = q >> 4, nb = q & 15; it.N = DM; it.ldk = DFF;
        it.src = a.in[20] + (size_t)e * DFF * DM + (size_t)(kb * 64 + kq) * DM + nb * 64 + n4;
        it.dst = (unsigned char*)(ws + WS_WD) + (size_t)e * DM * DFF + (size_t)(nb * 64) * DFF + kb * 64; }
    return it;
}
__device__ __forceinline__ void w_load(const WItem& it, f32x4 (&v)[16]) {
#pragma unroll
    for (int i = 0; i < 16; ++i) v[i] = __builtin_nontemporal_load((const f32x4*)(it.src + (size_t)(4 * i) * it.N));
}
__device__ __forceinline__ void w_finish(const WItem& it, const f32x4 (&v)[16], LAS float* scr, int lane) {
    const int kq = lane >> 4, n4 = (lane & 15) * 4;
#pragma unroll
    for (int i = 0; i < 16; ++i) { const int kk = kq + 4 * i; *(LAS f32x4*)(scr + kk * 68 + ((n4 + 8 * (kk >> 4)) & 63)) = v[i] * 32.0f; }
    LDS_WAIT(); asm volatile("" ::: "memory");
    const int nl = lane >> 2, j = lane & 3;
#pragma unroll
    for (int p = 0; p < 4; ++p) { const int n = 16 * p + nl; const LAS float* sp = scr + (16 * j) * 68 + ((n + 8 * j) & 63);
        u32x4 o; o.x = pk4_fp8(sp[0 * 68], sp[1 * 68], sp[2 * 68], sp[3 * 68]); o.y = pk4_fp8(sp[4 * 68], sp[5 * 68], sp[6 * 68], sp[7 * 68]);
        o.z = pk4_fp8(sp[8 * 68], sp[9 * 68], sp[10 * 68], sp[11 * 68]); o.w = pk4_fp8(sp[12 * 68], sp[13 * 68], sp[14 * 68], sp[15 * 68]);
        *(u32x4*)(it.dst + (size_t)n * it.ldk + 16 * j) = o; }
    LDS_WAIT(); asm volatile("" ::: "memory");
}
constexpr int WD_SPLIT = 6144;
__device__ __forceinline__ void expert_w_items(const Frame& F, KArgs& a, int which, int gwi, int ngw, int r_lo = 0, int r_hi = 8192) {
    LAS float* scr = (LAS float*)(F.lds + F.wave * 17408);
    for (int r = r_lo + gwi; r < r_hi; r += ngw) { const WItem it = w_item(a, which, r, F.lane); f32x4 v[16]; w_load(it, v); w_finish(it, v, scr, F.lane); }
}
__device__ __forceinline__ void p0_prep(const Frame& F, KArgs& a) {
    unsigned char* ws = a.ws;
    LAS float* scr = (LAS float*)(F.lds + F.wave * 17408);
    const int gw = F.vcu * NWAVES + F.wave, NGW = F.G * NWAVES;
    for (int r0 = (a.rep_phase == 100) ? a.rep_n : 0; r0 >= 0; --r0) { const float* x = a.in[0]; bf16_t* xb = (bf16_t*)(ws + WS_XB); float* rstd = (float*)(ws + WS_RSTD1);
      for (int m = gw; m < MTOK; m += 2 * NGW) {
          const int m2 = m + NGW;
          const f32x4* xr = (const f32x4*)(x + (size_t)m * DM) + F.lane; const f32x4* xr2 = (const f32x4*)(x + (size_t)(m2 < MTOK ? m2 : m) * DM) + F.lane; f32x4 v[4], v2[4]; float s = 0.f, s2 = 0.f;
#pragma unroll
          for (int j = 0; j < 4; ++j) { v[j] = __builtin_nontemporal_load(xr + 64 * j); v2[j] = __builtin_nontemporal_load(xr2 + 64 * j); }
#pragma unroll
          for (int j = 0; j < 4; ++j) { s += (v[j].x * v[j].x + v[j].y * v[j].y) + (v[j].z * v[j].z + v[j].w * v[j].w); s2 += (v2[j].x * v2[j].x + v2[j].y * v2[j].y) + (v2[j].z * v2[j].z + v2[j].w * v2[j].w); }
          s = wave_sum(s); s2 = wave_sum(s2);
          if (F.lane == 0) { rstd[m] = 1.0f / sqrtf(s * (1.0f / DM) + EPS); if (m2 < MTOK) rstd[m2] = 1.0f / sqrtf(s2 * (1.0f / DM) + EPS); }
          unsigned long long* o8 = (unsigned long long*)(xb + (size_t)m * DM) + F.lane;
#pragma unroll
          for (int j = 0; j < 4; ++j) o8[64 * j] = (unsigned long long)pk2(v[j].x, v[j].y) | ((unsigned long long)pk2(v[j].z, v[j].w) << 32);
          if (m2 < MTOK) { unsigned long long* o82 = (unsigned long long*)(xb + (size_t)m2 * DM) + F.lane;
#pragma unroll
              for (int j = 0; j < 4; ++j) o82[64 * j] = (unsigned long long)pk2(v2[j].x, v2[j].y) | ((unsigned long long)pk2(v2[j].z, v2[j].w) << 32); }
      } }
    for (int r0 = (a.rep_phase == 101) ? a.rep_n : 0; r0 >= 0; --r0) { constexpr int I_WIN = 16 * 48, I_WOUT = 8 * 32;
      bf16_t* WinT = (bf16_t*)(ws + WS_WIN); bf16_t* W2T = (bf16_t*)(ws + WS_W2);
      for (int it = gw; it < I_WIN + I_WOUT; it += NGW) {
          int r = it;
          if (r < I_WIN) { const int kb = r / 48, nb = r % 48; transpose_item(a.in[2], NPROJ, kb * 64, nb * 32, WinT, DM, nb * 32, a.in[1], scr, F.lane); continue; } r -= I_WIN;
          { const int kb = r / 32, nb = r % 32; transpose_item(a.in[15], DM, kb * 64, nb * 32, W2T, KOUT, nb * 32, nullptr, scr, F.lane); }
      } }
    for (int r0 = (a.rep_phase == 102) ? a.rep_n : 0; r0 >= 0; --r0) { expert_w_items(F, a, 0, gw, NGW); expert_w_items(F, a, 1, gw, NGW); expert_w_items(F, a, 2, gw, NGW, 0, WD_SPLIT); }
    { LAS float* ctab = (LAS float*)(F.lds);
      __syncthreads();
      if (F.tid < 128) ctab[F.tid] = cospif((float)F.tid * (1.0f / 64.0f));
      __syncthreads();
      const float* wout = a.in[15]; bf16_t* W2T = (bf16_t*)(ws + WS_W2);
      for (int it = gw; it < 2048; it += NGW) {
          const int kb = it >> 4, nb = it & 15; const int krow0 = 512 + kb * 8; const int sn = (krow0 >= 1024) ? 1 : 0; const int cg0 = (krow0 - 512 - sn * 512); const int g = cg0 >> 7, c0 = cg0 & 127;
          const int n = nb * 64 + F.lane; float accv[8];
#pragma unroll
          for (int i = 0; i < 8; ++i) accv[i] = 0.f;
          const float* wp = wout + (size_t)(512 + g * 128) * DM + n;
#pragma unroll 1
          for (int jb = 0; jb < 128; jb += 32) { float wv[32];
#pragma unroll
              for (int jj = 0; jj < 32; ++jj) wv[jj] = wp[(size_t)(jb + jj) * DM];
#pragma unroll
              for (int jj = 0; jj < 32; ++jj) { const int j = jb + jj;
#pragma unroll
                  for (int i = 0; i < 8; ++i) { const int ph = (j * (c0 + i) - sn * 32) & 127; accv[i] += ctab[ph] * wv[jj]; } } }
          const float sc = sn ? (-1.0f / 1024.0f) : (1.0f / 1024.0f);
          u32x4 o; o.x = pk2(accv[0] * sc, accv[1] * sc); o.y = pk2(accv[2] * sc, accv[3] * sc); o.z = pk2(accv[4] * sc, accv[5] * sc); o.w = pk2(accv[6] * sc, accv[7] * sc);
          *(u32x4*)(W2T + (size_t)n * KOUT + krow0) = o;
      } }
    { bf16_t* WgT = (bf16_t*)(ws + WS_WGT);
      for (int o = (F.vcu * NTHREADS + F.tid); o < NHEAD * 256 * 64; o += F.G * NTHREADS) {
          const int k = o & 63, n = (o >> 6) & 255, h = o >> 14, mat = n >> 6, j = n & 63;
          const float* W = a.in[mat == 0 ? 5 : mat == 1 ? 7 : mat == 2 ? 10 : 12];
          WgT[o] = (bf16_t)f2bf(W[(h * 64 + k) * 64 + j]);
      } }
}

__device__ constexpr float TWR[32] = {1.000000000e+00f, 9.951847267e-01f, 9.807852804e-01f, 9.569403357e-01f, 9.238795325e-01f, 8.819212643e-01f, 8.314696123e-01f, 7.730104534e-01f, 7.071067812e-01f, 6.343932842e-01f, 5.555702330e-01f, 4.713967368e-01f, 3.826834324e-01f, 2.902846773e-01f, 1.950903220e-01f, 9.801714033e-02f, 0.0f, -9.801714033e-02f, -1.950903220e-01f, -2.902846773e-01f, -3.826834324e-01f, -4.713967368e-01f, -5.555702330e-01f, -6.343932842e-01f, -7.071067812e-01f, -7.730104534e-01f, -8.314696123e-01f, -8.819212643e-01f, -9.238795325e-01f, -9.569403357e-01f, -9.807852804e-01f, -9.951847267e-01f};
__device__ constexpr float TWI[32] = {-0.0f, -9.801714033e-02f, -1.950903220e-01f, -2.902846773e-01f, -3.826834324e-01f, -4.713967368e-01f, -5.555702330e-01f, -6.343932842e-01f, -7.071067812e-01f, -7.730104534e-01f, -8.314696123e-01f, -8.819212643e-01f, -9.238795325e-01f, -9.569403357e-01f, -9.807852804e-01f, -9.951847267e-01f, -1.000000000e+00f, -9.951847267e-01f, -9.807852804e-01f, -9.569403357e-01f, -9.238795325e-01f, -8.819212643e-01f, -8.314696123e-01f, -7.730104534e-01f, -7.071067812e-01f, -6.343932842e-01f, -5.555702330e-01f, -4.713967368e-01f, -3.826834324e-01f, -2.902846773e-01f, -1.950903220e-01f, -9.801714033e-02f};
constexpr int bitrev_c(int i, int n) { int r = 0; for (int b = 0; b < n; ++b) r |= ((i >> b) & 1) << (n - 1 - b); return r; }
template <int N, int ST, int L> struct FftStage {
    static __device__ __forceinline__ void run(float (&re)[N], float (&im)[N]) {
        constexpr int m = 1 << ST, h = m >> 1;
#pragma unroll
        for (int kk = 0; kk < N; kk += m) {
#pragma unroll
            for (int j = 0; j < h; ++j) {
                const float wr = TWR[j * (64 / m)], wi = TWI[j * (64 / m)];
                const float xr = re[kk + j + h], xi = im[kk + j + h];
                const float tr = wr * xr - wi * xi, ti = wr * xi + wi * xr;
                re[kk + j + h] = re[kk + j] - tr; im[kk + j + h] = im[kk + j] - ti;
                re[kk + j] += tr; im[kk + j] += ti;
            }
        }
        if constexpr (ST < L) FftStage<N, ST + 1, L>::run(re, im);
    }
};
template <int N, int L> __device__ __forceinline__ void fft_inreg(float (&re)[N], float (&im)[N]) {
#pragma unroll
    for (int i = 0; i < N; ++i) { const int j = bitrev_c(i, L); if (i < j) { float t = re[i]; re[i] = re[j]; re[j] = t; t = im[i]; im[i] = im[j]; im[j] = t; } }
    FftStage<N, 1, L>::run(re, im);
}

__device__ __forceinline__ void fft1_item(const Frame& F, const bf16_t* P, u32x2* V, int item) {
    const int b = item >> 7, sg = (item >> 3) & 15, cc = item & 7;
    const int s2a = 16 * sg + 2 * F.wave, c = cc * 64 + F.lane;
    float re[32], im[32];
    const bf16_t* src = P + ((size_t)b * SEQ + s2a) * NPROJ + 1024 + c;
#pragma unroll
    for (int i = 0; i < 32; ++i) { re[i] = bf2f(src[(size_t)i * 256 * NPROJ]); im[i] = bf2f(src[(size_t)i * 256 * NPROJ + NPROJ]); }
    fft_inreg<32, 5>(re, im);
    float sa, ca, sb, cb; sincospif((float)s2a * (1.0f / 4096.0f), &sa, &ca); sincospif((float)(s2a + 1) * (1.0f / 4096.0f), &sb, &cb);
    float war = 1.f, wai = 0.f, wbr = 1.f, wbi = 0.f;
    u32x2* dst = V + (((size_t)b * 17) * 128 + (s2a >> 1)) * 512 + c;
#pragma unroll
    for (int k = 0; k <= 16; ++k) {
        const int km = (32 - k) & 31;
        const float ar = 0.5f * (re[k] + re[km]), ai = 0.5f * (im[k] - im[km]), br = 0.5f * (im[k] + im[km]), bi = -0.5f * (re[k] - re[km]);
        f32x2 va, vb; va.x = ar * war - ai * wai; va.y = ar * wai + ai * war; vb.x = br * wbr - bi * wbi; vb.y = br * wbi + bi * wbr;
        dst[(size_t)k * 128 * 512] = (u32x2){pk2(va.x, va.y), pk2(vb.x, vb.y)};
        const float t0 = war * ca + wai * sa; wai = wai * ca - war * sa; war = t0;
        const float t1 = wbr * cb + wbi * sb; wbi = wbi * cb - wbr * sb; wbr = t1;
    }
}
__device__ __forceinline__ void fft2_item(const Frame& F, const u32x2* V, bf16_t* A2, int b, int k1, int cc) {
    const int w = F.wave, c = cc * 64 + F.lane;
    LAS f32x2* T = (LAS f32x2*)F.lds;
    { u32x2 pv[16];
      const u32x2* src = V + (((size_t)b * 17 + k1) * 128 + w) * 512 + c;
#pragma unroll
      for (int j1 = 0; j1 < 16; ++j1) pv[j1] = src[(size_t)j1 * 8 * 512];
#pragma unroll
      for (int jj = 0; jj < 2; ++jj) { const int j2 = 2 * w + jj; float re[16], im[16];
#pragma unroll
          for (int j1 = 0; j1 < 16; ++j1) { const unsigned q = jj ? pv[j1].y : pv[j1].x; re[j1] = bf2f(q & 0xffffu); im[j1] = bf2f(q >> 16); }
          fft_inreg<16, 4>(re, im);
#pragma unroll
          for (int q1 = 0; q1 < 16; ++q1) { float sn, cs; sincospif((float)(q1 * j2) * (1.0f / 128.0f), &sn, &cs);
              f32x2 o; o.x = re[q1] * cs + im[q1] * sn; o.y = im[q1] * cs - re[q1] * sn; T[(q1 * 16 + j2) * 64 + F.lane] = o; } } }
    __syncthreads();
#pragma unroll 1
    for (int qq = 0; qq < 2; ++qq) { const int q1 = 2 * w + qq; float re[16], im[16];
#pragma unroll
        for (int j2 = 0; j2 < 16; ++j2) { const f32x2 v = T[(q1 * 16 + j2) * 64 + F.lane]; re[j2] = v.x; im[j2] = v.y; }
        fft_inreg<16, 4>(re, im);
#pragma unroll
        for (int q2 = 0; q2 < 16; ++q2) { const int k = k1 + 32 * (q1 + 16 * q2);
            bf16_t* d = A2 + ((size_t)b * SEQ + k) * KOUT + 512 + c; d[0] = (bf16_t)f2bf(re[q2]); d[512] = (bf16_t)f2bf(-im[q2]);
            if (k1 != 0 && k1 != 16) { bf16_t* dm = A2 + ((size_t)b * SEQ + (SEQ - k)) * KOUT + 512 + c; dm[0] = (bf16_t)f2bf(re[q2]); dm[512] = (bf16_t)f2bf(im[q2]); } } }
    __syncthreads();
}

constexpr int LRU_WG = 0, LRU_CS = 32768, LRU_CF = 49152, LRU_XT = 81920, LRU_GT = 98816  , LRU_AGW = 115200, LRU_WCAR = 123392, LRU_CARRY = 127488, LRU_CONST = 131584;
static_assert(LRU_XT + 131 * 128 <= LRU_GT && LRU_GT + 16384 <= LRU_AGW && LRU_AGW + 8192 <= LRU_WCAR && LRU_WCAR + 4096 <= LRU_CARRY && LRU_CARRY + 4096 <= LRU_CONST && LRU_CONST + 11 * 256 <= MISC_OFF, "LRU LDS map");
template <int PASS>
__device__ __forceinline__ void lru_super_item(const Frame& F, KArgs& a, int si) {
    const int b = si >> 6, h = (si >> 3) & 7, j0 = (si & 7) * 8;
    const int tid = F.tid, lane = F.lane, w = F.wave, fr = lane & 15, fq = lane >> 4;
    unsigned char* ws = a.ws;
    const bf16_t* P = (const bf16_t*)a.out;
    LAS unsigned char* lds = F.lds;
    f32x2* agg = (f32x2*)(ws + WS_AGG);
    { const bf16_t* WgT = (const bf16_t*)(ws + WS_WGT) + (size_t)h * 256 * 64;
#pragma unroll
      for (int i = 0; i < 4; ++i) { const int q = tid + 512 * i, n = q >> 3, ch = q & 7; const u32x4 v = *(const u32x4*)(WgT + n * 64 + ch * 8); *(LAS u32x4*)(lds + LRU_WG + n * 128 + ((ch ^ (n & 7)) << 4)) = v; } }
    { LAS float* KC = (LAS float*)(lds + LRU_CONST);
      if (tid < 64) { const int ch = h * 64 + tid;
          KC[0 * 64 + tid] = -8.0f * log1pf(expf(-a.in[9][ch])) * 1.4426950408889634f; KC[1 * 64 + tid] = -8.0f * log1pf(expf(-a.in[14][ch])) * 1.4426950408889634f;
          KC[2 * 64 + tid] = a.in[6][ch]; KC[3 * 64 + tid] = a.in[8][ch]; KC[4 * 64 + tid] = a.in[11][ch]; KC[5 * 64 + tid] = a.in[13][ch]; KC[6 * 64 + tid] = a.in[4][ch];
#pragma unroll
          for (int k = 0; k < 4; ++k) KC[(7 + k) * 64 + tid] = a.in[3][k * DLRU + ch]; } }
    const LAS float* KC = (const LAS float*)(lds + LRU_CONST);
    const int ch4 = tid & 15, tq = tid >> 4;
    if (PASS == 2) {
        if (tid < 128) { const int dir = tid >> 6, ch = tid & 63; LAS float* CAR = (LAS float*)(lds + LRU_CARRY);
            float carry = 0.f;
            if (dir == 0) { for (int jj = 0; jj < j0 + 8; ++jj) { if (jj >= j0) CAR[((jj - j0) * 2 + 0) * 64 + ch] = carry; const f32x2 ah = agg[(((size_t)b * 64 + jj) * 2 + 0) * 512 + h * 64 + ch]; carry = ah.x * carry + ah.y; } }
            else { for (int jj = 63; jj >= j0; --jj) { if (jj < j0 + 8) CAR[((jj - j0) * 2 + 1) * 64 + ch] = carry; const f32x2 ah = agg[(((size_t)b * 64 + jj) * 2 + 1) * 512 + h * 64 + ch]; carry = ah.x * carry + ah.y; } }
        }
    }
    __syncthreads();
    u32x4 px[3], pg[2];
#define LRU_LOAD_CHUNK(jj) do { const int _t0 = (jj) * 128; \
        _Pragma("unroll") for (int _i = 0; _i < 3; ++_i) { const int _q = tid + 512 * _i, _r = _q >> 3, _c = _q & 7, _t = _t0 - 2 + _r; px[_i] = (u32x4){0u, 0u, 0u, 0u}; \
            if (_q < 131 * 8 && _t >= 0 && _t < SEQ) px[_i] = *(const u32x4*)(P + ((size_t)b * SEQ + _t) * NPROJ + h * 64 + _c * 8); } \
        if (PASS == 2) { _Pragma("unroll") for (int _i = 0; _i < 2; ++_i) { const int _q = tid + 512 * _i, _r = _q >> 3, _c = _q & 7; pg[_i] = *(const u32x4*)(P + ((size_t)b * SEQ + _t0 + _r) * NPROJ + 512 + h * 64 + _c * 8); } } } while (0)
    LRU_LOAD_CHUNK(j0);
    for (int jl = 0; jl < 8; ++jl) {
        const int j = j0 + jl, t0 = j * 128;
#pragma unroll
        for (int i = 0; i < 3; ++i) { const int q = tid + 512 * i, r = q >> 3, chk = q & 7; if (q < 131 * 8) *(LAS u32x4*)(lds + LRU_XT + r * 128 + chk * 16) = px[i]; }
        if (PASS == 2) {
#pragma unroll
            for (int i = 0; i < 2; ++i) { const int q = tid + 512 * i, r = q >> 3, chk = q & 7; *(LAS u32x4*)(lds + LRU_GT + r * 128 + chk * 16) = pg[i]; } }
        __syncthreads();
        if (jl < 7) LRU_LOAD_CHUNK(j + 1);
        { float xv[7][4]; const f32x4 cbias = *(const LAS f32x4*)(KC + 6 * 64 + ch4 * 4); f32x4 cwv[4];
#pragma unroll
          for (int k = 0; k < 4; ++k) cwv[k] = *(const LAS f32x4*)(KC + (7 + k) * 64 + ch4 * 4);
#pragma unroll
          for (int r = 0; r < 7; ++r) { const u32x2 v = *(const LAS u32x2*)(lds + LRU_XT + (4 * tq + r) * 128 + ch4 * 8); xv[r][0] = bf2f(v.x & 0xffffu); xv[r][1] = bf2f(v.x >> 16); xv[r][2] = bf2f(v.y & 0xffffu); xv[r][3] = bf2f(v.y >> 16); }
#pragma unroll
          for (int tt = 0; tt < 4; ++tt) { const int t = 4 * tq + tt; f32x4 cv;
#pragma unroll
              for (int i = 0; i < 4; ++i) { float s = cbias[i];
#pragma unroll
                  for (int k = 0; k < 4; ++k) s += cwv[k][i] * xv[tt + k][i];
                  cv[i] = s; }
              *(LAS f32x4*)(lds + LRU_CF + t * 256 + ch4 * 16) = cv;
              u32x2 pk; pk.x = pk2(cv[0], cv[1]); pk.y = pk2(cv[2], cv[3]);
              *(LAS u32x2*)(lds + LRU_CS + t * 128 + (((ch4 >> 1) ^ (t & 7)) << 4) + (ch4 & 1) * 8) = pk; } }
        __syncthreads();
        bf16x8 af[2];
        { const int row = 16 * w + fr;
#pragma unroll
          for (int kk = 0; kk < 2; ++kk) af[kk] = *(const LAS bf16x8*)(lds + LRU_CS + row * 128 + (((kk * 4 + fq) ^ (row & 7)) << 4)); }
#pragma unroll 1
        for (int hf = 0; hf < 2; ++hf) {
            float Pf[2][4], Hf[2][4], Pb[2][4], Hb[2][4];
#pragma unroll
            for (int cb = 0; cb < 2; ++cb) { const int cb4 = 2 * hf + cb;
                f32x4 acc[4];
#pragma unroll
                for (int mat = 0; mat < 4; ++mat) { acc[mat] = (f32x4){0.f, 0.f, 0.f, 0.f}; const int n = (mat * 4 + cb4) * 16 + fr;
#pragma unroll
                    for (int kk = 0; kk < 2; ++kk) { const bf16x8 bfr = *(const LAS bf16x8*)(lds + LRU_WG + n * 128 + (((kk * 4 + fq) ^ (n & 7)) << 4)); acc[mat] = __builtin_amdgcn_mfma_f32_16x16x32_bf16(af[kk], bfr, acc[mat], 0, 0, 0); } }
                float af_[4], bf_[4], ab_[4], bb_[4]; const int chl = cb4 * 16 + fr;
                const float k_c8f = KC[chl], k_c8b = KC[64 + chl], k_baf = KC[128 + chl], k_bxf = KC[192 + chl], k_bab = KC[256 + chl], k_bxb = KC[320 + chl];
#pragma unroll
                for (int r = 0; r < 4; ++r) { const int t = 16 * w + 4 * fq + r; const float cval = *(const LAS float*)(lds + LRU_CF + t * 256 + chl * 4);
                    const float rf = fast_sigmoid(acc[0][r] + k_baf), xf = fast_sigmoid(acc[1][r] + k_bxf);
                    const float rb = fast_sigmoid(acc[2][r] + k_bab), xb = fast_sigmoid(acc[3][r] + k_bxb);
                    const float a1 = __builtin_amdgcn_exp2f(k_c8f * rf), a2 = __builtin_amdgcn_exp2f(k_c8b * rb);
                    af_[r] = a1; bf_[r] = __builtin_amdgcn_sqrtf(fmaxf(fmaf(-a1, a1, 1.0f), 0.f)) * xf * cval;
                    ab_[r] = a2; bb_[r] = __builtin_amdgcn_sqrtf(fmaxf(fmaf(-a2, a2, 1.0f), 0.f)) * xb * cval; }
                Pf[cb][0] = af_[0]; Hf[cb][0] = bf_[0];
#pragma unroll
                for (int r = 1; r < 4; ++r) { Pf[cb][r] = af_[r] * Pf[cb][r - 1]; Hf[cb][r] = af_[r] * Hf[cb][r - 1] + bf_[r]; }
                Pb[cb][3] = ab_[3]; Hb[cb][3] = bb_[3];
#pragma unroll
                for (int r = 2; r >= 0; --r) { Pb[cb][r] = ab_[r] * Pb[cb][r + 1]; Hb[cb][r] = ab_[r] * Hb[cb][r + 1] + bb_[r]; }
            }
            float gPf[2], gHf[2], gPb[2], gHb[2];
            { LAS f32x2* AGW = (LAS f32x2*)(lds + LRU_AGW);
#pragma unroll
              for (int cb = 0; cb < 2; ++cb) { const int chl = (2 * hf + cb) * 16 + fr;
                  const bool odd = (fq & 1) != 0, hi = (fq & 2) != 0;
                  { const float A = Pf[cb][3], H = Hf[cb][3];
                    const float A1 = xchg16(A, lane), H1 = xchg16(H, lane);
                    const float pA = odd ? A1 : 1.f, pH = odd ? H1 : 0.f, qA = A * A1, qH = odd ? (A * H1 + H) : (A1 * H + H1);
                    const float QA = xchg32(qA, lane), QH = xchg32(qH, lane);
                    gPf[cb] = hi ? pA * QA : pA; gHf[cb] = hi ? (pA * QH + pH) : pH;
                    if (fq == 0) AGW[(w * 2 + 0) * 64 + chl] = (f32x2){qA * QA, QA * qH + QH}; }
                  { const float A = Pb[cb][0], H = Hb[cb][0];
                    const float A1 = xchg16(A, lane), H1 = xchg16(H, lane);
                    const float pA = odd ? 1.f : A1, pH = odd ? 0.f : H1, qA = A * A1, qH = odd ? (A1 * H + H1) : (A * H1 + H);
                    const float QA = xchg32(qA, lane), QH = xchg32(qH, lane);
                    gPb[cb] = hi ? pA : pA * QA; gHb[cb] = hi ? pH : (pA * QH + pH);
                    if (fq == 0) AGW[(w * 2 + 1) * 64 + chl] = (f32x2){qA * QA, qA * QH + qH}; }
              } }
            __syncthreads();
            if (tid < 64) { const int dir = tid >> 5, ch = hf * 32 + (tid & 31); const LAS f32x2* AGW = (const LAS f32x2*)(lds + LRU_AGW); LAS float* WCAR = (LAS float*)(lds + LRU_WCAR);
                float carry = (PASS == 2) ? ((const LAS float*)(lds + LRU_CARRY))[(jl * 2 + dir) * 64 + ch] : 0.f; float ptot = 1.f;
                if (dir == 0) { for (int ww = 0; ww < 8; ++ww) { WCAR[(ww * 2 + 0) * 64 + ch] = carry; const f32x2 ah = AGW[(ww * 2 + 0) * 64 + ch]; carry = ah.x * carry + ah.y; ptot *= ah.x; } }
                else { for (int ww = 7; ww >= 0; --ww) { WCAR[(ww * 2 + 1) * 64 + ch] = carry; const f32x2 ah = AGW[(ww * 2 + 1) * 64 + ch]; carry = ah.x * carry + ah.y; ptot *= ah.x; } }
                if (PASS == 1) agg[(((size_t)b * 64 + j) * 2 + dir) * 512 + h * 64 + ch] = (f32x2){ptot, carry};
            }
            if (PASS == 2) {
                __syncthreads();
                const LAS float* WCAR = (const LAS float*)(lds + LRU_WCAR);
#pragma unroll
                for (int cb = 0; cb < 2; ++cb) { const int ch = (2 * hf + cb) * 16 + fr;
                    const float cf = gHf[cb] + gPf[cb] * WCAR[(w * 2 + 0) * 64 + ch], cbk = gHb[cb] + gPb[cb] * WCAR[(w * 2 + 1) * 64 + ch];
#pragma unroll
                    for (int r = 0; r < 4; ++r) { const int t = 16 * w + 4 * fq + r; const float hs = (Hf[cb][r] + Pf[cb][r] * cf) + (Hb[cb][r] + Pb[cb][r] * cbk);
                        LAS bf16_t* gp = (LAS bf16_t*)(lds + LRU_GT + t * 128 + ch * 2); const float g = bf2f((unsigned)*gp);
                        const float u = 0.7978845608028654f * (g + 0.044715f * g * g * g); const float th = 1.0f - 2.0f * __builtin_amdgcn_rcpf(1.0f + __builtin_amdgcn_exp2f(2.885390081777927f * u));
                        *gp = (bf16_t)f2bf(0.5f * g * (1.0f + th) * hs); } }
            }
        }
        if (PASS == 2) {
            __syncthreads();
            bf16_t* A2 = (bf16_t*)(ws + WS_A2);
#pragma unroll
            for (int i = 0; i < 2; ++i) { const int q = tid + 512 * i, r = q >> 3, chk = q & 7; const u32x4 v = *(const LAS u32x4*)(lds + LRU_GT + r * 128 + chk * 16);
                *(u32x4*)(A2 + ((size_t)b * SEQ + t0 + r) * KOUT + h * 64 + chk * 8) = v; }
        }
        __syncthreads();
    }
#undef LRU_LOAD_CHUNK
}

constexpr int P5_PITCH = 2048 + 16;
__device__ __forceinline__ void p5_router(const Frame& F, KArgs& a) {
    unsigned char* ws = a.ws;
    LAS unsigned char* WH = F.lds; LAS unsigned char* WL = F.lds + 16 * P5_PITCH;
    { const float* wr = a.in[17];
      for (int o = F.tid; o < DM * NEXP; o += NTHREADS) { const int k = o >> 4, e = o & 15; const float w = wr[o]; const unsigned hi = f2bf(w); const float lo = w - bf2f(hi);
          *(LAS bf16_t*)(WH + e * P5_PITCH + k * 2) = (bf16_t)hi; *(LAS bf16_t*)(WL + e * P5_PITCH + k * 2) = (bf16_t)f2bf(lo); } }
    __syncthreads();
    const bf16_t* xm = (const bf16_t*)(ws + WS_DELTA); const float* g2 = a.in[16];
    unsigned char* h2 = (unsigned char*)(ws + WS_H2); float* scores = (float*)(ws + WS_SCORES); float* rstd2 = (float*)(ws + WS_RSTD1);
    const int gw = F.vcu * NWAVES + F.wave, NGW = F.G * NWAVES, fr = F.lane & 15, fq = F.lane >> 4;
    for (int grp = gw; grp < MTOK / 16; grp += NGW) {
        const int m0 = grp * 16;
        const bf16_t* xrow = xm + (size_t)(m0 + fr) * DM + 16 * fq; unsigned char* hrow = h2 + (size_t)(m0 + fr) * DM + 16 * fq;
        f32x4 acc = (f32x4){0.f, 0.f, 0.f, 0.f}; float ssq = 0.f;
#pragma unroll 2
        for (int kp = 0; kp < 16; ++kp) {
            const u32x4 x0 = *(const u32x4*)(xrow + 64 * kp), x1 = *(const u32x4*)(xrow + 64 * kp + 8); unsigned qq[4];
#pragma unroll
            for (int hh = 0; hh < 2; ++hh) { const u32x4 xv = hh ? x1 : x0; const int k0 = 64 * kp + 16 * fq + 8 * hh;
                f32x4 xa, xb; xa.x = bf2f(xv.x & 0xffffu); xa.y = bf2f(xv.x >> 16); xa.z = bf2f(xv.y & 0xffffu); xa.w = bf2f(xv.y >> 16); xb.x = bf2f(xv.z & 0xffffu); xb.y = bf2f(xv.z >> 16); xb.z = bf2f(xv.w & 0xffffu); xb.w = bf2f(xv.w >> 16);
                const f32x4 ga = *(const f32x4*)(g2 + k0), gb = *(const f32x4*)(g2 + k0 + 4);
                ssq += (xa.x * xa.x + xa.y * xa.y) + (xa.z * xa.z + xa.w * xa.w) + (xb.x * xb.x + xb.y * xb.y) + (xb.z * xb.z + xb.w * xb.w);
                const f32x4 va = xa * ga, vb = xb * gb;
                u32x4 hi, lo;
                hi.x = pk2(va.x, va.y); hi.y = pk2(va.z, va.w); hi.z = pk2(vb.x, vb.y); hi.w = pk2(vb.z, vb.w);
                lo.x = pk2(va.x - bf2f(hi.x & 0xffffu), va.y - bf2f(hi.x >> 16)); lo.y = pk2(va.z - bf2f(hi.y & 0xffffu), va.w - bf2f(hi.y >> 16));
                lo.z = pk2(vb.x - bf2f(hi.z & 0xffffu), vb.y - bf2f(hi.z >> 16)); lo.w = pk2(vb.z - bf2f(hi.w & 0xffffu), vb.w - bf2f(hi.w >> 16));
                const bf16x8 bh = *(const LAS bf16x8*)(WH + fr * P5_PITCH + k0 * 2), bl = *(const LAS bf16x8*)(WL + fr * P5_PITCH + k0 * 2);
                acc = __builtin_amdgcn_mfma_f32_16x16x32_bf16((bf16x8)hi, bh, acc, 0, 0, 0);
                acc = __builtin_amdgcn_mfma_f32_16x16x32_bf16((bf16x8)lo, bh, acc, 0, 0, 0);
                acc = __builtin_amdgcn_mfma_f32_16x16x32_bf16((bf16x8)hi, bl, acc, 0, 0, 0);
                qq[2 * hh] = pk4_fp8(va.x, va.y, va.z, va.w); qq[2 * hh + 1] = pk4_fp8(vb.x, vb.y, vb.z, vb.w); }
            *(u32x4*)(hrow + 64 * kp) = (u32x4){qq[0], qq[1], qq[2], qq[3]};
        }
        ssq += __shfl_xor(ssq, 16); ssq += __shfl_xor(ssq, 32);
        const float rs = 1.0f / sqrtf(ssq * (1.0f / DM) + EPS);
        if (fq == 0) rstd2[m0 + fr] = rs;
        f32x4 sc;
#pragma unroll
        for (int r = 0; r < 4; ++r) { const float l = acc[r] * __shfl(rs, 4 * fq + r);
            float mx = l;
#pragma unroll
            for (int o = 1; o < 16; o <<= 1) mx = fmaxf(mx, __shfl_xor(mx, o));
            const float ex = expf(l - mx); float sm = ex;
#pragma unroll
            for (int o = 1; o < 16; o <<= 1) sm += __shfl_xor(sm, o);
            sc[r] = ex / sm; }
        const int bb = m0 >> 13, s0 = m0 & (SEQ - 1);
        *(f32x4*)(scores + ((size_t)bb * NEXP + fr) * SEQ + s0 + 4 * fq) = sc;
    }
}

__device__ __forceinline__ void p6_topk_item(const Frame& F, KArgs& a, int item) {
    unsigned char* ws = a.ws; const int b = item >> 4, e = item & 15, tid = F.tid;
    const float* sc = (const float*)(ws + WS_SCORES) + (size_t)item * SEQ;
    int* tok = (int*)(ws + WS_TOK) + e * EROWS + b * CAP; float* gate = (float*)(ws + WS_GATE) + e * EROWS + b * CAP; int* inv = (int*)(ws + WS_INV) + (size_t)item * SEQ;
    float* rsl = (float*)(ws + WS_RS) + e * EROWS + b * CAP; const float* rstd2 = (const float*)(ws + WS_RSTD1) + b * SEQ;
    LAS unsigned* hist = (LAS unsigned*)F.lds;
    LAS unsigned* sfx = hist + 256;
    LAS unsigned* bc = hist + 512;
    LAS unsigned* scan = hist + 768;
    unsigned key[16];
    { const u32x4* p = (const u32x4*)(sc + tid * 16);
#pragma unroll
      for (int i = 0; i < 4; ++i) { const u32x4 v = p[i]; key[4 * i] = v.x; key[4 * i + 1] = v.y; key[4 * i + 2] = v.z; key[4 * i + 3] = v.w; } }
    unsigned prefix = 0, need = CAP;
    const int lane = F.lane, wv = F.wave;
    if (tid < 256) hist[tid] = 0u;
    __syncthreads();
#pragma unroll 1
    for (int pass = 0; pass < 4; ++pass) {
        const int shift = 24 - 8 * pass; const unsigned himask = pass == 0 ? 0u : (0xffffffffu << (shift + 8));
#pragma unroll
        for (int i = 0; i < 16; ++i) if ((key[i] & himask) == prefix) __hip_atomic_fetch_add(&hist[(key[i] >> shift) & 255u], 1u, __ATOMIC_RELAXED, __HIP_MEMORY_SCOPE_WORKGROUP);
        __syncthreads();
        unsigned hv = 0u, sv = 0u;
        if (tid < 256) { hv = hist[tid]; hist[tid] = 0u; sv = hv;
#pragma unroll
            for (int d = 1; d < 64; d <<= 1) { const unsigned o = __shfl_down(sv, d); if (lane + d < 64) sv += o; }
            if (lane == 0) sfx[wv] = sv; }
        __syncthreads();
        if (tid < 256) { unsigned ge = sv;
#pragma unroll
            for (int k = 1; k < 4; ++k) if (wv + k < 4) ge += sfx[wv + k];
            const unsigned gt = ge - hv;
            if (ge >= need && gt < need) { bc[0] = prefix | ((unsigned)tid << shift); bc[1] = need - gt; } }
        __syncthreads();
        prefix = bc[0]; need = bc[1];
    }
    const unsigned T = prefix;
    unsigned ngt = 0, neq = 0;
#pragma unroll
    for (int i = 0; i < 16; ++i) { ngt += key[i] > T ? 1u : 0u; neq += key[i] == T ? 1u : 0u; }
    unsigned incl = ngt | (neq << 16);
#pragma unroll
    for (int d = 1; d < 64; d <<= 1) { const unsigned o = __shfl_up(incl, d); if (lane >= d) incl += o; }
    if (lane == 63) scan[wv] = incl;
    __syncthreads();
    unsigned tot = 0u;
#pragma unroll
    for (int k = 0; k < 8; ++k) { const unsigned wt = scan[k]; if (k < wv) incl += wt; tot += wt; }
    const unsigned totgt = tot & 0xffffu;
    unsigned pgt = (incl & 0xffffu) - ngt, peq = (incl >> 16) - neq;
#pragma unroll
    for (int i = 0; i < 16; ++i) { const int s = tid * 16 + i; int slot = -1;
        if (key[i] > T) { slot = (int)pgt; ++pgt; }
        else if (key[i] == T) { if (peq < need) slot = (int)(totgt + peq); ++peq; }
        inv[s] = slot;
        if (slot >= 0) { tok[slot] = b * SEQ + s; gate[slot] = __builtin_bit_cast(float, key[i]); rsl[slot] = rstd2[s]; } }
    __syncthreads();
}

__device__ __forceinline__ void p9_final(const Frame& F, KArgs& a, float* dst) {
    unsigned char* ws = a.ws; const bf16_t* dl = (const bf16_t*)(ws + WS_DELTA); const float* gf = a.in[21]; const unsigned char* eo = (const unsigned char*)(ws + WS_EO); const int* inv = (const int*)(ws + WS_INV);
    const int gw = F.vcu * NWAVES + F.wave, NGW = F.G * NWAVES;
    f32x4 gv[4];
#pragma unroll
    for (int j = 0; j < 4; ++j) gv[j] = ((const f32x4*)gf)[F.lane + 64 * j];
    unsigned long long dn[4]; int slotn = -1;
    { const int m0 = gw < MTOK ? gw : 0; const unsigned long long* dr = (const unsigned long long*)(dl + (size_t)m0 * DM) + F.lane;
#pragma unroll
      for (int j = 0; j < 4; ++j) dn[j] = dr[64 * j];
      if (F.lane < 16) slotn = inv[((size_t)(m0 >> 13) * NEXP + F.lane) * SEQ + (m0 & (SEQ - 1))]; }
    for (int m = gw; m < MTOK; m += NGW) {
        f32x4 v[4]; const int myslot = slotn;
#pragma unroll
        for (int j = 0; j < 4; ++j) { const unsigned lo = (unsigned)dn[j], hi = (unsigned)(dn[j] >> 32); v[j].x = bf2f(lo & 0xffffu); v[j].y = bf2f(lo >> 16); v[j].z = bf2f(hi & 0xffffu); v[j].w = bf2f(hi >> 16); }
        const int bb = m >> 13;
        { const int mn = (m + NGW < MTOK) ? m + NGW : m; const unsigned long long* dr = (const unsigned long long*)(dl + (size_t)mn * DM) + F.lane;
#pragma unroll
          for (int j = 0; j < 4; ++j) dn[j] = dr[64 * j];
          slotn = -1; if (F.lane < 16) slotn = inv[((size_t)(mn >> 13) * NEXP + F.lane) * SEQ + (mn & (SEQ - 1))]; }
#if !DBG_NO_MOE
        unsigned mask = (unsigned)__ballot(myslot >= 0) & 0xffffu;
        while (mask) {
            unsigned q[4][4]; int ne = 0;
#pragma unroll
            for (int t = 0; t < 4; ++t) { if (mask) { const int e = __builtin_ctz(mask); mask &= mask - 1u; const int slot = __builtin_amdgcn_readlane(myslot, e);
                    const unsigned* er = (const unsigned*)(eo + ((size_t)e * EROWS + bb * CAP + slot) * DM) + F.lane;
#pragma unroll
                    for (int j = 0; j < 4; ++j) q[t][j] = er[64 * j];
                    ne = t + 1; } }
#pragma unroll
            for (int t = 0; t < 4; ++t) { if (t < ne) {
#pragma unroll
                    for (int j = 0; j < 4; ++j) { const f32x2 lo = __builtin_amdgcn_cvt_pk_f32_fp8((int)q[t][j], false), hi = __builtin_amdgcn_cvt_pk_f32_fp8((int)q[t][j], true);
                        v[j].x += lo.x * 0.0625f; v[j].y += lo.y * 0.0625f; v[j].z += hi.x * 0.0625f; v[j].w += hi.y * 0.0625f; } } }
        }
#endif
        float s = 0.f;
#pragma unroll
        for (int j = 0; j < 4; ++j) s += (v[j].x * v[j].x + v[j].y * v[j].y) + (v[j].z * v[j].z + v[j].w * v[j].w);
        const float rstd = 1.0f / sqrtf(wave_sum(s) * (1.0f / DM) + EPS);
        f32x4* xw = (f32x4*)(dst + (size_t)m * DM) + F.lane;
#pragma unroll
        for (int j = 0; j < 4; ++j) xw[64 * j] = v[j] * rstd * gv[j];
    }
}

__global__ void __launch_bounds__(NTHREADS, 2) fwd(Args args) {
    extern __shared__ __attribute__((aligned(16))) unsigned char lds_raw[];
    Frame F;
    F.lds = (LAS unsigned char*)lds_raw;
    F.tid = threadIdx.x; F.lane = F.tid & 63; F.wave = __builtin_amdgcn_readfirstlane(F.tid >> 6);
    F.G = gridDim.x; F.bx = blockIdx.x; F.vcu = (F.G % 8 == 0) ? (F.bx % 8) * (F.G / 8) + F.bx / 8 : F.bx;
    volatile LAS unsigned* MISC = (volatile LAS unsigned*)(F.lds + MISC_OFF);
    if (F.tid < 16) MISC[F.tid] = 0u;
    __syncthreads();
    KArgs* kap = (KArgs*)__builtin_amdgcn_kernarg_segment_ptr();
    unsigned char* ws = args.ws;
    unsigned* ctl = (unsigned*)(ws + WS_CTL);
    const int lo = args.ph_lo, hi = args.ph_hi;
    const __amdgpu_buffer_rsrc_t rsrc = __builtin_amdgcn_make_buffer_rsrc((void*)ws, (short)0, (int)0x7fffffff, (int)0x00020000);
#if !N_LAUNCH_PER_PHASE
    XcdBarrier bar = xcd_barrier_post(ctl + 1024, MISC + 8);
#if USE_COOP == 1
    cg::this_grid().sync();
#endif
#define GRID_BAR() xcd_barrier(bar)
#else
#define GRID_BAR() do {} while (0)
#endif
#ifdef ONLY_PHASE
#define IN(k) ((k) == ONLY_PHASE && lo <= (k) && (k) < hi)
#else
#define IN(k) (lo <= (k) && (k) < hi)
#endif
#define REFRESH() int t_ = threadIdx.x; asm volatile("" : "+v"(t_)); F.tid = t_; F.lane = t_ & 63; F.wave = __builtin_amdgcn_readfirstlane(t_ >> 6); KArgs* ap_ = kap; asm volatile("" : "+s"(ap_)); KArgs& A = *ap_
#define REPS(k) for (int rep = (args.rep_phase == (k)) ? args.rep_n : 0; rep >= 0; --rep)
    if (IN(0)) REPS(0) { REFRESH(); p0_prep(F, A); GRID_BAR(); }
    if (IN(1)) REPS(1) { REFRESH();
        pg8::DenseOrder S; S.init(WS_XB, WS_WIN, MTOK, NPROJ, DM, F.G, F.bx);
        pg8::EpiP E{(bf16_t*)A.out, (unsigned)WS_RSTD1};
        pg8::gemm_phase<pg8::EpiP, pg8::DenseOrder, false, false>(F.lds, rsrc, F.tid, DM * 2, S, E);
        GRID_BAR();
    }
    if (IN(2)) REPS(2) { REFRESH();
        for (int r2 = (A.rep_phase == 20) ? A.rep_n : 0; r2 >= 0; --r2)
        for (int si = F.bx; si < 256; si += F.G) lru_super_item<1>(F, A, si);
        for (int r2 = (A.rep_phase == 21) ? A.rep_n : 0; r2 >= 0; --r2)
        for (int it = F.bx; it < 512; it += F.G) fft1_item(F, (const bf16_t*)A.out, (u32x2*)(ws + WS_V), it);
        GRID_BAR();
    }
    if (IN(3)) REPS(3) { REFRESH();
        for (int r2 = (A.rep_phase == 30) ? A.rep_n : 0; r2 >= 0; --r2)
        for (int si = F.bx; si < 256; si += F.G) lru_super_item<2>(F, A, si);
        for (int r2 = (A.rep_phase == 31) ? A.rep_n : 0; r2 >= 0; --r2)
        for (int it = F.bx; it < NB * 16 * 8; it += F.G) { const int cc = it & 7, kk = (it >> 3) & 15, b = it >> 7;
            if (kk == 0) { fft2_item(F, (const u32x2*)(ws + WS_V), (bf16_t*)(ws + WS_A2), b, 0, cc); fft2_item(F, (const u32x2*)(ws + WS_V), (bf16_t*)(ws + WS_A2), b, 16, cc); }
            else fft2_item(F, (const u32x2*)(ws + WS_V), (bf16_t*)(ws + WS_A2), b, kk, cc); }
        GRID_BAR();
    }
    if (IN(4)) REPS(4) { REFRESH();
        pg8::DenseOrder S; S.init(WS_A2, WS_W2, MTOK, DM, KOUT, F.G, F.bx);
        pg8::EpiD E{(bf16_t*)(ws + WS_DELTA), (const bf16_t*)(ws + WS_XB)};
        pg8::gemm_phase<pg8::EpiD, pg8::DenseOrder, false, false>(F.lds, rsrc, F.tid, KOUT * 2, S, E);
        GRID_BAR();
    }
    if (IN(5)) REPS(5) { REFRESH(); p5_router(F, A); GRID_BAR(); }
    if (IN(6)) REPS(6) { REFRESH();
        if (F.G > NB * NEXP) { if (F.bx < NB * NEXP) p6_topk_item(F, A, F.bx); else expert_w_items(F, A, 2, (F.bx - NB * NEXP) * NWAVES + F.wave, (F.G - NB * NEXP) * NWAVES, WD_SPLIT, 8192); }
        else { for (int it = F.bx; it < NB * NEXP; it += F.G) p6_topk_item(F, A, it); expert_w_items(F, A, 2, F.bx * NWAVES + F.wave, F.G * NWAVES, WD_SPLIT, 8192); }
        GRID_BAR(); }
#if !DBG_NO_MOE
    if (IN(7)) REPS(7) { REFRESH();
        pg8::G1Order S{(unsigned)WS_H2, (unsigned)WS_WGU, (const int*)(ws + WS_TOK), F.G, F.bx};
        pg8::EpiH E{(unsigned char*)(ws + WS_H), (unsigned)WS_RS};
        pg8::gemm_phase<pg8::EpiH, pg8::G1Order, true, true>(F.lds, rsrc, F.tid, DM, S, E);
        GRID_BAR();
    }
    if (IN(8)) REPS(8) { REFRESH();
        pg8::G2Order S{(unsigned)WS_H, (unsigned)WS_WD, F.G, F.bx};
        pg8::EpiEo E{(unsigned char*)(ws + WS_EO), (unsigned)WS_GATE};
        pg8::gemm_phase<pg8::EpiEo, pg8::G2Order, false, true>(F.lds, rsrc, F.tid, DFF, S, E);
        GRID_BAR();
    }
#endif
    if (IN(9)) REPS(9) { REFRESH(); p9_final(F, A, rep > 0 ? (float*)(ws + WS_H) : A.out); if (rep > 0) GRID_BAR(); }
#undef IN
}

extern "C" void kernel_launch(void* const* d_in, const int* in_sizes, int n_in, void* d_out, int out_size, void* d_ws, size_t ws_size, hipStream_t stream) {
    static int grid = 0;
    if (grid == 0) {
        if (n_in != 22 || out_size != MTOK * DM || ws_size < WS_END) { fprintf(stderr, "kernel_launch: unexpected problem (n_in %d out %d ws %zu)\n", n_in, out_size, ws_size); grid = -1; return; }
        int dev = 0, cus = 0, per_cu = 0;
        (void)hipGetDevice(&dev);
        (void)hipDeviceGetAttribute(&cus, hipDeviceAttributeMultiprocessorCount, dev);
        (void)hipFuncSetAttribute((const void*)fwd, hipFuncAttributeMaxDynamicSharedMemorySize, LDS_BYTES);
        (void)hipOccupancyMaxActiveBlocksPerMultiprocessor(&per_cu, (const void*)fwd, NTHREADS, LDS_BYTES);
        (void)hipGetLastError();
        if (per_cu < 1) { fprintf(stderr, "kernel_launch: occupancy query says %d workgroups per CU; nothing launched\n", per_cu); grid = -1; return; }
        grid = cus * 1;
    }
    if (grid < 0) return;
    (void)hipMemsetAsync((char*)d_ws + WS_CTL, 0, 65536, stream);
    Args a{};
    for (int i = 0; i < 22; ++i) a.in[i] = (const float*)d_in[i];
    a.out = (float*)d_out; a.ws = (unsigned char*)d_ws; a.rep_phase = REPEAT_PHASE; a.rep_n = REPEAT_N;
#if N_LAUNCH_PER_PHASE
    for (int p = 0; p < 10; ++p) { a.ph_lo = p; a.ph_hi = p + 1; hipLaunchKernelGGL(fwd, dim3(grid), dim3(NTHREADS), LDS_BYTES, stream, a); }
#else
    a.ph_lo = 0; a.ph_hi = 10;
    void* kargs[] = {&a};
#if USE_COOP
    hipError_t e = hipLaunchCooperativeKernel((const void*)fwd, dim3(grid), dim3(NTHREADS), kargs, LDS_BYTES, stream);
    if (e != hipSuccess) fprintf(stderr, "cooperative launch failed: %s (grid %d)\n", hipGetErrorString(e), grid);
#else
    (void)kargs; hipLaunchKernelGGL(fwd, dim3(grid), dim3(NTHREADS), LDS_BYTES, stream, a);
#endif
#endif
}
```

```cpp
#include <hip/hip_runtime.h>
#include <hip/hip_cooperative_groups.h>
#include <cstdio>
#include <cstdint>
namespace cg = cooperative_groups;

#ifndef USE_COOP
#define USE_COOP 2
#endif
#ifndef N_LAUNCH_PER_PHASE
#define N_LAUNCH_PER_PHASE 0
#endif
#ifndef DBG_NO_MOE
#define DBG_NO_MOE 0
#endif

#ifndef REPEAT_PHASE
#define REPEAT_PHASE -1
#endif
#ifndef REPEAT_N
#define REPEAT_N 0
#endif
#define LAS __attribute__((address_space(3)))
typedef unsigned short bf16_t;
typedef short bf16x8 __attribute__((ext_vector_type(8)));
typedef float f32x4 __attribute__((ext_vector_type(4)));
typedef float f32x2 __attribute__((ext_vector_type(2)));
typedef unsigned u32x4 __attribute__((ext_vector_type(4)));
typedef unsigned u32x2 __attribute__((ext_vector_type(2)));
typedef int i32x4 __attribute__((ext_vector_type(4)));
typedef int i32x8 __attribute__((ext_vector_type(8)));

constexpr int NB = 4, SEQ = 8192, DM = 1024, MTOK = NB * SEQ;
constexpr int DLRU = 512, NHEAD = 8, HDIM = 64, NPROJ = 1536, KOUT = 1536;
constexpr int NEXP = 16, CAP = 1024, DFF = 2048, EROWS = NB * CAP;
constexpr float EPS = 1e-6f;
constexpr int NTHREADS = 512, NWAVES = 8;
constexpr int LDS_BYTES = 147456;
constexpr int MISC_OFF = 131072 + 8192;

constexpr size_t KiB = 1024, MiB = 1u << 20;
constexpr size_t WS_CTL = 0;
constexpr size_t WS_RSTD1 = 64 * KiB;
constexpr size_t WS_WGT = 256 * KiB;
constexpr size_t WS_IDX = 512 * KiB;
constexpr size_t WS_GATE = 768 * KiB;
constexpr size_t WS_AGG = 1 * MiB;
constexpr size_t WS_SCORES = 3 * MiB;
constexpr size_t WS_INV = 5 * MiB;
constexpr size_t WS_RS = 7 * MiB;
constexpr size_t WS_TOK = 7 * MiB + 256 * KiB;
constexpr size_t WS_WGU = 8 * MiB;
constexpr size_t WS_EO = 8 * MiB;
constexpr size_t WS_WD = 136 * MiB;
constexpr size_t WS_H = 200 * MiB;
constexpr size_t WS_XB = 436 * MiB;
constexpr size_t WS_V = 200 * MiB;
constexpr size_t WS_A2 = 270 * MiB;
constexpr size_t WS_WIN = 366 * MiB;
constexpr size_t WS_W2 = 369 * MiB;
constexpr size_t WS_DELTA = 372 * MiB;
constexpr size_t WS_H2 = 168 * MiB;
constexpr size_t WS_END = 520 * MiB;

typedef __bf16 bf16x2_t __attribute__((ext_vector_type(2)));
__device__ __forceinline__ unsigned f2bf(float f) { return (unsigned)__builtin_bit_cast(unsigned short, (__bf16)f); }
__device__ __forceinline__ unsigned pk2(float lo, float hi) { bf16x2_t v; v.x = (__bf16)lo; v.y = (__bf16)hi; return __builtin_bit_cast(unsigned, v); }
__device__ __forceinline__ unsigned cvt_pk_bf16(float lo, float hi) { unsigned r; asm volatile("v_cvt_pk_bf16_f32 %0, %1, %2" : "=v"(r) : "v"(lo), "v"(hi)); return r; }
__device__ __forceinline__ float bf2f(unsigned h) { return __builtin_bit_cast(float, h << 16); }
__device__ __forceinline__ float wave_sum(float v) {
#pragma unroll
    for (int o = 1; o < 64; o <<= 1) v += __shfl_xor(v, o);
    return v;
}
__device__ __forceinline__ float fast_sigmoid(float x) { return __builtin_amdgcn_rcpf(1.0f + __builtin_amdgcn_exp2f(-1.4426950408889634f * x)); }
__device__ __forceinline__ unsigned pk4_fp8(float a, float b, float c, float d) { int w = 0; w = __builtin_amdgcn_cvt_pk_fp8_f32(a, b, w, false); w = __builtin_amdgcn_cvt_pk_fp8_f32(c, d, w, true); return (unsigned)w; }
__device__ __forceinline__ float xchg16(float v, int lane) { const unsigned u = __builtin_bit_cast(unsigned, v); const auto r = __builtin_amdgcn_permlane16_swap(u, u, false, false); return __builtin_bit_cast(float, (lane & 16) ? r[0] : r[1]); }
__device__ __forceinline__ float xchg32(float v, int lane) { const unsigned u = __builtin_bit_cast(unsigned, v); const auto r = __builtin_amdgcn_permlane32_swap(u, u, false, false); return __builtin_bit_cast(float, (lane & 32) ? r[0] : r[1]); }
#define LDS_WAIT() asm volatile("s_waitcnt lgkmcnt(0)" ::: "memory")

#define XB_TMO      128
#define XB_XCNT(j)  (256  + 64 * (j))
#define XB_XSUB(j)  (1280 + 64 * (j))
#define XB_XGEN(j)  (2304 + 64 * (j))
#define XB_TOP      3328
#define XB_TOPGEN   3392
#define XCD_BAR_WORDS 3456
#define XB_SPIN_CAP (1u << 20)
__device__ __forceinline__ unsigned xb_ld(unsigned* p)              { return __hip_atomic_load(p, __ATOMIC_RELAXED, __HIP_MEMORY_SCOPE_AGENT); }
__device__ __forceinline__ unsigned xb_add(unsigned* p, unsigned v) { return __hip_atomic_fetch_add(p, v, __ATOMIC_RELAXED, __HIP_MEMORY_SCOPE_AGENT); }
__device__ __forceinline__ unsigned xb_xcc_id() { return (unsigned)__builtin_amdgcn_s_getreg((3 << 11) | 20) & 0xFu; }
#define XB_SPIN(cond, bar) do { unsigned _sp = 0; while (cond) { __builtin_amdgcn_s_sleep(1); \
    if ((++_sp & 255u) == 0u) { if (xb_ld(&(bar)[XB_TMO])) break; if (_sp > XB_SPIN_CAP) { atomicAdd(&(bar)[XB_TMO], 1u); break; } } } } while (0)
struct XcdBarrier { unsigned* bar; unsigned x; volatile LAS unsigned* st; };
__device__ __forceinline__ XcdBarrier xcd_barrier_post(unsigned* bar, volatile LAS unsigned* st) {
    XcdBarrier b; b.bar = bar; b.x = xb_xcc_id(); b.st = st;
    if (threadIdx.x == 0) (void)xb_add(&bar[XB_XCNT(b.x)], 1u);
    return b;
}
__device__ __forceinline__ void xcd_barrier_complete(unsigned* bar, unsigned x, unsigned& nloc, unsigned& nx) {
    const unsigned G = gridDim.x * gridDim.y * gridDim.z;
    unsigned sum, cnt, mine, sp = 0u;
    for (;;) {
        sum = 0u; cnt = 0u; mine = 0u;
#pragma unroll
        for (unsigned j = 0; j < 16; ++j) { const unsigned c = xb_ld(&bar[XB_XCNT(j)]); sum += c; cnt += (c > 0u) ? 1u : 0u; mine = (j == x) ? c : mine; }
        if (sum == G) break;
        __builtin_amdgcn_s_sleep(1);
        if ((++sp & 255u) == 0u) { if (xb_ld(&bar[XB_TMO])) break; if (sp > XB_SPIN_CAP) { atomicAdd(&bar[XB_TMO], 1u); break; } }
    }
    nloc = mine > 0u ? mine : 1u; nx = cnt > 0u ? cnt : 1u;
}
__device__ __forceinline__ void xcd_barrier(const XcdBarrier& b) {
    asm volatile("s_waitcnt vmcnt(0)" ::: "memory");
    __syncthreads();
    if (threadIdx.x == 0) {
        unsigned* bar = b.bar;
        __builtin_amdgcn_s_waitcnt(0);
        unsigned nloc = b.st[0], nx = b.st[1];
        if (nloc == 0u) { xcd_barrier_complete(bar, b.x, nloc, nx); b.st[0] = nloc; b.st[1] = nx; }
        const unsigned old = xb_add(&bar[XB_XSUB(b.x)], 1u);
        const unsigned gen = old / nloc;
        if (old + 1u == (gen + 1u) * nloc) {
            __builtin_amdgcn_fence(__ATOMIC_RELEASE, "agent");
            asm volatile("s_waitcnt vmcnt(0)" ::: "memory");
            const unsigned og = xb_add(&bar[XB_TOP], 1u);
            const unsigned tg = og / nx;
            if (og + 1u == (tg + 1u) * nx) xb_add(&bar[XB_TOPGEN], 1u);
            else XB_SPIN(xb_ld(&bar[XB_TOPGEN]) == tg, bar);
            __builtin_amdgcn_fence(__ATOMIC_ACQUIRE, "agent");
            xb_add(&bar[XB_XGEN(b.x)], 1u);
            asm volatile("s_waitcnt vmcnt(0)" ::: "memory");
        } else {
            XB_SPIN(xb_ld(&bar[XB_XGEN(b.x)]) == gen, bar);
            __builtin_amdgcn_fence(__ATOMIC_ACQUIRE, "agent");
            asm volatile("s_waitcnt vmcnt(0)" ::: "memory");
        }
    }
    __syncthreads();
}

namespace pg8 {
constexpr int BM = 256, BK = 64, HALF = 128, HTB = HALF * BK * 2, STAGE_BYTES = 8 * HTB, NXCD = 8, WGM = 8;
__host__ __device__ __forceinline__ int lds_byte(int r, int c) { return r * 128 + ((((c >> 3) ^ (r >> 1)) & 7) << 4) + (c & 7) * 2; }
__host__ __device__ __forceinline__ void stage_rc(int b, int& R, int& C) { R = b >> 7; C = ((((b >> 4) ^ (R >> 1)) & 7) << 3); }
__host__ __device__ __forceinline__ int perm32(int rho) { const int n = rho >> 4, i = rho & 15; return 8 * (i >> 2) + 4 * n + (i & 3); }

struct Unit { unsigned a, b; int row0, col0; };

struct DenseOrder {
    unsigned A, Bt; int K, nM, nN, nwg, G, c;
    __device__ void init(size_t A_, size_t Bt_, int M, int N, int K_, int G_, int c_) { A = (unsigned)A_; Bt = (unsigned)Bt_; K = K_; nM = M / BM; nN = N / BM; nwg = nM * nN; G = G_; c = c_; }
    __device__ bool next(int i, Unit& u) const {
        const long L = (long)i * G + c; if (L >= nwg) return false;
        int wgid = (int)L; { const int q = nwg / NXCD, r = nwg % NXCD, xcd = wgid % NXCD, off = wgid / NXCD; wgid = (xcd < r ? xcd * (q + 1) : r * (q + 1) + (xcd - r) * q) + off; }
        const int nig = WGM * nN, gid = wgid / nig, fm = gid * WGM, gsz = (nM - fm) < WGM ? (nM - fm) : WGM;
        const int pm = fm + ((wgid % nig) % gsz), pn = (wgid % nig) / gsz;
        u.a = A + (unsigned)(pm * BM * K * 2); u.b = Bt + (unsigned)(pn * BM * K * 2); u.row0 = pm * BM; u.col0 = pn * BM; return true;
    }
    __device__ __forceinline__ int arow(const Unit&, int) const { return 0; }
    __device__ __forceinline__ unsigned tokoff() const { return 0u; }
};
struct G1Order {
    unsigned h2, wgu; const int* tok; int G, c;
    __device__ bool next(int i, Unit& u) const {
        const long L = (long)i * G + c; if (L >= 4096) return false;
        const int e = (int)(L >> 8), w = (int)(L & 255), xcd = w & 7, l = w >> 3;
        const int pm = 4 * (xcd & 3) + (l & 3), pn = 8 * (xcd >> 2) + (l >> 2);
        u.a = h2; u.b = wgu + (unsigned)((e * 4096 + pn * 256) * DM); u.row0 = e * EROWS + pm * 256; u.col0 = pn * 128; return true;
    }
    __device__ __forceinline__ int arow(const Unit& u, int r) const { return tok[u.row0 + r]; }
    __device__ __forceinline__ unsigned tokoff() const { return (unsigned)WS_TOK; }
};
struct G2Order {
    unsigned H, wd; int G, c;
    __device__ bool next(int i, Unit& u) const {
        const long L = (long)i * G + c; if (L >= 1024) return false;
        const int r4 = (int)(L >> 8), w = (int)(L & 255), xcd = w & 7, l = w >> 3;
        const int e = 4 * r4 + (xcd >> 1), pm = 8 * (xcd & 1) + (l & 7), pn = l >> 3;
        u.a = H + (unsigned)((e * EROWS + pm * 256) * DFF); u.b = wd + (unsigned)((e * DM + pn * 256) * DFF); u.row0 = e * EROWS + pm * 256; u.col0 = pn * 256; return true;
    }
    __device__ __forceinline__ int arow(const Unit&, int) const { return 0; }
    __device__ __forceinline__ unsigned tokoff() const { return 0u; }
};

struct EpiP {
    static constexpr bool PERM = true, HAS_SCALE = true;
    bf16_t* P; unsigned soff;
    __device__ __forceinline__ unsigned scale_off() const { return soff; }
    __device__ __forceinline__ void operator()(const f32x4 (&acc)[2][2][4][2], const Unit& u, int wr, int wc, int fr, int fq, const LAS float* scl) const {
        const int row0 = u.row0 + wr * 64 + fr, col0 = u.col0 + wc * 32 + 8 * fq;
#pragma unroll
        for (int ai = 0; ai < 2; ++ai)
#pragma unroll
            for (int m = 0; m < 4; ++m) { const int r = row0 + ai * HALF + m * 16; const float rs = scl[wr * 64 + fr + ai * HALF + m * 16]; bf16_t* rowp = P + (size_t)r * NPROJ + col0;
#pragma unroll
                for (int bj = 0; bj < 2; ++bj) { const f32x4 v0 = acc[ai][bj][m][0] * rs, v1 = acc[ai][bj][m][1] * rs;
                    u32x4 w; w.x = cvt_pk_bf16(v0[0], v0[1]); w.y = cvt_pk_bf16(v0[2], v0[3]); w.z = cvt_pk_bf16(v1[0], v1[1]); w.w = cvt_pk_bf16(v1[2], v1[3]);
                    *(u32x4*)(rowp + bj * HALF) = w; } }
    }
};
struct EpiD {
    static constexpr bool PERM = true, HAS_SCALE = false;
    bf16_t* O; const bf16_t* XB;
    __device__ __forceinline__ unsigned scale_off() const { return 0u; }
    __device__ __forceinline__ void operator()(const f32x4 (&acc)[2][2][4][2], const Unit& u, int wr, int wc, int fr, int fq, const LAS float*) const {
        const int row0 = u.row0 + wr * 64 + fr, col0 = u.col0 + wc * 32 + 8 * fq;
#pragma unroll
        for (int ai = 0; ai < 2; ++ai) { u32x4 xv[4][2];
#pragma unroll
            for (int m = 0; m < 4; ++m)
#pragma unroll
                for (int bj = 0; bj < 2; ++bj) xv[m][bj] = *(const u32x4*)(XB + (size_t)(row0 + ai * HALF + m * 16) * DM + col0 + bj * HALF);
#pragma unroll
            for (int m = 0; m < 4; ++m) { bf16_t* rowp = O + (size_t)(row0 + ai * HALF + m * 16) * DM + col0;
#pragma unroll
                for (int bj = 0; bj < 2; ++bj) { const f32x4 v0 = acc[ai][bj][m][0], v1 = acc[ai][bj][m][1]; const u32x4 x = xv[m][bj];
                    u32x4 w; w.x = cvt_pk_bf16(v0[0] + bf2f(x.x & 0xffffu), v0[1] + bf2f(x.x >> 16)); w.y = cvt_pk_bf16(v0[2] + bf2f(x.y & 0xffffu), v0[3] + bf2f(x.y >> 16));
                    w.z = cvt_pk_bf16(v1[0] + bf2f(x.z & 0xffffu), v1[1] + bf2f(x.z >> 16)); w.w = cvt_pk_bf16(v1[2] + bf2f(x.w & 0xffffu), v1[3] + bf2f(x.w >> 16));
                    *(u32x4*)(rowp + bj * HALF) = w; } } }
    }
};
struct EpiH {
    static constexpr bool PERM = true, HAS_SCALE = true;
    unsigned char* Hh; unsigned soff;
    __device__ __forceinline__ unsigned scale_off() const { return soff; }
    __device__ __forceinline__ void operator()(const f32x4 (&acc)[2][2][4][2], const Unit& u, int wr, int wc, int fr, int fq, const LAS float* scl) const {
        const int row0 = u.row0 + wr * 64 + fr, col0 = u.col0 + wc * 32 + 8 * fq;
#pragma unroll
        for (int ai = 0; ai < 2; ++ai)
#pragma unroll
            for (int m = 0; m < 4; ++m) { const int r = row0 + ai * HALF + m * 16; unsigned char* rowp = Hh + (size_t)r * DFF + col0; const float rsc = scl[wr * 64 + fr + ai * HALF + m * 16] * 0.03125f;
                float h[8]; const float ke = -1.4426950408889634f * rsc, k2 = rsc * rsc;
#pragma unroll
                for (int n = 0; n < 2; ++n)
#pragma unroll
                    for (int jp = 0; jp < 2; ++jp) { const f32x2 ag = (f32x2){acc[ai][0][m][n][2 * jp], acc[ai][0][m][n][2 * jp + 1]}, au = (f32x2){acc[ai][1][m][n][2 * jp], acc[ai][1][m][n][2 * jp + 1]};
                        const f32x2 ex = ag * ke; f32x2 d; d.x = __builtin_amdgcn_exp2f(ex.x); d.y = __builtin_amdgcn_exp2f(ex.y); d = d + 1.0f;
                        f32x2 rc; rc.x = __builtin_amdgcn_rcpf(d.x); rc.y = __builtin_amdgcn_rcpf(d.y);
                        const f32x2 hv = (ag * au) * k2 * rc; h[n * 4 + 2 * jp] = hv.x; h[n * 4 + 2 * jp + 1] = hv.y; }
                u32x2 w; w.x = pk4_fp8(h[0], h[1], h[2], h[3]); w.y = pk4_fp8(h[4], h[5], h[6], h[7]);
                *(u32x2*)rowp = w; }
    }
};
struct EpiEo {
    static constexpr bool PERM = true, HAS_SCALE = true;
    unsigned char* O; unsigned soff;
    __device__ __forceinline__ unsigned scale_off() const { return soff; }
    __device__ __forceinline__ void operator()(const f32x4 (&acc)[2][2][4][2], const Unit& u, int wr, int wc, int fr, int fq, const LAS float* scl) const {
        const int row0 = u.row0 + wr * 64 + fr, col0 = u.col0 + wc * 32 + 8 * fq;
#pragma unroll
        for (int ai = 0; ai < 2; ++ai)
#pragma unroll
            for (int m = 0; m < 4; ++m) { const int r = row0 + ai * HALF + m * 16; const float gs = scl[wr * 64 + fr + ai * HALF + m * 16] * 0.5f; unsigned char* rowp = O + (size_t)r * DM + col0;
#pragma unroll
                for (int bj = 0; bj < 2; ++bj) { const f32x4 v0 = acc[ai][bj][m][0] * gs, v1 = acc[ai][bj][m][1] * gs;
                    u32x2 w; w.x = pk4_fp8(v0[0], v0[1], v0[2], v0[3]); w.y = pk4_fp8(v1[0], v1[1], v1[2], v1[3]);
                    *(u32x2*)(rowp + bj * HALF) = w; } }
    }
};

template <class Epi, class Sched, bool GATHER, bool FP8>
__device__ __forceinline__ void gemm_phase(LAS unsigned char* lds, const __amdgpu_buffer_rsrc_t rs, const int tid, const int KB, const Sched& S, const Epi& E) {
    const int wid = __builtin_amdgcn_readfirstlane(tid >> 6), lane = tid & 63, wr = wid >> 2, wc = wid & 3, fr = lane & 15, fq = lane >> 4;
    const int nt = KB / 128;
    int RA[2], CA[2];
    unsigned voffA[2][2], voffB[2];
#pragma unroll
    for (int i = 0; i < 2; ++i) { int R, C; stage_rc(tid * 16 + i * 8192, R, C); const int Rb = Epi::PERM ? ((R & ~31) + perm32(R & 31)) : R;
        RA[i] = R; CA[i] = C; voffB[i] = (unsigned)(Rb * KB + C * 2); }
    const unsigned kstep = 128u;
    const unsigned hstep = (unsigned)(HALF * KB);
    const unsigned ldsw = (unsigned)wid * 1024u;
    const int aoff = lds_byte(wr * 64 + fr, fq * 8), boff = lds_byte(wc * 32 + fr, fq * 8);
    const int aoff1 = lds_byte(wr * 64 + fr, 32 + fq * 8), boff1 = lds_byte(wc * 32 + fr, 32 + fq * 8);
#define PG8_SA(b, h) (((b) * 2 + (h)) * HTB)
#define PG8_SB(b, h) ((4 + (b) * 2 + (h)) * HTB)
#define PG8_STAGE(bufoff, gbase, voff) do { _Pragma("unroll") for (int _i = 0; _i < 2; ++_i) \
        __builtin_amdgcn_raw_ptr_buffer_load_lds(rs, (LAS void*)(lds + (bufoff) + ldsw + _i * 8192), 16, (int)(voff)[_i], (int)(gbase), 0, 0); } while (0)
#define PG8_STAGE_A(bufoff, gbase, h) do { if constexpr (GATHER) { PG8_STAGE(bufoff, gbase, voffA[h]); } else { PG8_STAGE(bufoff, (gbase) + (h) * hstep, voffA[0]); } } while (0)
#define PG8_LDA(dst, b, h) do { _Pragma("unroll") for (int m = 0; m < 4; ++m) { const i32x4 _lo = *(const LAS i32x4*)(lds + PG8_SA(b, h) + aoff + m * 2048), _hi = *(const LAS i32x4*)(lds + PG8_SA(b, h) + aoff1 + m * 2048); \
        dst[m] = __builtin_shufflevector(_lo, _hi, 0, 1, 2, 3, 4, 5, 6, 7); } } while (0)
#define PG8_LDB(dst, b, h) do { _Pragma("unroll") for (int n = 0; n < 2; ++n) { const i32x4 _lo = *(const LAS i32x4*)(lds + PG8_SB(b, h) + boff + n * 2048), _hi = *(const LAS i32x4*)(lds + PG8_SB(b, h) + boff1 + n * 2048); \
        dst[n] = __builtin_shufflevector(_lo, _hi, 0, 1, 2, 3, 4, 5, 6, 7); } } while (0)
#define PG8_MMA(ai, bj, At, Bt) do { __builtin_amdgcn_s_setprio(1); _Pragma("unroll") for (int m = 0; m < 4; ++m) _Pragma("unroll") for (int n = 0; n < 2; ++n) { \
        if constexpr (FP8) asm volatile("v_mfma_scale_f32_16x16x128_f8f6f4 %0, %1, %2, %0, %3, %3 op_sel_hi:[0,0,0]" : "+v"(acc[ai][bj][m][n]) : "v"(Bt[n]), "v"(At[m]), "v"(sc1)); \
        else { acc[ai][bj][m][n] = __builtin_amdgcn_mfma_f32_16x16x32_bf16((bf16x8)__builtin_shufflevector(Bt[n], Bt[n], 0, 1, 2, 3), (bf16x8)__builtin_shufflevector(At[m], At[m], 0, 1, 2, 3), acc[ai][bj][m][n], 0, 0, 0); \
               acc[ai][bj][m][n] = __builtin_amdgcn_mfma_f32_16x16x32_bf16((bf16x8)__builtin_shufflevector(Bt[n], Bt[n], 4, 5, 6, 7), (bf16x8)__builtin_shufflevector(At[m], At[m], 4, 5, 6, 7), acc[ai][bj][m][n], 0, 0, 0); } } \
        __builtin_amdgcn_s_setprio(0); } while (0)
#define PG8_WAIT_V(n) asm volatile("s_waitcnt vmcnt(" #n ")" ::: "memory")
#define PG8_WAIT_L(n) asm volatile("s_waitcnt lgkmcnt(" #n ")" ::: "memory")
#define PG8_BAR __builtin_amdgcn_s_barrier()
#define PG8_SCHED __builtin_amdgcn_sched_barrier(0)
#define PG8_SETVOFF(dst, unit) do { _Pragma("unroll") for (int _h = 0; _h < 2; ++_h) _Pragma("unroll") for (int _i = 0; _i < 2; ++_i) { \
        if constexpr (GATHER) dst[_h][_i] = (unsigned)(S.arow(unit, _h * HALF + RA[_i]) * KB + CA[_i] * 2); \
        else dst[_h][_i] = (unsigned)(RA[_i] * KB + CA[_i] * 2); } } while (0)
    Unit cur, nxt; int ui = 0;
    if (!S.next(0, cur)) return;
    int sc1 = 0x7f7f7f7f; asm volatile("" : "+v"(sc1));
    f32x4 acc[2][2][4][2];
#pragma unroll
    for (int a = 0; a < 2; ++a)
#pragma unroll
        for (int b = 0; b < 2; ++b)
#pragma unroll
            for (int m = 0; m < 4; ++m)
#pragma unroll
                for (int n = 0; n < 2; ++n) acc[a][b][m][n] = (f32x4){0.f, 0.f, 0.f, 0.f};
    i32x8 At[4], B0[2], B1[2];
    unsigned cA = cur.a, cB = cur.b;
    PG8_SETVOFF(voffA, cur);
    PG8_STAGE(PG8_SB(0, 0), cB, voffB); PG8_STAGE(PG8_SB(0, 1), cB + hstep, voffB); PG8_STAGE_A(PG8_SA(0, 0), cA, 0); PG8_STAGE_A(PG8_SA(0, 1), cA, 1);
    if (wr == 1) PG8_BAR;
    PG8_WAIT_V(2); PG8_BAR;
    PG8_STAGE(PG8_SB(1, 0), cB + kstep, voffB); PG8_STAGE_A(PG8_SA(1, 0), cA + kstep, 0); PG8_STAGE(PG8_SB(1, 1), cB + hstep + kstep, voffB);
    PG8_WAIT_V(6); PG8_BAR;
    for (;;) {
        const bool has_next = S.next(ui + 1, nxt);
        const unsigned nA = has_next ? nxt.a : cA, nB = has_next ? nxt.b : cB;
#pragma clang loop unroll(disable)
        for (int t = 0; t < nt; t += 2) {
            const bool last = (t == nt - 2);
            const unsigned a1 = cA + (unsigned)(t + 1) * kstep;
            const unsigned a2 = last ? nA : cA + (unsigned)(t + 2) * kstep, b2 = last ? nB : cB + (unsigned)(t + 2) * kstep;
            const unsigned a3 = a2 + kstep, b3 = b2 + kstep;
            unsigned nvoff[2][2];
            if constexpr (Epi::HAS_SCALE) { if (t == 0)
                    __builtin_amdgcn_raw_ptr_buffer_load_lds(rs, (LAS void*)(lds + 133120 + (ui & 1) * 2048 + (wid >> 2) * 1024 + (wid & 3) * 256), 4, (int)(lane * 4), (int)(E.scale_off() + (unsigned)(cur.row0 + (wid & 3) * 64) * 4u), 0, 0); }
            if constexpr (GATHER) {
                if (t == 0 && has_next)
                    __builtin_amdgcn_raw_ptr_buffer_load_lds(rs, (LAS void*)(lds + 131072 + (wid >> 2) * 1024 + (wid & 3) * 256), 4, (int)(lane * 4), (int)(S.tokoff() + (unsigned)(nxt.row0 + (wid & 3) * 64) * 4u), 0, 0);
                if (last && has_next) {
#pragma unroll
                    for (int _h = 0; _h < 2; ++_h)
#pragma unroll
                        for (int _i = 0; _i < 2; ++_i) nvoff[_h][_i] = (unsigned)(*(const LAS int*)(lds + 131072 + (_h * HALF + RA[_i]) * 4) * KB + CA[_i] * 2); } }
            PG8_LDB(B0, 0, 0); PG8_LDB(B1, 0, 1); PG8_SCHED; PG8_LDA(At, 0, 0); PG8_STAGE_A(PG8_SA(1, 1), a1, 1);
            PG8_WAIT_V(8); PG8_WAIT_L(0); PG8_BAR; PG8_MMA(0, 0, At, B0); PG8_MMA(0, 1, At, B1); PG8_BAR; PG8_SCHED;
            if constexpr (GATHER) { if (last && has_next) {
#pragma unroll
                for (int _h = 0; _h < 2; ++_h)
#pragma unroll
                    for (int _i = 0; _i < 2; ++_i) voffA[_h][_i] = nvoff[_h][_i]; } }
            PG8_LDA(At, 0, 1); PG8_STAGE(PG8_SB(0, 0), b2, voffB); PG8_STAGE(PG8_SB(0, 1), b2 + hstep, voffB);
            PG8_WAIT_V(6); PG8_WAIT_L(0); PG8_BAR; PG8_MMA(1, 0, At, B0); PG8_SCHED; PG8_STAGE_A(PG8_SA(0, 0), a2, 0); PG8_SCHED; PG8_MMA(1, 1, At, B1); PG8_BAR; PG8_SCHED;
            PG8_LDB(B0, 1, 0); PG8_LDB(B1, 1, 1); PG8_SCHED; PG8_LDA(At, 1, 0); PG8_STAGE_A(PG8_SA(0, 1), a2, 1);
            PG8_WAIT_V(8); PG8_WAIT_L(0); PG8_BAR; PG8_MMA(0, 0, At, B0); PG8_MMA(0, 1, At, B1); PG8_BAR; PG8_SCHED;
            PG8_LDA(At, 1, 1); PG8_STAGE(PG8_SB(1, 0), b3, voffB); PG8_STAGE(PG8_SB(1, 1), b3 + hstep, voffB);
            PG8_WAIT_V(6); PG8_WAIT_L(0); PG8_BAR; PG8_MMA(1, 0, At, B0); PG8_SCHED; PG8_STAGE_A(PG8_SA(1, 0), a3, 0); PG8_SCHED; PG8_MMA(1, 1, At, B1); PG8_BAR; PG8_SCHED;
        }
        if (wr == 0) PG8_BAR;
        if constexpr (FP8) asm volatile("s_nop 15\n\ts_nop 15" ::: "memory");
        E(acc, cur, wr, wc, fr, fq, (const LAS float*)(lds + 133120 + (ui & 1) * 2048));
        if (!has_next) break;
#pragma unroll
        for (int a = 0; a < 2; ++a)
#pragma unroll
            for (int b = 0; b < 2; ++b)
#pragma unroll
                for (int m = 0; m < 4; ++m)
#pragma unroll
                    for (int n = 0; n < 2; ++n) acc[a][b][m][n] = (f32x4){0.f, 0.f, 0.f, 0.f};
        cur = nxt; cA = nA; cB = nB; ++ui;
        if (wr == 1) PG8_BAR;
    }
    PG8_WAIT_V(0);
    PG8_BAR;
#undef PG8_SA
#undef PG8_SB
#undef PG8_STAGE
#undef PG8_STAGE_A
#undef PG8_LDA
#undef PG8_LDB
#undef PG8_MMA
#undef PG8_WAIT_V
#undef PG8_WAIT_L
#undef PG8_BAR
#undef PG8_SCHED
#undef PG8_SETVOFF
}
}

struct Args { const float* in[22]; float* out; unsigned char* ws; int ph_lo, ph_hi, rep_phase, rep_n; };
typedef const __attribute__((address_space(4))) Args KArgs;
struct Frame {
    LAS unsigned char* lds;
    int tid, lane, wave, G, bx, vcu;
};

__device__ __forceinline__ void transpose_item(const float* W, int N, int k0, int n0, bf16_t* WT, int ldk, int drow0, const float* kscale, LAS float* scr, int lane) {
#pragma unroll 8
    for (int i = 0; i < 32; ++i) { const int kk = 2 * i + (lane >> 5); float v = W[(size_t)(k0 + kk) * N + n0 + (lane & 31)]; if (kscale) v *= kscale[k0 + kk]; scr[kk * 33 + (lane & 31)] = v; }
    LDS_WAIT(); asm volatile("" ::: "memory");
    const int c = lane & 7;
#pragma unroll
    for (int j = 0; j < 4; ++j) { const int n = (lane >> 3) + 8 * j; const LAS float* s = scr + (8 * c) * 33 + n;
        u32x4 o; o.x = pk2(s[0 * 33], s[1 * 33]); o.y = pk2(s[2 * 33], s[3 * 33]); o.z = pk2(s[4 * 33], s[5 * 33]); o.w = pk2(s[6 * 33], s[7 * 33]);
        *(u32x4*)(WT + (size_t)(drow0 + n) * ldk + k0 + 8 * c) = o; }
    LDS_WAIT(); asm volatile("" ::: "memory");
}
struct WItem { const float* src; unsigned char* dst; int N, ldk; };
__device__ __forceinline__ WItem w_item(KArgs& a, int which, int r, int lane) {
    unsigned char* ws = a.ws; WItem it; const int e = r >> 9, q = r & 511; const int kq = lane >> 4, n4 = (lane & 15) * 4;
    if (which < 2) { const int kb = q >> 5, nb = q & 31, n0 = nb * 64; it.N = DFF; it.ldk = DM;
        it.src = a.in[18 + which] + (size_t)e * DM * DFF + (size_t)(kb * 64 + kq) * DFF + n0 + n4;
        it.dst = (unsigned char*)(ws + WS_WGU) + (size_t)e * 4096 * DM + (size_t)((n0 >> 7) * 256 + which * 128 + (n0 & 127)) * DM + kb * 64; }
    else { const int kb = q >> 4, nb = q & 15; it.N = DM; it.ldk = DFF;
        it.src = a.in[20] + (size_t)e * DFF * DM + (size_t)(kb * 64 + kq) * DM + nb * 64 + n4;
        it.dst = (unsigned char*)(ws + WS_WD) + (size_t)e * DM * DFF + (size_t)(nb * 64) * DFF + kb * 64; }
    return it;
}
__device__ __forceinline__ void w_load(const WItem& it, f32x4 (&v)[16]) {
#pragma unroll
    for (int i = 0; i < 16; ++i) v[i] = __builtin_nontemporal_load((const f32x4*)(it.src + (size_t)(4 * i) * it.N));
}
__device__ __forceinline__ void w_finish(const WItem& it, const f32x4 (&v)[16], LAS float* scr, int lane) {
    const int kq = lane >> 4, n4 = (lane & 15) * 4;
#pragma unroll
    for (int i = 0; i < 16; ++i) { const int kk = kq + 4 * i; *(LAS f32x4*)(scr + kk * 68 + ((n4 + 8 * (kk >> 4)) & 63)) = v[i] * 32.0f; }
    LDS_WAIT(); asm volatile("" ::: "memory");
    const int nl = lane >> 2, j = lane & 3;
#pragma unroll
    for (int p = 0; p < 4; ++p) { const int n = 16 * p + nl; const LAS float* sp = scr + (16 * j) * 68 + ((n + 8 * j) & 63);
        u32x4 o; o.x = pk4_fp8(sp[0 * 68], sp[1 * 68], sp[2 * 68], sp[3 * 68]); o.y = pk4_fp8(sp[4 * 68], sp[5 * 68], sp[6 * 68], sp[7 * 68]);
        o.z = pk4_fp8(sp[8 * 68], sp[9 * 68], sp[10 * 68], sp[11 * 68]); o.w = pk4_fp8(sp[12 * 68], sp[13 * 68], sp[14 * 68], sp[15 * 68]);
        *(u32x4*)(it.dst + (size_t)n * it.ldk + 16 * j) = o; }
    LDS_WAIT(); asm volatile("" ::: "memory");
}
constexpr int WD_SPLIT = 6144;
__device__ __forceinline__ void expert_w_items(const Frame& F, KArgs& a, int which, int gwi, int ngw, int r_lo = 0, int r_hi = 8192) {
    LAS float* scr = (LAS float*)(F.lds + F.wave * 17408);
    for (int r = r_lo + gwi; r < r_hi; r += ngw) { const WItem it = w_item(a, which, r, F.lane); f32x4 v[16]; w_load(it, v); w_finish(it, v, scr, F.lane); }
}
__device__ __forceinline__ void p0_prep(const Frame& F, KArgs& a) {
    unsigned char* ws = a.ws;
    LAS float* scr = (LAS float*)(F.lds + F.wave * 17408);
    const int gw = F.vcu * NWAVES + F.wave, NGW = F.G * NWAVES;
    for (int r0 = (a.rep_phase == 100) ? a.rep_n : 0; r0 >= 0; --r0) { const float* x = a.in[0]; bf16_t* xb = (bf16_t*)(ws + WS_XB); float* rstd = (float*)(ws + WS_RSTD1);
      for (int m = gw; m < MTOK; m += 2 * NGW) {
          const int m2 = m + NGW;
          const f32x4* xr = (const f32x4*)(x + (size_t)m * DM) + F.lane; const f32x4* xr2 = (const f32x4*)(x + (size_t)(m2 < MTOK ? m2 : m) * DM) + F.lane; f32x4 v[4], v2[4]; float s = 0.f, s2 = 0.f;
#pragma unroll
          for (int j = 0; j < 4; ++j) { v[j] = __builtin_nontemporal_load(xr + 64 * j); v2[j] = __builtin_nontemporal_load(xr2 + 64 * j); }
#pragma unroll
          for (int j = 0; j < 4; ++j) { s += (v[j].x * v[j].x + v[j].y * v[j].y) + (v[j].z * v[j].z + v[j].w * v[j].w); s2 += (v2[j].x * v2[j].x + v2[j].y * v2[j].y) + (v2[j].z * v2[j].z + v2[j].w * v2[j].w); }
          s = wave_sum(s); s2 = wave_sum(s2);
          if (F.lane == 0) { rstd[m] = 1.0f / sqrtf(s * (1.0f / DM) + EPS); if (m2 < MTOK) rstd[m2] = 1.0f / sqrtf(s2 * (1.0f / DM) + EPS); }
          unsigned long long* o8 = (unsigned long long*)(xb + (size_t)m * DM) + F.lane;
#pragma unroll
          for (int j = 0; j < 4; ++j) o8[64 * j] = (unsigned long long)pk2(v[j].x, v[j].y) | ((unsigned long long)pk2(v[j].z, v[j].w) << 32);
          if (m2 < MTOK) { unsigned long long* o82 = (unsigned long long*)(xb + (size_t)m2 * DM) + F.lane;
#pragma unroll
              for (int j = 0; j < 4; ++j) o82[64 * j] = (unsigned long long)pk2(v2[j].x, v2[j].y) | ((unsigned long long)pk2(v2[j].z, v2[j].w) << 32); }
      } }
    for (int r0 = (a.rep_phase == 101) ? a.rep_n : 0; r0 >= 0; --r0) { constexpr int I_WIN = 16 * 48, I_WOUT = 8 * 32;
      bf16_t* WinT = (bf16_t*)(ws + WS_WIN); bf16_t* W2T = (bf16_t*)(ws + WS_W2);
      for (int it = gw; it < I_WIN + I_WOUT; it += NGW) {
          int r = it;
          if (r < I_WIN) { const int kb = r / 48, nb = r % 48; transpose_item(a.in[2], NPROJ, kb * 64, nb * 32, WinT, DM, nb * 32, a.in[1], scr, F.lane); continue; } r -= I_WIN;
          { const int kb = r / 32, nb = r % 32; transpose_item(a.in[15], DM, kb * 64, nb * 32, W2T, KOUT, nb * 32, nullptr, scr, F.lane); }
      } }
    for (int r0 = (a.rep_phase == 102) ? a.rep_n : 0; r0 >= 0; --r0) { expert_w_items(F, a, 0, gw, NGW); expert_w_items(F, a, 1, gw, NGW); expert_w_items(F, a, 2, gw, NGW, 0, WD_SPLIT); }
    { LAS float* ctab = (LAS float*)(F.lds);
      __syncthreads();
      if (F.tid < 128) ctab[F.tid] = cospif((float)F.tid * (1.0f / 64.0f));
      __syncthreads();
      const float* wout = a.in[15]; bf16_t* W2T = (bf16_t*)(ws + WS_W2);
      for (int it = gw; it < 2048; it += NGW) {
          const int kb = it >> 4, nb = it & 15; const int krow0 = 512 + kb * 8; const int sn = (krow0 >= 1024) ? 1 : 0; const int cg0 = (krow0 - 512 - sn * 512); const int g = cg0 >> 7, c0 = cg0 & 127;
          const int n = nb * 64 + F.lane; float accv[8];
#pragma unroll
          for (int i = 0; i < 8; ++i) accv[i] = 0.f;
          const float* wp = wout + (size_t)(512 + g * 128) * DM + n;
#pragma unroll 1
          for (int jb = 0; jb < 128; jb += 32) { float wv[32];
#pragma unroll
              for (int jj = 0; jj < 32; ++jj) wv[jj] = wp[(size_t)(jb + jj) * DM];
#pragma unroll
              for (int jj = 0; jj < 32; ++jj) { const int j = jb + jj;
#pragma unroll
                  for (int i = 0; i < 8; ++i) { const int ph = (j * (c0 + i) - sn * 32) & 127; accv[i] += ctab[ph] * wv[jj]; } } }
          const float sc = sn ? (-1.0f / 1024.0f) : (1.0f / 1024.0f);
          u32x4 o; o.x = pk2(accv[0] * sc, accv[1] * sc); o.y = pk2(accv[2] * sc, accv[3] * sc); o.z = pk2(accv[4] * sc, accv[5] * sc); o.w = pk2(accv[6] * sc, accv[7] * sc);
          *(u32x4*)(W2T + (size_t)n * KOUT + krow0) = o;
      } }
    { bf16_t* WgT = (bf16_t*)(ws + WS_WGT);
      for (int o = (F.vcu * NTHREADS + F.tid); o < NHEAD * 256 * 64; o += F.G * NTHREADS) {
          const int k = o & 63, n = (o >> 6) & 255, h = o >> 14, mat = n >> 6, j = n & 63;
          const float* W = a.in[mat == 0 ? 5 : mat == 1 ? 7 : mat == 2 ? 10 : 12];
          WgT[o] = (bf16_t)f2bf(W[(h * 64 + k) * 64 + j]);
      } }
}

__device__ constexpr float TWR[32] = {1.000000000e+00f, 9.951847267e-01f, 9.807852804e-01f, 9.569403357e-01f, 9.238795325e-01f, 8.819212643e-01f, 8.314696123e-01f, 7.730104534e-01f, 7.071067812e-01f, 6.343932842e-01f, 5.555702330e-01f, 4.713967368e-01f, 3.826834324e-01f, 2.902846773e-01f, 1.950903220e-01f, 9.801714033e-02f, 0.0f, -9.801714033e-02f, -1.950903220e-01f, -2.902846773e-01f, -3.826834324e-01f, -4.713967368e-01f, -5.555702330e-01f, -6.343932842e-01f, -7.071067812e-01f, -7.730104534e-01f, -8.314696123e-01f, -8.819212643e-01f, -9.238795325e-01f, -9.569403357e-01f, -9.807852804e-01f, -9.951847267e-01f};
__device__ constexpr float TWI[32] = {-0.0f, -9.801714033e-02f, -1.950903220e-01f, -2.902846773e-01f, -3.826834324e-01f, -4.713967368e-01f, -5.555702330e-01f, -6.343932842e-01f, -7.071067812e-01f, -7.730104534e-01f, -8.314696123e-01f, -8.819212643e-01f, -9.238795325e-01f, -9.569403357e-01f, -9.807852804e-01f, -9.951847267e-01f, -1.000000000e+00f, -9.951847267e-01f, -9.807852804e-01f, -9.569403357e-01f, -9.238795325e-01f, -8.819212643e-01f, -8.314696123e-01f, -7.730104534e-01f, -7.071067812e-01f, -6.343932842e-01f, -5.555702330e-01f, -4.713967368e-01f, -3.826834324e-01f, -2.902846773e-01f, -1.950903220e-01f, -9.801714033e-02f};
constexpr int bitrev_c(int i, int n) { int r = 0; for (int b = 0; b < n; ++b) r |= ((i >> b) & 1) << (n - 1 - b); return r; }
template <int N, int ST, int L> struct FftStage {
    static __device__ __forceinline__ void run(float (&re)[N], float (&im)[N]) {
        constexpr int m = 1 << ST, h = m >> 1;
#pragma unroll
        for (int kk = 0; kk < N; kk += m) {
#pragma unroll
            for (int j = 0; j < h; ++j) {
                const float wr = TWR[j * (64 / m)], wi = TWI[j * (64 / m)];
                const float xr = re[kk + j + h], xi = im[kk + j + h];
                const float tr = wr * xr - wi * xi, ti = wr * xi + wi * xr;
                re[kk + j + h] = re[kk + j] - tr; im[kk + j + h] = im[kk + j] - ti;
                re[kk + j] += tr; im[kk + j] += ti;
            }
        }
        if constexpr (ST < L) FftStage<N, ST + 1, L>::run(re, im);
    }
};
template <int N, int L> __device__ __forceinline__ void fft_inreg(float (&re)[N], float (&im)[N]) {
#pragma unroll
    for (int i = 0; i < N; ++i) { const int j = bitrev_c(i, L); if (i < j) { float t = re[i]; re[i] = re[j]; re[j] = t; t = im[i]; im[i] = im[j]; im[j] = t; } }
    FftStage<N, 1, L>::run(re, im);
}

__device__ __forceinline__ void fft1_item(const Frame& F, const bf16_t* P, u32x2* V, int item) {
    const int b = item >> 7, sg = (item >> 3) & 15, cc = item & 7;
    const int s2a = 16 * sg + 2 * F.wave, c = cc * 64 + F.lane;
    float re[32], im[32];
    const bf16_t* src = P + ((size_t)b * SEQ + s2a) * NPROJ + 1024 + c;
#pragma unroll
    for (int i = 0; i < 32; ++i) { re[i] = bf2f(__builtin_nontemporal_load(src + (size_t)i * 256 * NPROJ)); im[i] = bf2f(__builtin_nontemporal_load(src + (size_t)i * 256 * NPROJ + NPROJ)); }
    fft_inreg<32, 5>(re, im);
    float sa, ca, sb, cb; sincospif((float)s2a * (1.0f / 4096.0f), &sa, &ca); sincospif((float)(s2a + 1) * (1.0f / 4096.0f), &sb, &cb);
    float war = 1.f, wai = 0.f, wbr = 1.f, wbi = 0.f;
    u32x2* dst = V + (((size_t)b * 17) * 128 + (s2a >> 1)) * 512 + c;
#pragma unroll
    for (int k = 0; k <= 16; ++k) {
        const int km = (32 - k) & 31;
        const float ar = 0.5f * (re[k] + re[km]), ai = 0.5f * (im[k] - im[km]), br = 0.5f * (im[k] + im[km]), bi = -0.5f * (re[k] - re[km]);
        f32x2 va, vb; va.x = ar * war - ai * wai; va.y = ar * wai + ai * war; vb.x = br * wbr - bi * wbi; vb.y = br * wbi + bi * wbr;
        dst[(size_t)k * 128 * 512] = (u32x2){pk2(va.x, va.y), pk2(vb.x, vb.y)};
        const float t0 = war * ca + wai * sa; wai = wai * ca - war * sa; war = t0;
        const float t1 = wbr * cb + wbi * sb; wbi = wbi * cb - wbr * sb; wbr = t1;
    }
}
__device__ __forceinline__ void fft2_item(const Frame& F, const u32x2* V, bf16_t* A2, int b, int k1, int cc) {
    const int w = F.wave, c = cc * 64 + F.lane;
    LAS f32x2* T = (LAS f32x2*)F.lds;
    { u32x2 pv[16];
      const u32x2* src = V + (((size_t)b * 17 + k1) * 128 + w) * 512 + c;
#pragma unroll
      for (int j1 = 0; j1 < 16; ++j1) pv[j1] = __builtin_nontemporal_load(src + (size_t)j1 * 8 * 512);
#pragma unroll
      for (int jj = 0; jj < 2; ++jj) { const int j2 = 2 * w + jj; float re[16], im[16];
#pragma unroll
          for (int j1 = 0; j1 < 16; ++j1) { const unsigned q = jj ? pv[j1].y : pv[j1].x; re[j1] = bf2f(q & 0xffffu); im[j1] = bf2f(q >> 16); }
          fft_inreg<16, 4>(re, im);
#pragma unroll
          for (int q1 = 0; q1 < 16; ++q1) { float sn, cs; sincospif((float)(q1 * j2) * (1.0f / 128.0f), &sn, &cs);
              f32x2 o; o.x = re[q1] * cs + im[q1] * sn; o.y = im[q1] * cs - re[q1] * sn; T[(q1 * 16 + j2) * 64 + F.lane] = o; } } }
    __syncthreads();
#pragma unroll 1
    for (int qq = 0; qq < 2; ++qq) { const int q1 = 2 * w + qq; float re[16], im[16];
#pragma unroll
        for (int j2 = 0; j2 < 16; ++j2) { const f32x2 v = T[(q1 * 16 + j2) * 64 + F.lane]; re[j2] = v.x; im[j2] = v.y; }
        fft_inreg<16, 4>(re, im);
#pragma unroll
        for (int q2 = 0; q2 < 16; ++q2) { const int k = k1 + 32 * (q1 + 16 * q2);
            bf16_t* d = A2 + ((size_t)b * SEQ + k) * KOUT + 512 + c; d[0] = (bf16_t)f2bf(re[q2]); d[512] = (bf16_t)f2bf(-im[q2]);
            if (k1 != 0 && k1 != 16) { bf16_t* dm = A2 + ((size_t)b * SEQ + (SEQ - k)) * KOUT + 512 + c; dm[0] = (bf16_t)f2bf(re[q2]); dm[512] = (bf16_t)f2bf(im[q2]); } } }
    __syncthreads();
}

constexpr int LRU_WG = 0, LRU_CS = 32768, LRU_CF = 49152, LRU_XT = 81920, LRU_GT = 98816  , LRU_AGW = 115200, LRU_WCAR = 123392, LRU_CARRY = 127488, LRU_CONST = 131584;
static_assert(LRU_XT + 131 * 128 <= LRU_GT && LRU_GT + 16384 <= LRU_AGW && LRU_AGW + 8192 <= LRU_WCAR && LRU_WCAR + 4096 <= LRU_CARRY && LRU_CARRY + 4096 <= LRU_CONST && LRU_CONST + 11 * 256 <= MISC_OFF, "LRU LDS map");
template <int PASS>
__device__ __forceinline__ void lru_super_item(const Frame& F, KArgs& a, int si) {
    const int b = si >> 6, h = (si >> 3) & 7, j0 = (si & 7) * 8;
    const int tid = F.tid, lane = F.lane, w = F.wave, fr = lane & 15, fq = lane >> 4;
    unsigned char* ws = a.ws;
    const bf16_t* P = (const bf16_t*)a.out;
    LAS unsigned char* lds = F.lds;
    f32x2* agg = (f32x2*)(ws + WS_AGG);
    { const bf16_t* WgT = (const bf16_t*)(ws + WS_WGT) + (size_t)h * 256 * 64;
#pragma unroll
      for (int i = 0; i < 4; ++i) { const int q = tid + 512 * i, n = q >> 3, ch = q & 7; const u32x4 v = *(const u32x4*)(WgT + n * 64 + ch * 8); *(LAS u32x4*)(lds + LRU_WG + n * 128 + ((ch ^ (n & 7)) << 4)) = v; } }
    { LAS float* KC = (LAS float*)(lds + LRU_CONST);
      if (tid < 64) { const int ch = h * 64 + tid;
          KC[0 * 64 + tid] = -8.0f * log1pf(expf(-a.in[9][ch])) * 1.4426950408889634f; KC[1 * 64 + tid] = -8.0f * log1pf(expf(-a.in[14][ch])) * 1.4426950408889634f;
          KC[2 * 64 + tid] = a.in[6][ch]; KC[3 * 64 + tid] = a.in[8][ch]; KC[4 * 64 + tid] = a.in[11][ch]; KC[5 * 64 + tid] = a.in[13][ch]; KC[6 * 64 + tid] = a.in[4][ch];
#pragma unroll
          for (int k = 0; k < 4; ++k) KC[(7 + k) * 64 + tid] = a.in[3][k * DLRU + ch]; } }
    const LAS float* KC = (const LAS float*)(lds + LRU_CONST);
    const int ch4 = tid & 15, tq = tid >> 4;
    if (PASS == 2) {
        if (tid < 128) { const int dir = tid >> 6, ch = tid & 63; LAS float* CAR = (LAS float*)(lds + LRU_CARRY);
            float carry = 0.f;
            if (dir == 0) { for (int jj = 0; jj < j0 + 8; ++jj) { if (jj >= j0) CAR[((jj - j0) * 2 + 0) * 64 + ch] = carry; const f32x2 ah = agg[(((size_t)b * 64 + jj) * 2 + 0) * 512 + h * 64 + ch]; carry = ah.x * carry + ah.y; } }
            else { for (int jj = 63; jj >= j0; --jj) { if (jj < j0 + 8) CAR[((jj - j0) * 2 + 1) * 64 + ch] = carry; const f32x2 ah = agg[(((size_t)b * 64 + jj) * 2 + 1) * 512 + h * 64 + ch]; carry = ah.x * carry + ah.y; } }
        }
    }
    __syncthreads();
    u32x4 px[3], pg[2];
#define LRU_LOAD_CHUNK(jj) do { const int _t0 = (jj) * 128; \
        _Pragma("unroll") for (int _i = 0; _i < 3; ++_i) { const int _q = tid + 512 * _i, _r = _q >> 3, _c = _q & 7, _t = _t0 - 2 + _r; px[_i] = (u32x4){0u, 0u, 0u, 0u}; \
            if (_q < 131 * 8 && _t >= 0 && _t < SEQ) px[_i] = *(const u32x4*)(P + ((size_t)b * SEQ + _t) * NPROJ + h * 64 + _c * 8); } \
        if (PASS == 2) { _Pragma("unroll") for (int _i = 0; _i < 2; ++_i) { const int _q = tid + 512 * _i, _r = _q >> 3, _c = _q & 7; pg[_i] = *(const u32x4*)(P + ((size_t)b * SEQ + _t0 + _r) * NPROJ + 512 + h * 64 + _c * 8); } } } while (0)
    LRU_LOAD_CHUNK(j0);
    for (int jl = 0; jl < 8; ++jl) {
        const int j = j0 + jl, t0 = j * 128;
#pragma unroll
        for (int i = 0; i < 3; ++i) { const int q = tid + 512 * i, r = q >> 3, chk = q & 7; if (q < 131 * 8) *(LAS u32x4*)(lds + LRU_XT + r * 128 + chk * 16) = px[i]; }
        if (PASS == 2) {
#pragma unroll
            for (int i = 0; i < 2; ++i) { const int q = tid + 512 * i, r = q >> 3, chk = q & 7; *(LAS u32x4*)(lds + LRU_GT + r * 128 + chk * 16) = pg[i]; } }
        __syncthreads();
        if (jl < 7) LRU_LOAD_CHUNK(j + 1);
        { float xv[7][4]; const f32x4 cbias = *(const LAS f32x4*)(KC + 6 * 64 + ch4 * 4); f32x4 cwv[4];
#pragma unroll
          for (int k = 0; k < 4; ++k) cwv[k] = *(const LAS f32x4*)(KC + (7 + k) * 64 + ch4 * 4);
#pragma unroll
          for (int r = 0; r < 7; ++r) { const u32x2 v = *(const LAS u32x2*)(lds + LRU_XT + (4 * tq + r) * 128 + ch4 * 8); xv[r][0] = bf2f(v.x & 0xffffu); xv[r][1] = bf2f(v.x >> 16); xv[r][2] = bf2f(v.y & 0xffffu); xv[r][3] = bf2f(v.y >> 16); }
#pragma unroll
          for (int tt = 0; tt < 4; ++tt) { const int t = 4 * tq + tt; f32x4 cv;
#pragma unroll
              for (int i = 0; i < 4; ++i) { float s = cbias[i];
#pragma unroll
                  for (int k = 0; k < 4; ++k) s += cwv[k][i] * xv[tt + k][i];
                  cv[i] = s; }
              *(LAS f32x4*)(lds + LRU_CF + t * 256 + ch4 * 16) = cv;
              u32x2 pk; pk.x = pk2(cv[0], cv[1]); pk.y = pk2(cv[2], cv[3]);
              *(LAS u32x2*)(lds + LRU_CS + t * 128 + (((ch4 >> 1) ^ (t & 7)) << 4) + (ch4 & 1) * 8) = pk; } }
        __syncthreads();
        bf16x8 af[2];
        { const int row = 16 * w + fr;
#pragma unroll
          for (int kk = 0; kk < 2; ++kk) af[kk] = *(const LAS bf16x8*)(lds + LRU_CS + row * 128 + (((kk * 4 + fq) ^ (row & 7)) << 4)); }
#pragma unroll 1
        for (int hf = 0; hf < 2; ++hf) {
            float Pf[2][4], Hf[2][4], Pb[2][4], Hb[2][4];
#pragma unroll
            for (int cb = 0; cb < 2; ++cb) { const int cb4 = 2 * hf + cb;
                f32x4 acc[4];
#pragma unroll
                for (int mat = 0; mat < 4; ++mat) { acc[mat] = (f32x4){0.f, 0.f, 0.f, 0.f}; const int n = (mat * 4 + cb4) * 16 + fr;
#pragma unroll
                    for (int kk = 0; kk < 2; ++kk) { const bf16x8 bfr = *(const LAS bf16x8*)(lds + LRU_WG + n * 128 + (((kk * 4 + fq) ^ (n & 7)) << 4)); acc[mat] = __builtin_amdgcn_mfma_f32_16x16x32_bf16(af[kk], bfr, acc[mat], 0, 0, 0); } }
                float af_[4], bf_[4], ab_[4], bb_[4]; const int chl = cb4 * 16 + fr;
                const float k_c8f = KC[chl], k_c8b = KC[64 + chl], k_baf = KC[128 + chl], k_bxf = KC[192 + chl], k_bab = KC[256 + chl], k_bxb = KC[320 + chl];
#pragma unroll
                for (int r = 0; r < 4; ++r) { const int t = 16 * w + 4 * fq + r; const float cval = *(const LAS float*)(lds + LRU_CF + t * 256 + chl * 4);
                    const float rf = fast_sigmoid(acc[0][r] + k_baf), xf = fast_sigmoid(acc[1][r] + k_bxf);
                    const float rb = fast_sigmoid(acc[2][r] + k_bab), xb = fast_sigmoid(acc[3][r] + k_bxb);
                    const float a1 = __builtin_amdgcn_exp2f(k_c8f * rf), a2 = __builtin_amdgcn_exp2f(k_c8b * rb);
                    af_[r] = a1; bf_[r] = __builtin_amdgcn_sqrtf(fmaxf(fmaf(-a1, a1, 1.0f), 0.f)) * xf * cval;
                    ab_[r] = a2; bb_[r] = __builtin_amdgcn_sqrtf(fmaxf(fmaf(-a2, a2, 1.0f), 0.f)) * xb * cval; }
                Pf[cb][0] = af_[0]; Hf[cb][0] = bf_[0];
#pragma unroll
                for (int r = 1; r < 4; ++r) { Pf[cb][r] = af_[r] * Pf[cb][r - 1]; Hf[cb][r] = af_[r] * Hf[cb][r - 1] + bf_[r]; }
                Pb[cb][3] = ab_[3]; Hb[cb][3] = bb_[3];
#pragma unroll
                for (int r = 2; r >= 0; --r) { Pb[cb][r] = ab_[r] * Pb[cb][r + 1]; Hb[cb][r] = ab_[r] * Hb[cb][r + 1] + bb_[r]; }
            }
            float gPf[2], gHf[2], gPb[2], gHb[2];
            { LAS f32x2* AGW = (LAS f32x2*)(lds + LRU_AGW);
#pragma unroll
              for (int cb = 0; cb < 2; ++cb) { const int chl = (2 * hf + cb) * 16 + fr;
                  const bool odd = (fq & 1) != 0, hi = (fq & 2) != 0;
                  { const float A = Pf[cb][3], H = Hf[cb][3];
                    const float A1 = xchg16(A, lane), H1 = xchg16(H, lane);
                    const float pA = odd ? A1 : 1.f, pH = odd ? H1 : 0.f, qA = A * A1, qH = odd ? (A * H1 + H) : (A1 * H + H1);
                    const float QA = xchg32(qA, lane), QH = xchg32(qH, lane);
                    gPf[cb] = hi ? pA * QA : pA; gHf[cb] = hi ? (pA * QH + pH) : pH;
                    if (fq == 0) AGW[(w * 2 + 0) * 64 + chl] = (f32x2){qA * QA, QA * qH + QH}; }
                  { const float A = Pb[cb][0], H = Hb[cb][0];
                    const float A1 = xchg16(A, lane), H1 = xchg16(H, lane);
                    const float pA = odd ? 1.f : A1, pH = odd ? 0.f : H1, qA = A * A1, qH = odd ? (A1 * H + H1) : (A * H1 + H);
                    const float QA = xchg32(qA, lane), QH = xchg32(qH, lane);
                    gPb[cb] = hi ? pA : pA * QA; gHb[cb] = hi ? pH : (pA * QH + pH);
                    if (fq == 0) AGW[(w * 2 + 1) * 64 + chl] = (f32x2){qA * QA, qA * QH + qH}; }
              } }
            __syncthreads();
            if (tid < 64) { const int dir = tid >> 5, ch = hf * 32 + (tid & 31); const LAS f32x2* AGW = (const LAS f32x2*)(lds + LRU_AGW); LAS float* WCAR = (LAS float*)(lds + LRU_WCAR);
                float carry = (PASS == 2) ? ((const LAS float*)(lds + LRU_CARRY))[(jl * 2 + dir) * 64 + ch] : 0.f; float ptot = 1.f;
                if (dir == 0) { for (int ww = 0; ww < 8; ++ww) { WCAR[(ww * 2 + 0) * 64 + ch] = carry; const f32x2 ah = AGW[(ww * 2 + 0) * 64 + ch]; carry = ah.x * carry + ah.y; ptot *= ah.x; } }
                else { for (int ww = 7; ww >= 0; --ww) { WCAR[(ww * 2 + 1) * 64 + ch] = carry; const f32x2 ah = AGW[(ww * 2 + 1) * 64 + ch]; carry = ah.x * carry + ah.y; ptot *= ah.x; } }
                if (PASS == 1) agg[(((size_t)b * 64 + j) * 2 + dir) * 512 + h * 64 + ch] = (f32x2){ptot, carry};
            }
            if (PASS == 2) {
                __syncthreads();
                const LAS float* WCAR = (const LAS float*)(lds + LRU_WCAR);
#pragma unroll
                for (int cb = 0; cb < 2; ++cb) { const int ch = (2 * hf + cb) * 16 + fr;
                    const float cf = gHf[cb] + gPf[cb] * WCAR[(w * 2 + 0) * 64 + ch], cbk = gHb[cb] + gPb[cb] * WCAR[(w * 2 + 1) * 64 + ch];
#pragma unroll
                    for (int r = 0; r < 4; ++r) { const int t = 16 * w + 4 * fq + r; const float hs = (Hf[cb][r] + Pf[cb][r] * cf) + (Hb[cb][r] + Pb[cb][r] * cbk);
                        LAS bf16_t* gp = (LAS bf16_t*)(lds + LRU_GT + t * 128 + ch * 2); const float g = bf2f((unsigned)*gp);
                        const float u = 0.7978845608028654f * (g + 0.044715f * g * g * g); const float th = 1.0f - 2.0f * __builtin_amdgcn_rcpf(1.0f + __builtin_amdgcn_exp2f(2.885390081777927f * u));
                        *gp = (bf16_t)f2bf(0.5f * g * (1.0f + th) * hs); } }
            }
        }
        if (PASS == 2) {
            __syncthreads();
            bf16_t* A2 = (bf16_t*)(ws + WS_A2);
#pragma unroll
            for (int i = 0; i < 2; ++i) { const int q = tid + 512 * i, r = q >> 3, chk = q & 7; const u32x4 v = *(const LAS u32x4*)(lds + LRU_GT + r * 128 + chk * 16);
                *(u32x4*)(A2 + ((size_t)b * SEQ + t0 + r) * KOUT + h * 64 + chk * 8) = v; }
        }
        __syncthreads();
    }
#undef LRU_LOAD_CHUNK
}

constexpr int P5_PITCH = 2048 + 16;
__device__ __forceinline__ void p5_router(const Frame& F, KArgs& a) {
    unsigned char* ws = a.ws;
    LAS unsigned char* WH = F.lds; LAS unsigned char* WL = F.lds + 16 * P5_PITCH;
    { const float* wr = a.in[17];
      for (int o = F.tid; o < DM * NEXP; o += NTHREADS) { const int k = o >> 4, e = o & 15; const float w = wr[o]; const unsigned hi = f2bf(w); const float lo = w - bf2f(hi);
          *(LAS bf16_t*)(WH + e * P5_PITCH + k * 2) = (bf16_t)hi; *(LAS bf16_t*)(WL + e * P5_PITCH + k * 2) = (bf16_t)f2bf(lo); } }
    __syncthreads();
    const bf16_t* xm = (const bf16_t*)(ws + WS_DELTA); const float* g2 = a.in[16];
    unsigned char* h2 = (unsigned char*)(ws + WS_H2); float* scores = (float*)(ws + WS_SCORES); float* rstd2 = (float*)(ws + WS_RSTD1);
    const int gw = F.vcu * NWAVES + F.wave, NGW = F.G * NWAVES, fr = F.lane & 15, fq = F.lane >> 4;
    for (int grp = gw; grp < MTOK / 16; grp += NGW) {
        const int m0 = grp * 16;
        const bf16_t* xrow = xm + (size_t)(m0 + fr) * DM + 16 * fq; unsigned char* hrow = h2 + (size_t)(m0 + fr) * DM + 16 * fq;
        f32x4 acc = (f32x4){0.f, 0.f, 0.f, 0.f}; float ssq = 0.f;
#pragma unroll 2
        for (int kp = 0; kp < 16; ++kp) {
            const u32x4 x0 = *(const u32x4*)(xrow + 64 * kp), x1 = *(const u32x4*)(xrow + 64 * kp + 8); unsigned qq[4];
#pragma unroll
            for (int hh = 0; hh < 2; ++hh) { const u32x4 xv = hh ? x1 : x0; const int k0 = 64 * kp + 16 * fq + 8 * hh;
                f32x4 xa, xb; xa.x = bf2f(xv.x & 0xffffu); xa.y = bf2f(xv.x >> 16); xa.z = bf2f(xv.y & 0xffffu); xa.w = bf2f(xv.y >> 16); xb.x = bf2f(xv.z & 0xffffu); xb.y = bf2f(xv.z >> 16); xb.z = bf2f(xv.w & 0xffffu); xb.w = bf2f(xv.w >> 16);
                const f32x4 ga = *(const f32x4*)(g2 + k0), gb = *(const f32x4*)(g2 + k0 + 4);
                ssq += (xa.x * xa.x + xa.y * xa.y) + (xa.z * xa.z + xa.w * xa.w) + (xb.x * xb.x + xb.y * xb.y) + (xb.z * xb.z + xb.w * xb.w);
                const f32x4 va = xa * ga, vb = xb * gb;
                u32x4 hi, lo;
                hi.x = pk2(va.x, va.y); hi.y = pk2(va.z, va.w); hi.z = pk2(vb.x, vb.y); hi.w = pk2(vb.z, vb.w);
                lo.x = pk2(va.x - bf2f(hi.x & 0xffffu), va.y - bf2f(hi.x >> 16)); lo.y = pk2(va.z - bf2f(hi.y & 0xffffu), va.w - bf2f(hi.y >> 16));
                lo.z = pk2(vb.x - bf2f(hi.z & 0xffffu), vb.y - bf2f(hi.z >> 16)); lo.w = pk2(vb.z - bf2f(hi.w & 0xffffu), vb.w - bf2f(hi.w >> 16));
                const bf16x8 bh = *(const LAS bf16x8*)(WH + fr * P5_PITCH + k0 * 2), bl = *(const LAS bf16x8*)(WL + fr * P5_PITCH + k0 * 2);
                acc = __builtin_amdgcn_mfma_f32_16x16x32_bf16((bf16x8)hi, bh, acc, 0, 0, 0);
                acc = __builtin_amdgcn_mfma_f32_16x16x32_bf16((bf16x8)lo, bh, acc, 0, 0, 0);
                acc = __builtin_amdgcn_mfma_f32_16x16x32_bf16((bf16x8)hi, bl, acc, 0, 0, 0);
                qq[2 * hh] = pk4_fp8(va.x, va.y, va.z, va.w); qq[2 * hh + 1] = pk4_fp8(vb.x, vb.y, vb.z, vb.w); }
            *(u32x4*)(hrow + 64 * kp) = (u32x4){qq[0], qq[1], qq[2], qq[3]};
        }
        ssq += __shfl_xor(ssq, 16); ssq += __shfl_xor(ssq, 32);
        const float rs = 1.0f / sqrtf(ssq * (1.0f / DM) + EPS);
        if (fq == 0) rstd2[m0 + fr] = rs;
        f32x4 sc;
#pragma unroll
        for (int r = 0; r < 4; ++r) { const float l = acc[r] * __shfl(rs, 4 * fq + r);
            float mx = l;
#pragma unroll
            for (int o = 1; o < 16; o <<= 1) mx = fmaxf(mx, __shfl_xor(mx, o));
            const float ex = expf(l - mx); float sm = ex;
#pragma unroll
            for (int o = 1; o < 16; o <<= 1) sm += __shfl_xor(sm, o);
            sc[r] = ex / sm; }
        const int bb = m0 >> 13, s0 = m0 & (SEQ - 1);
        *(f32x4*)(scores + ((size_t)bb * NEXP + fr) * SEQ + s0 + 4 * fq) = sc;
    }
}

__device__ __forceinline__ void p6_topk_item(const Frame& F, KArgs& a, int item) {
    unsigned char* ws = a.ws; const int b = item >> 4, e = item & 15, tid = F.tid;
    const float* sc = (const float*)(ws + WS_SCORES) + (size_t)item * SEQ;
    int* tok = (int*)(ws + WS_TOK) + e * EROWS + b * CAP; float* gate = (float*)(ws + WS_GATE) + e * EROWS + b * CAP; int* inv = (int*)(ws + WS_INV) + (size_t)item * SEQ;
    float* rsl = (float*)(ws + WS_RS) + e * EROWS + b * CAP; const float* rstd2 = (const float*)(ws + WS_RSTD1) + b * SEQ;
    LAS unsigned* hist = (LAS unsigned*)F.lds;
    LAS unsigned* sfx = hist + 256;
    LAS unsigned* bc = hist + 512;
    LAS unsigned* scan = hist + 768;
    unsigned key[16];
    { const u32x4* p = (const u32x4*)(sc + tid * 16);
#pragma unroll
      for (int i = 0; i < 4; ++i) { const u32x4 v = p[i]; key[4 * i] = v.x; key[4 * i + 1] = v.y; key[4 * i + 2] = v.z; key[4 * i + 3] = v.w; } }
    unsigned prefix = 0, need = CAP;
    const int lane = F.lane, wv = F.wave;
    if (tid < 256) hist[tid] = 0u;
    __syncthreads();
#pragma unroll 1
    for (int pass = 0; pass < 4; ++pass) {
        const int shift = 24 - 8 * pass; const unsigned himask = pass == 0 ? 0u : (0xffffffffu << (shift + 8));
#pragma unroll
        for (int i = 0; i < 16; ++i) if ((key[i] & himask) == prefix) __hip_atomic_fetch_add(&hist[(key[i] >> shift) & 255u], 1u, __ATOMIC_RELAXED, __HIP_MEMORY_SCOPE_WORKGROUP);
        __syncthreads();
        unsigned hv = 0u, sv = 0u;
        if (tid < 256) { hv = hist[tid]; hist[tid] = 0u; sv = hv;
#pragma unroll
            for (int d = 1; d < 64; d <<= 1) { const unsigned o = __shfl_down(sv, d); if (lane + d < 64) sv += o; }
            if (lane == 0) sfx[wv] = sv; }
        __syncthreads();
        if (tid < 256) { unsigned ge = sv;
#pragma unroll
            for (int k = 1; k < 4; ++k) if (wv + k < 4) ge += sfx[wv + k];
            const unsigned gt = ge - hv;
            if (ge >= need && gt < need) { bc[0] = prefix | ((unsigned)tid << shift); bc[1] = need - gt; } }
        __syncthreads();
        prefix = bc[0]; need = bc[1];
    }
    const unsigned T = prefix;
    unsigned ngt = 0, neq = 0;
#pragma unroll
    for (int i = 0; i < 16; ++i) { ngt += key[i] > T ? 1u : 0u; neq += key[i] == T ? 1u : 0u; }
    unsigned incl = ngt | (neq << 16);
#pragma unroll
    for (int d = 1; d < 64; d <<= 1) { const unsigned o = __shfl_up(incl, d); if (lane >= d) incl += o; }
    if (lane == 63) scan[wv] = incl;
    __syncthreads();
    unsigned tot = 0u;
#pragma unroll
    for (int k = 0; k < 8; ++k) { const unsigned wt = scan[k]; if (k < wv) incl += wt; tot += wt; }
    const unsigned totgt = tot & 0xffffu;
    unsigned pgt = (incl & 0xffffu) - ngt, peq = (incl >> 16) - neq;
#pragma unroll
    for (int i = 0; i < 16; ++i) { const int s = tid * 16 + i; int slot = -1;
        if (key[i] > T) { slot = (int)pgt; ++pgt; }
        else if (key[i] == T) { if (peq < need) slot = (int)(totgt + peq); ++peq; }
        inv[s] = slot;
        if (slot >= 0) { tok[slot] = b * SEQ + s; gate[slot] = __builtin_bit_cast(float, key[i]); rsl[slot] = rstd2[s]; } }
    __syncthreads();
}

__device__ __forceinline__ void p9_final(const Frame& F, KArgs& a, float* dst) {
    unsigned char* ws = a.ws; const bf16_t* dl = (const bf16_t*)(ws + WS_DELTA); const float* gf = a.in[21]; const unsigned char* eo = (const unsigned char*)(ws + WS_EO); const int* inv = (const int*)(ws + WS_INV);
    const int gw = F.vcu * NWAVES + F.wave, NGW = F.G * NWAVES;
    f32x4 gv[4];
#pragma unroll
    for (int j = 0; j < 4; ++j) gv[j] = ((const f32x4*)gf)[F.lane + 64 * j];
    unsigned long long dn[4]; int slotn = -1;
    { const int m0 = gw < MTOK ? gw : 0; const unsigned long long* dr = (const unsigned long long*)(dl + (size_t)m0 * DM) + F.lane;
#pragma unroll
      for (int j = 0; j < 4; ++j) dn[j] = __builtin_nontemporal_load(dr + 64 * j);
      if (F.lane < 16) slotn = inv[((size_t)(m0 >> 13) * NEXP + F.lane) * SEQ + (m0 & (SEQ - 1))]; }
    for (int m = gw; m < MTOK; m += NGW) {
        f32x4 v[4]; const int myslot = slotn;
#pragma unroll
        for (int j = 0; j < 4; ++j) { const unsigned lo = (unsigned)dn[j], hi = (unsigned)(dn[j] >> 32); v[j].x = bf2f(lo & 0xffffu); v[j].y = bf2f(lo >> 16); v[j].z = bf2f(hi & 0xffffu); v[j].w = bf2f(hi >> 16); }
        const int bb = m >> 13;
        { const int mn = (m + NGW < MTOK) ? m + NGW : m; const unsigned long long* dr = (const unsigned long long*)(dl + (size_t)mn * DM) + F.lane;
#pragma unroll
          for (int j = 0; j < 4; ++j) dn[j] = __builtin_nontemporal_load(dr + 64 * j);
          slotn = -1; if (F.lane < 16) slotn = inv[((size_t)(mn >> 13) * NEXP + F.lane) * SEQ + (mn & (SEQ - 1))]; }
#if !DBG_NO_MOE
        unsigned mask = (unsigned)__ballot(myslot >= 0) & 0xffffu;
        while (mask) {
            unsigned q[4][4]; int ne = 0;
#pragma unroll
            for (int t = 0; t < 4; ++t) { if (mask) { const int e = __builtin_ctz(mask); mask &= mask - 1u; const int slot = __builtin_amdgcn_readlane(myslot, e);
                    const unsigned* er = (const unsigned*)(eo + ((size_t)e * EROWS + bb * CAP + slot) * DM) + F.lane;
#pragma unroll
                    for (int j = 0; j < 4; ++j) q[t][j] = __builtin_nontemporal_load(er + 64 * j);
                    ne = t + 1; } }
#pragma unroll
            for (int t = 0; t < 4; ++t) { if (t < ne) {
#pragma unroll
                    for (int j = 0; j < 4; ++j) { const f32x2 lo = __builtin_amdgcn_cvt_pk_f32_fp8((int)q[t][j], false), hi = __builtin_amdgcn_cvt_pk_f32_fp8((int)q[t][j], true);
                        v[j].x += lo.x * 0.0625f; v[j].y += lo.y * 0.0625f; v[j].z += hi.x * 0.0625f; v[j].w += hi.y * 0.0625f; } } }
        }
#endif
        float s = 0.f;
#pragma unroll
        for (int j = 0; j < 4; ++j) s += (v[j].x * v[j].x + v[j].y * v[j].y) + (v[j].z * v[j].z + v[j].w * v[j].w);
        const float rstd = 1.0f / sqrtf(wave_sum(s) * (1.0f / DM) + EPS);
        f32x4* xw = (f32x4*)(dst + (size_t)m * DM) + F.lane;
#pragma unroll
        for (int j = 0; j < 4; ++j) xw[64 * j] = v[j] * rstd * gv[j];
    }
}

__global__ void __launch_bounds__(NTHREADS, 2) fwd(Args args) {
    extern __shared__ __attribute__((aligned(16))) unsigned char lds_raw[];
    Frame F;
    F.lds = (LAS unsigned char*)lds_raw;
    F.tid = threadIdx.x; F.lane = F.tid & 63; F.wave = __builtin_amdgcn_readfirstlane(F.tid >> 6);
    F.G = gridDim.x; F.bx = blockIdx.x; F.vcu = (F.G % 8 == 0) ? (F.bx % 8) * (F.G / 8) + F.bx / 8 : F.bx;
    volatile LAS unsigned* MISC = (volatile LAS unsigned*)(F.lds + MISC_OFF);
    if (F.tid < 16) MISC[F.tid] = 0u;
    __syncthreads();
    KArgs* kap = (KArgs*)__builtin_amdgcn_kernarg_segment_ptr();
    unsigned char* ws = args.ws;
    unsigned* ctl = (unsigned*)(ws + WS_CTL);
    const int lo = args.ph_lo, hi = args.ph_hi;
    const __amdgpu_buffer_rsrc_t rsrc = __builtin_amdgcn_make_buffer_rsrc((void*)ws, (short)0, (int)0x7fffffff, (int)0x00020000);
#if !N_LAUNCH_PER_PHASE
    XcdBarrier bar = xcd_barrier_post(ctl + 1024, MISC + 8);
#if USE_COOP == 1
    cg::this_grid().sync();
#endif
#define GRID_BAR() xcd_barrier(bar)
#else
#define GRID_BAR() do {} while (0)
#endif
#ifdef ONLY_PHASE
#define IN(k) ((k) == ONLY_PHASE && lo <= (k) && (k) < hi)
#else
#define IN(k) (lo <= (k) && (k) < hi)
#endif
#define REFRESH() int t_ = threadIdx.x; asm volatile("" : "+v"(t_)); F.tid = t_; F.lane = t_ & 63; F.wave = __builtin_amdgcn_readfirstlane(t_ >> 6); KArgs* ap_ = kap; asm volatile("" : "+s"(ap_)); KArgs& A = *ap_
#define REPS(k) for (int rep = (args.rep_phase == (k)) ? args.rep_n : 0; rep >= 0; --rep)
    if (IN(0)) REPS(0) { REFRESH(); p0_prep(F, A); GRID_BAR(); }
    if (IN(1)) REPS(1) { REFRESH();
        pg8::DenseOrder S; S.init(WS_XB, WS_WIN, MTOK, NPROJ, DM, F.G, F.bx);
        pg8::EpiP E{(bf16_t*)A.out, (unsigned)WS_RSTD1};
        pg8::gemm_phase<pg8::EpiP, pg8::DenseOrder, false, false>(F.lds, rsrc, F.tid, DM * 2, S, E);
        GRID_BAR();
    }
    if (IN(2)) REPS(2) { REFRESH();
        for (int r2 = (A.rep_phase == 20) ? A.rep_n : 0; r2 >= 0; --r2)
        for (int si = F.bx; si < 256; si += F.G) lru_super_item<1>(F, A, si);
        for (int r2 = (A.rep_phase == 21) ? A.rep_n : 0; r2 >= 0; --r2)
        for (int it = F.bx; it < 512; it += F.G) fft1_item(F, (const bf16_t*)A.out, (u32x2*)(ws + WS_V), it);
        GRID_BAR();
    }
    if (IN(3)) REPS(3) { REFRESH();
        for (int r2 = (A.rep_phase == 30) ? A.rep_n : 0; r2 >= 0; --r2)
        for (int si = F.bx; si < 256; si += F.G) lru_super_item<2>(F, A, si);
        for (int r2 = (A.rep_phase == 31) ? A.rep_n : 0; r2 >= 0; --r2)
        for (int it = F.bx; it < NB * 16 * 8; it += F.G) { const int cc = it & 7, kk = (it >> 3) & 15, b = it >> 7;
            if (kk == 0) { fft2_item(F, (const u32x2*)(ws + WS_V), (bf16_t*)(ws + WS_A2), b, 0, cc); fft2_item(F, (const u32x2*)(ws + WS_V), (bf16_t*)(ws + WS_A2), b, 16, cc); }
            else fft2_item(F, (const u32x2*)(ws + WS_V), (bf16_t*)(ws + WS_A2), b, kk, cc); }
        GRID_BAR();
    }
    if (IN(4)) REPS(4) { REFRESH();
        pg8::DenseOrder S; S.init(WS_A2, WS_W2, MTOK, DM, KOUT, F.G, F.bx);
        pg8::EpiD E{(bf16_t*)(ws + WS_DELTA), (const bf16_t*)(ws + WS_XB)};
        pg8::gemm_phase<pg8::EpiD, pg8::DenseOrder, false, false>(F.lds, rsrc, F.tid, KOUT * 2, S, E);
        GRID_BAR();
    }
    if (IN(5)) REPS(5) { REFRESH(); p5_router(F, A); GRID_BAR(); }
    if (IN(6)) REPS(6) { REFRESH();
        if (F.G > NB * NEXP) { if (F.bx < NB * NEXP) p6_topk_item(F, A, F.bx); else expert_w_items(F, A, 2, (F.bx - NB * NEXP) * NWAVES + F.wave, (F.G - NB * NEXP) * NWAVES, WD_SPLIT, 8192); }
        else { for (int it = F.bx; it < NB * NEXP; it += F.G) p6_topk_item(F, A, it); expert_w_items(F, A, 2, F.bx * NWAVES + F.wave, F.G * NWAVES, WD_SPLIT, 8192); }
        GRID_BAR(); }
#if !DBG_NO_MOE
    if (IN(7)) REPS(7) { REFRESH();
        pg8::G1Order S{(unsigned)WS_H2, (unsigned)WS_WGU, (const int*)(ws + WS_TOK), F.G, F.bx};
        pg8::EpiH E{(unsigned char*)(ws + WS_H), (unsigned)WS_RS};
        pg8::gemm_phase<pg8::EpiH, pg8::G1Order, true, true>(F.lds, rsrc, F.tid, DM, S, E);
        GRID_BAR();
    }
    if (IN(8)) REPS(8) { REFRESH();
        pg8::G2Order S{(unsigned)WS_H, (unsigned)WS_WD, F.G, F.bx};
        pg8::EpiEo E{(unsigned char*)(ws + WS_EO), (unsigned)WS_GATE};
        pg8::gemm_phase<pg8::EpiEo, pg8::G2Order, false, true>(F.lds, rsrc, F.tid, DFF, S, E);
        GRID_BAR();
    }
#endif
    if (IN(9)) REPS(9) { REFRESH(); p9_final(F, A, rep > 0 ? (float*)(ws + WS_H) : A.out); if (rep > 0) GRID_BAR(); }
#undef IN
}

extern "C" void kernel_launch(void* const* d_in, const int* in_sizes, int n_in, void* d_out, int out_size, void* d_ws, size_t ws_size, hipStream_t stream) {
    static int grid = 0;
    if (grid == 0) {
        if (n_in != 22 || out_size != MTOK * DM || ws_size < WS_END) { fprintf(stderr, "kernel_launch: unexpected problem (n_in %d out %d ws %zu)\n", n_in, out_size, ws_size); grid = -1; return; }
        int dev = 0, cus = 0, per_cu = 0;
        (void)hipGetDevice(&dev);
        (void)hipDeviceGetAttribute(&cus, hipDeviceAttributeMultiprocessorCount, dev);
        (void)hipFuncSetAttribute((const void*)fwd, hipFuncAttributeMaxDynamicSharedMemorySize, LDS_BYTES);
        (void)hipOccupancyMaxActiveBlocksPerMultiprocessor(&per_cu, (const void*)fwd, NTHREADS, LDS_BYTES);
        (void)hipGetLastError();
        if (per_cu < 1) { fprintf(stderr, "kernel_launch: occupancy query says %d workgroups per CU; nothing launched\n", per_cu); grid = -1; return; }
        grid = cus * 1;
    }
    if (grid < 0) return;
    (void)hipMemsetAsync((char*)d_ws + WS_CTL, 0, 65536, stream);
    Args a{};
    for (int i = 0; i < 22; ++i) a.in[i] = (const float*)d_in[i];
    a.out = (float*)d_out; a.ws = (unsigned char*)d_ws; a.rep_phase = REPEAT_PHASE; a.rep_n = REPEAT_N;
#if N_LAUNCH_PER_PHASE
    for (int p = 0; p < 10; ++p) { a.ph_lo = p; a.ph_hi = p + 1; hipLaunchKernelGGL(fwd, dim3(grid), dim3(NTHREADS), LDS_BYTES, stream, a); }
#else
    a.ph_lo = 0; a.ph_hi = 10;
    void* kargs[] = {&a};
#if USE_COOP
    hipError_t e = hipLaunchCooperativeKernel((const void*)fwd, dim3(grid), dim3(NTHREADS), kargs, LDS_BYTES, stream);
    if (e != hipSuccess) fprintf(stderr, "cooperative launch failed: %s (grid %d)\n", hipGetErrorString(e), grid);
#else
    (void)kargs; hipLaunchKernelGGL(fwd, dim3(grid), dim3(NTHREADS), LDS_BYTES, stream, a);
#endif
#endif
}
```

```cpp
#include <hip/hip_runtime.h>
#include <hip/hip_cooperative_groups.h>
#include <cstdio>
#include <cstdint>
namespace cg = cooperative_groups;

#ifndef USE_COOP
#define USE_COOP 2
#endif
#ifndef N_LAUNCH_PER_PHASE
#define N_LAUNCH_PER_PHASE 0
#endif
#ifndef DBG_NO_MOE
#define DBG_NO_MOE 0
#endif

#ifndef REPEAT_PHASE
#define REPEAT_PHASE -1
#endif
#ifndef REPEAT_N
#define REPEAT_N 0
#endif
#define LAS __attribute__((address_space(3)))
typedef unsigned short bf16_t;
typedef short bf16x8 __attribute__((ext_vector_type(8)));
typedef float f32x4 __attribute__((ext_vector_type(4)));
typedef float f32x2 __attribute__((ext_vector_type(2)));
typedef unsigned u32x4 __attribute__((ext_vector_type(4)));
typedef unsigned u32x2 __attribute__((ext_vector_type(2)));
typedef int i32x4 __attribute__((ext_vector_type(4)));
typedef int i32x8 __attribute__((ext_vector_type(8)));

constexpr int NB = 4, SEQ = 8192, DM = 1024, MTOK = NB * SEQ;
constexpr int DLRU = 512, NHEAD = 8, HDIM = 64, NPROJ = 1536, KOUT = 1536;
constexpr int NEXP = 16, CAP = 1024, DFF = 2048, EROWS = NB * CAP;
constexpr float EPS = 1e-6f;
constexpr int NTHREADS = 512, NWAVES = 8;
constexpr int LDS_BYTES = 147456;
constexpr int MISC_OFF = 131072 + 8192;

constexpr size_t KiB = 1024, MiB = 1u << 20;
constexpr size_t WS_CTL = 0;
constexpr size_t WS_RSTD1 = 64 * KiB;
constexpr size_t WS_WGT = 256 * KiB;
constexpr size_t WS_IDX = 512 * KiB;
constexpr size_t WS_GATE = 768 * KiB;
constexpr size_t WS_AGG = 1 * MiB;
constexpr size_t WS_SCORES = 3 * MiB;
constexpr size_t WS_INV = 5 * MiB;
constexpr size_t WS_RS = 7 * MiB;
constexpr size_t WS_TOK = 7 * MiB + 256 * KiB;
constexpr size_t WS_WGU = 8 * MiB;
constexpr size_t WS_EO = 8 * MiB;
constexpr size_t WS_WD = 136 * MiB;
constexpr size_t WS_H = 200 * MiB;
constexpr size_t WS_XB = 436 * MiB;
constexpr size_t WS_V = 200 * MiB;
constexpr size_t WS_A2 = 270 * MiB;
constexpr size_t WS_WIN = 366 * MiB;
constexpr size_t WS_W2 = 369 * MiB;
constexpr size_t WS_DELTA = 372 * MiB;
constexpr size_t WS_H2 = 168 * MiB;
constexpr size_t WS_END = 520 * MiB;

typedef __bf16 bf16x2_t __attribute__((ext_vector_type(2)));
__device__ __forceinline__ unsigned f2bf(float f) { return (unsigned)__builtin_bit_cast(unsigned short, (__bf16)f); }
__device__ __forceinline__ unsigned pk2(float lo, float hi) { bf16x2_t v; v.x = (__bf16)lo; v.y = (__bf16)hi; return __builtin_bit_cast(unsigned, v); }
__device__ __forceinline__ unsigned cvt_pk_bf16(float lo, float hi) { unsigned r; asm volatile("v_cvt_pk_bf16_f32 %0, %1, %2" : "=v"(r) : "v"(lo), "v"(hi)); return r; }
__device__ __forceinline__ float bf2f(unsigned h) { return __builtin_bit_cast(float, h << 16); }
__device__ __forceinline__ float wave_sum(float v) {
#pragma unroll
    for (int o = 1; o < 64; o <<= 1) v += __shfl_xor(v, o);
    return v;
}
__device__ __forceinline__ float fast_sigmoid(float x) { return __builtin_amdgcn_rcpf(1.0f + __builtin_amdgcn_exp2f(-1.4426950408889634f * x)); }
__device__ __forceinline__ unsigned pk4_fp8(float a, float b, float c, float d) { int w = 0; w = __builtin_amdgcn_cvt_pk_fp8_f32(a, b, w, false); w = __builtin_amdgcn_cvt_pk_fp8_f32(c, d, w, true); return (unsigned)w; }
__device__ __forceinline__ float xchg16(float v, int lane) { const unsigned u = __builtin_bit_cast(unsigned, v); const auto r = __builtin_amdgcn_permlane16_swap(u, u, false, false); return __builtin_bit_cast(float, (lane & 16) ? r[0] : r[1]); }
__device__ __forceinline__ float xchg32(float v, int lane) { const unsigned u = __builtin_bit_cast(unsigned, v); const auto r = __builtin_amdgcn_permlane32_swap(u, u, false, false); return __builtin_bit_cast(float, (lane & 32) ? r[0] : r[1]); }
#define LDS_WAIT() asm volatile("s_waitcnt lgkmcnt(0)" ::: "memory")

#define XB_TMO      128
#define XB_XCNT(j)  (256  + 64 * (j))
#define XB_XSUB(j)  (1280 + 64 * (j))
#define XB_XGEN(j)  (2304 + 64 * (j))
#define XB_TOP      3328
#define XB_TOPGEN   3392
#define XCD_BAR_WORDS 3456
#define XB_SPIN_CAP (1u << 20)
__device__ __forceinline__ unsigned xb_ld(unsigned* p)              { return __hip_atomic_load(p, __ATOMIC_RELAXED, __HIP_MEMORY_SCOPE_AGENT); }
__device__ __forceinline__ unsigned xb_add(unsigned* p, unsigned v) { return __hip_atomic_fetch_add(p, v, __ATOMIC_RELAXED, __HIP_MEMORY_SCOPE_AGENT); }
__device__ __forceinline__ unsigned xb_xcc_id() { return (unsigned)__builtin_amdgcn_s_getreg((3 << 11) | 20) & 0xFu; }
#define XB_SPIN(cond, bar) do { unsigned _sp = 0; while (cond) { __builtin_amdgcn_s_sleep(1); \
    if ((++_sp & 255u) == 0u) { if (xb_ld(&(bar)[XB_TMO])) break; if (_sp > XB_SPIN_CAP) { atomicAdd(&(bar)[XB_TMO], 1u); break; } } } } while (0)
struct XcdBarrier { unsigned* bar; unsigned x; volatile LAS unsigned* st; };
__device__ __forceinline__ XcdBarrier xcd_barrier_post(unsigned* bar, volatile LAS unsigned* st) {
    XcdBarrier b; b.bar = bar; b.x = xb_xcc_id(); b.st = st;
    if (threadIdx.x == 0) (void)xb_add(&bar[XB_XCNT(b.x)], 1u);
    return b;
}
__device__ __forceinline__ void xcd_barrier_complete(unsigned* bar, unsigned x, unsigned& nloc, unsigned& nx) {
    const unsigned G = gridDim.x * gridDim.y * gridDim.z;
    unsigned sum, cnt, mine, sp = 0u;
    for (;;) {
        sum = 0u; cnt = 0u; mine = 0u;
#pragma unroll
        for (unsigned j = 0; j < 16; ++j) { const unsigned c = xb_ld(&bar[XB_XCNT(j)]); sum += c; cnt += (c > 0u) ? 1u : 0u; mine = (j == x) ? c : mine; }
        if (sum == G) break;
        __builtin_amdgcn_s_sleep(1);
        if ((++sp & 255u) == 0u) { if (xb_ld(&bar[XB_TMO])) break; if (sp > XB_SPIN_CAP) { atomicAdd(&bar[XB_TMO], 1u); break; } }
    }
    nloc = mine > 0u ? mine : 1u; nx = cnt > 0u ? cnt : 1u;
}
__device__ __forceinline__ void xcd_barrier(const XcdBarrier& b) {
    asm volatile("s_waitcnt vmcnt(0)" ::: "memory");
    __syncthreads();
    if (threadIdx.x == 0) {
        unsigned* bar = b.bar;
        __builtin_amdgcn_s_waitcnt(0);
        unsigned nloc = b.st[0], nx = b.st[1];
        if (nloc == 0u) { xcd_barrier_complete(bar, b.x, nloc, nx); b.st[0] = nloc; b.st[1] = nx; }
        const unsigned old = xb_add(&bar[XB_XSUB(b.x)], 1u);
        const unsigned gen = old / nloc;
        if (old + 1u == (gen + 1u) * nloc) {
            __builtin_amdgcn_fence(__ATOMIC_RELEASE, "agent");
            asm volatile("s_waitcnt vmcnt(0)" ::: "memory");
            const unsigned og = xb_add(&bar[XB_TOP], 1u);
            const unsigned tg = og / nx;
            if (og + 1u == (tg + 1u) * nx) xb_add(&bar[XB_TOPGEN], 1u);
            else XB_SPIN(xb_ld(&bar[XB_TOPGEN]) == tg, bar);
            __builtin_amdgcn_fence(__ATOMIC_ACQUIRE, "agent");
            xb_add(&bar[XB_XGEN(b.x)], 1u);
            asm volatile("s_waitcnt vmcnt(0)" ::: "memory");
        } else {
            XB_SPIN(xb_ld(&bar[XB_XGEN(b.x)]) == gen, bar);
            __builtin_amdgcn_fence(__ATOMIC_ACQUIRE, "agent");
            asm volatile("s_waitcnt vmcnt(0)" ::: "memory");
        }
    }
    __syncthreads();
}

namespace pg8 {
constexpr int BM = 256, BK = 64, HALF = 128, HTB = HALF * BK * 2, STAGE_BYTES = 8 * HTB, NXCD = 8, WGM = 8;
__host__ __device__ __forceinline__ int lds_byte(int r, int c) { return r * 128 + ((((c >> 3) ^ (r >> 1)) & 7) << 4) + (c & 7) * 2; }
__host__ __device__ __forceinline__ void stage_rc(int b, int& R, int& C) { R = b >> 7; C = ((((b >> 4) ^ (R >> 1)) & 7) << 3); }
__host__ __device__ __forceinline__ int perm32(int rho) { const int n = rho >> 4, i = rho & 15; return 8 * (i >> 2) + 4 * n + (i & 3); }

struct Unit { unsigned a, b; int row0, col0; };

struct DenseOrder {
    unsigned A, Bt; int K, nM, nN, nwg, G, c;
    __device__ void init(size_t A_, size_t Bt_, int M, int N, int K_, int G_, int c_) { A = (unsigned)A_; Bt = (unsigned)Bt_; K = K_; nM = M / BM; nN = N / BM; nwg = nM * nN; G = G_; c = c_; }
    __device__ bool next(int i, Unit& u) const {
        const long L = (long)i * G + c; if (L >= nwg) return false;
        int wgid = (int)L; { const int q = nwg / NXCD, r = nwg % NXCD, xcd = wgid % NXCD, off = wgid / NXCD; wgid = (xcd < r ? xcd * (q + 1) : r * (q + 1) + (xcd - r) * q) + off; }
        const int nig = WGM * nN, gid = wgid / nig, fm = gid * WGM, gsz = (nM - fm) < WGM ? (nM - fm) : WGM;
        const int pm = fm + ((wgid % nig) % gsz), pn = (wgid % nig) / gsz;
        u.a = A + (unsigned)(pm * BM * K * 2); u.b = Bt + (unsigned)(pn * BM * K * 2); u.row0 = pm * BM; u.col0 = pn * BM; return true;
    }
    __device__ __forceinline__ int arow(const Unit&, int) const { return 0; }
    __device__ __forceinline__ unsigned tokoff() const { return 0u; }
};
struct G1Order {
    unsigned h2, wgu; const int* tok; int G, c;
    __device__ bool next(int i, Unit& u) const {
        const long L = (long)i * G + c; if (L >= 4096) return false;
        const int e = (int)(L >> 8), w = (int)(L & 255), xcd = w & 7, l = w >> 3;
        const int pm = 4 * (xcd & 3) + (l & 3), pn = 8 * (xcd >> 2) + (l >> 2);
        u.a = h2; u.b = wgu + (unsigned)((e * 4096 + pn * 256) * DM); u.row0 = e * EROWS + pm * 256; u.col0 = pn * 128; return true;
    }
    __device__ __forceinline__ int arow(const Unit& u, int r) const { return tok[u.row0 + r]; }
    __device__ __forceinline__ unsigned tokoff() const { return (unsigned)WS_TOK; }
};
struct G2Order {
    unsigned H, wd; int G, c;
    __device__ bool next(int i, Unit& u) const {
        const long L = (long)i * G + c; if (L >= 1024) return false;
        const int r4 = (int)(L >> 8), w = (int)(L & 255), xcd = w & 7, l = w >> 3;
        const int e = 4 * r4 + (xcd >> 1), pm = 8 * (xcd & 1) + (l & 7), pn = l >> 3;
        u.a = H + (unsigned)((e * EROWS + pm * 256) * DFF); u.b = wd + (unsigned)((e * DM + pn * 256) * DFF); u.row0 = e * EROWS + pm * 256; u.col0 = pn * 256; return true;
    }
    __device__ __forceinline__ int arow(const Unit&, int) const { return 0; }
    __device__ __forceinline__ unsigned tokoff() const { return 0u; }
};

struct EpiP {
    static constexpr bool PERM = true, HAS_SCALE = true;
    bf16_t* P; unsigned soff;
    __device__ __forceinline__ unsigned scale_off() const { return soff; }
    __device__ __forceinline__ void operator()(const f32x4 (&acc)[2][2][4][2], const Unit& u, int wr, int wc, int fr, int fq, const LAS float* scl) const {
        const int row0 = u.row0 + wr * 64 + fr, col0 = u.col0 + wc * 32 + 8 * fq;
#pragma unroll
        for (int ai = 0; ai < 2; ++ai)
#pragma unroll
            for (int m = 0; m < 4; ++m) { const int r = row0 + ai * HALF + m * 16; const float rs = scl[wr * 64 + fr + ai * HALF + m * 16]; bf16_t* rowp = P + (size_t)r * NPROJ + col0;
#pragma unroll
                for (int bj = 0; bj < 2; ++bj) { const f32x4 v0 = acc[ai][bj][m][0] * rs, v1 = acc[ai][bj][m][1] * rs;
                    u32x4 w; w.x = cvt_pk_bf16(v0[0], v0[1]); w.y = cvt_pk_bf16(v0[2], v0[3]); w.z = cvt_pk_bf16(v1[0], v1[1]); w.w = cvt_pk_bf16(v1[2], v1[3]);
                    *(u32x4*)(rowp + bj * HALF) = w; } }
    }
};
struct EpiD {
    static constexpr bool PERM = true, HAS_SCALE = false;
    bf16_t* O; const bf16_t* XB;
    __device__ __forceinline__ unsigned scale_off() const { return 0u; }
    __device__ __forceinline__ void operator()(const f32x4 (&acc)[2][2][4][2], const Unit& u, int wr, int wc, int fr, int fq, const LAS float*) const {
        const int row0 = u.row0 + wr * 64 + fr, col0 = u.col0 + wc * 32 + 8 * fq;
#pragma unroll
        for (int ai = 0; ai < 2; ++ai) { u32x4 xv[4][2];
#pragma unroll
            for (int m = 0; m < 4; ++m)
#pragma unroll
                for (int bj = 0; bj < 2; ++bj) xv[m][bj] = *(const u32x4*)(XB + (size_t)(row0 + ai * HALF + m * 16) * DM + col0 + bj * HALF);
#pragma unroll
            for (int m = 0; m < 4; ++m) { bf16_t* rowp = O + (size_t)(row0 + ai * HALF + m * 16) * DM + col0;
#pragma unroll
                for (int bj = 0; bj < 2; ++bj) { const f32x4 v0 = acc[ai][bj][m][0], v1 = acc[ai][bj][m][1]; const u32x4 x = xv[m][bj];
                    u32x4 w; w.x = cvt_pk_bf16(v0[0] + bf2f(x.x & 0xffffu), v0[1] + bf2f(x.x >> 16)); w.y = cvt_pk_bf16(v0[2] + bf2f(x.y & 0xffffu), v0[3] + bf2f(x.y >> 16));
                    w.z = cvt_pk_bf16(v1[0] + bf2f(x.z & 0xffffu), v1[1] + bf2f(x.z >> 16)); w.w = cvt_pk_bf16(v1[2] + bf2f(x.w & 0xffffu), v1[3] + bf2f(x.w >> 16));
                    *(u32x4*)(rowp + bj * HALF) = w; } } }
    }
};
struct EpiH {
    static constexpr bool PERM = true, HAS_SCALE = true;
    unsigned char* Hh; unsigned soff;
    __device__ __forceinline__ unsigned scale_off() const { return soff; }
    __device__ __forceinline__ void operator()(const f32x4 (&acc)[2][2][4][2], const Unit& u, int wr, int wc, int fr, int fq, const LAS float* scl) const {
        const int row0 = u.row0 + wr * 64 + fr, col0 = u.col0 + wc * 32 + 8 * fq;
#pragma unroll
        for (int ai = 0; ai < 2; ++ai)
#pragma unroll
            for (int m = 0; m < 4; ++m) { const int r = row0 + ai * HALF + m * 16; unsigned char* rowp = Hh + (size_t)r * DFF + col0; const float rsc = scl[wr * 64 + fr + ai * HALF + m * 16] * 0.03125f;
                float h[8]; const float ke = -1.4426950408889634f * rsc, k2 = rsc * rsc;
#pragma unroll
                for (int n = 0; n < 2; ++n)
#pragma unroll
                    for (int jp = 0; jp < 2; ++jp) { const f32x2 ag = (f32x2){acc[ai][0][m][n][2 * jp], acc[ai][0][m][n][2 * jp + 1]}, au = (f32x2){acc[ai][1][m][n][2 * jp], acc[ai][1][m][n][2 * jp + 1]};
                        const f32x2 ex = ag * ke; f32x2 d; d.x = __builtin_amdgcn_exp2f(ex.x); d.y = __builtin_amdgcn_exp2f(ex.y); d = d + 1.0f;
                        f32x2 rc; rc.x = __builtin_amdgcn_rcpf(d.x); rc.y = __builtin_amdgcn_rcpf(d.y);
                        const f32x2 hv = (ag * au) * k2 * rc; h[n * 4 + 2 * jp] = hv.x; h[n * 4 + 2 * jp + 1] = hv.y; }
                u32x2 w; w.x = pk4_fp8(h[0], h[1], h[2], h[3]); w.y = pk4_fp8(h[4], h[5], h[6], h[7]);
                *(u32x2*)rowp = w; }
    }
};
struct EpiEo {
    static constexpr bool PERM = true, HAS_SCALE = true;
    unsigned char* O; unsigned soff;
    __device__ __forceinline__ unsigned scale_off() const { return soff; }
    __device__ __forceinline__ void operator()(const f32x4 (&acc)[2][2][4][2], const Unit& u, int wr, int wc, int fr, int fq, const LAS float* scl) const {
        const int row0 = u.row0 + wr * 64 + fr, col0 = u.col0 + wc * 32 + 8 * fq;
#pragma unroll
        for (int ai = 0; ai < 2; ++ai)
#pragma unroll
            for (int m = 0; m < 4; ++m) { const int r = row0 + ai * HALF + m * 16; const float gs = scl[wr * 64 + fr + ai * HALF + m * 16] * 0.5f; unsigned char* rowp = O + (size_t)r * DM + col0;
#pragma unroll
                for (int bj = 0; bj < 2; ++bj) { const f32x4 v0 = acc[ai][bj][m][0] * gs, v1 = acc[ai][bj][m][1] * gs;
                    u32x2 w; w.x = pk4_fp8(v0[0], v0[1], v0[2], v0[3]); w.y = pk4_fp8(v1[0], v1[1], v1[2], v1[3]);
                    *(u32x2*)(rowp + bj * HALF) = w; } }
    }
};

template <class Epi, class Sched, bool GATHER, bool FP8>
__device__ __forceinline__ void gemm_phase(LAS unsigned char* lds, const __amdgpu_buffer_rsrc_t rs, const int tid, const int KB, const Sched& S, const Epi& E) {
    const int wid = __builtin_amdgcn_readfirstlane(tid >> 6), lane = tid & 63, wr = wid >> 2, wc = wid & 3, fr = lane & 15, fq = lane >> 4;
    const int nt = KB / 128;
    int RA[2], CA[2];
    unsigned voffA[2][2], voffB[2];
#pragma unroll
    for (int i = 0; i < 2; ++i) { int R, C; stage_rc(tid * 16 + i * 8192, R, C); const int Rb = Epi::PERM ? ((R & ~31) + perm32(R & 31)) : R;
        RA[i] = R; CA[i] = C; voffB[i] = (unsigned)(Rb * KB + C * 2); }
    const unsigned kstep = 128u;
    const unsigned hstep = (unsigned)(HALF * KB);
    const unsigned ldsw = (unsigned)wid * 1024u;
    const int aoff = lds_byte(wr * 64 + fr, fq * 8), boff = lds_byte(wc * 32 + fr, fq * 8);
    const int aoff1 = lds_byte(wr * 64 + fr, 32 + fq * 8), boff1 = lds_byte(wc * 32 + fr, 32 + fq * 8);
#define PG8_SA(b, h) (((b) * 2 + (h)) * HTB)
#define PG8_SB(b, h) ((4 + (b) * 2 + (h)) * HTB)
#define PG8_STAGE(bufoff, gbase, voff) do { _Pragma("unroll") for (int _i = 0; _i < 2; ++_i) \
        __builtin_amdgcn_raw_ptr_buffer_load_lds(rs, (LAS void*)(lds + (bufoff) + ldsw + _i * 8192), 16, (int)(voff)[_i], (int)(gbase), 0, 0); } while (0)
#define PG8_STAGE_A(bufoff, gbase, h) do { if constexpr (GATHER) { PG8_STAGE(bufoff, gbase, voffA[h]); } else { PG8_STAGE(bufoff, (gbase) + (h) * hstep, voffA[0]); } } while (0)
#define PG8_LDA(dst, b, h) do { _Pragma("unroll") for (int m = 0; m < 4; ++m) { const i32x4 _lo = *(const LAS i32x4*)(lds + PG8_SA(b, h) + aoff + m * 2048), _hi = *(const LAS i32x4*)(lds + PG8_SA(b, h) + aoff1 + m * 2048); \
        dst[m] = __builtin_shufflevector(_lo, _hi, 0, 1, 2, 3, 4, 5, 6, 7); } } while (0)
#define PG8_LDB(dst, b, h) do { _Pragma("unroll") for (int n = 0; n < 2; ++n) { const i32x4 _lo = *(const LAS i32x4*)(lds + PG8_SB(b, h) + boff + n * 2048), _hi = *(const LAS i32x4*)(lds + PG8_SB(b, h) + boff1 + n * 2048); \
        dst[n] = __builtin_shufflevector(_lo, _hi, 0, 1, 2, 3, 4, 5, 6, 7); } } while (0)
#define PG8_MMA(ai, bj, At, Bt) do { __builtin_amdgcn_s_setprio(1); _Pragma("unroll") for (int m = 0; m < 4; ++m) _Pragma("unroll") for (int n = 0; n < 2; ++n) { \
        if constexpr (FP8) asm volatile("v_mfma_scale_f32_16x16x128_f8f6f4 %0, %1, %2, %0, %3, %3 op_sel_hi:[0,0,0]" : "+v"(acc[ai][bj][m][n]) : "v"(Bt[n]), "v"(At[m]), "v"(sc1)); \
        else { acc[ai][bj][m][n] = __builtin_amdgcn_mfma_f32_16x16x32_bf16((bf16x8)__builtin_shufflevector(Bt[n], Bt[n], 0, 1, 2, 3), (bf16x8)__builtin_shufflevector(At[m], At[m], 0, 1, 2, 3), acc[ai][bj][m][n], 0, 0, 0); \
               acc[ai][bj][m][n] = __builtin_amdgcn_mfma_f32_16x16x32_bf16((bf16x8)__builtin_shufflevector(Bt[n], Bt[n], 4, 5, 6, 7), (bf16x8)__builtin_shufflevector(At[m], At[m], 4, 5, 6, 7), acc[ai][bj][m][n], 0, 0, 0); } } \
        __builtin_amdgcn_s_setprio(0); } while (0)
#define PG8_WAIT_V(n) asm volatile("s_waitcnt vmcnt(" #n ")" ::: "memory")
#define PG8_WAIT_L(n) asm volatile("s_waitcnt lgkmcnt(" #n ")" ::: "memory")
#define PG8_BAR __builtin_amdgcn_s_barrier()
#define PG8_SCHED __builtin_amdgcn_sched_barrier(0)
#define PG8_SETVOFF(dst, unit) do { _Pragma("unroll") for (int _h = 0; _h < 2; ++_h) _Pragma("unroll") for (int _i = 0; _i < 2; ++_i) { \
        if constexpr (GATHER) dst[_h][_i] = (unsigned)(S.arow(unit, _h * HALF + RA[_i]) * KB + CA[_i] * 2); \
        else dst[_h][_i] = (unsigned)(RA[_i] * KB + CA[_i] * 2); } } while (0)
    Unit cur, nxt; int ui = 0;
    if (!S.next(0, cur)) return;
    int sc1 = 0x7f7f7f7f; asm volatile("" : "+v"(sc1));
    f32x4 acc[2][2][4][2];
#pragma unroll
    for (int a = 0; a < 2; ++a)
#pragma unroll
        for (int b = 0; b < 2; ++b)
#pragma unroll
            for (int m = 0; m < 4; ++m)
#pragma unroll
                for (int n = 0; n < 2; ++n) acc[a][b][m][n] = (f32x4){0.f, 0.f, 0.f, 0.f};
    i32x8 At[4], B0[2], B1[2];
    unsigned cA = cur.a, cB = cur.b;
    PG8_SETVOFF(voffA, cur);
    PG8_STAGE(PG8_SB(0, 0), cB, voffB); PG8_STAGE(PG8_SB(0, 1), cB + hstep, voffB); PG8_STAGE_A(PG8_SA(0, 0), cA, 0); PG8_STAGE_A(PG8_SA(0, 1), cA, 1);
    if (wr == 1) PG8_BAR;
    PG8_WAIT_V(2); PG8_BAR;
    PG8_STAGE(PG8_SB(1, 0), cB + kstep, voffB); PG8_STAGE_A(PG8_SA(1, 0), cA + kstep, 0); PG8_STAGE(PG8_SB(1, 1), cB + hstep + kstep, voffB);
    PG8_WAIT_V(6); PG8_BAR;
    for (;;) {
        const bool has_next = S.next(ui + 1, nxt);
        const unsigned nA = has_next ? nxt.a : cA, nB = has_next ? nxt.b : cB;
#pragma clang loop unroll(disable)
        for (int t = 0; t < nt; t += 2) {
            const bool last = (t == nt - 2);
            const unsigned a1 = cA + (unsigned)(t + 1) * kstep;
            const unsigned a2 = last ? nA : cA + (unsigned)(t + 2) * kstep, b2 = last ? nB : cB + (unsigned)(t + 2) * kstep;
            const unsigned a3 = a2 + kstep, b3 = b2 + kstep;
            unsigned nvoff[2][2];
            if constexpr (Epi::HAS_SCALE) { if (t == 0)
                    __builtin_amdgcn_raw_ptr_buffer_load_lds(rs, (LAS void*)(lds + 133120 + (ui & 1) * 2048 + (wid >> 2) * 1024 + (wid & 3) * 256), 4, (int)(lane * 4), (int)(E.scale_off() + (unsigned)(cur.row0 + (wid & 3) * 64) * 4u), 0, 0); }
            if constexpr (GATHER) {
                if (t == 0 && has_next)
                    __builtin_amdgcn_raw_ptr_buffer_load_lds(rs, (LAS void*)(lds + 131072 + (wid >> 2) * 1024 + (wid & 3) * 256), 4, (int)(lane * 4), (int)(S.tokoff() + (unsigned)(nxt.row0 + (wid & 3) * 64) * 4u), 0, 0);
                if (last && has_next) {
#pragma unroll
                    for (int _h = 0; _h < 2; ++_h)
#pragma unroll
                        for (int _i = 0; _i < 2; ++_i) nvoff[_h][_i] = (unsigned)(*(const LAS int*)(lds + 131072 + (_h * HALF + RA[_i]) * 4) * KB + CA[_i] * 2); } }
            PG8_LDB(B0, 0, 0); PG8_LDB(B1, 0, 1); PG8_SCHED; PG8_LDA(At, 0, 0); PG8_STAGE_A(PG8_SA(1, 1), a1, 1);
            PG8_WAIT_V(8); PG8_WAIT_L(0); PG8_BAR; PG8_MMA(0, 0, At, B0); PG8_MMA(0, 1, At, B1); PG8_BAR; PG8_SCHED;
            if constexpr (GATHER) { if (last && has_next) {
#pragma unroll
                for (int _h = 0; _h < 2; ++_h)
#pragma unroll
                    for (int _i = 0; _i < 2; ++_i) voffA[_h][_i] = nvoff[_h][_i]; } }
            PG8_LDA(At, 0, 1); PG8_STAGE(PG8_SB(0, 0), b2, voffB); PG8_STAGE(PG8_SB(0, 1), b2 + hstep, voffB);
            PG8_WAIT_V(6); PG8_WAIT_L(0); PG8_BAR; PG8_MMA(1, 0, At, B0); PG8_SCHED; PG8_STAGE_A(PG8_SA(0, 0), a2, 0); PG8_SCHED; PG8_MMA(1, 1, At, B1); PG8_BAR; PG8_SCHED;
            PG8_LDB(B0, 1, 0); PG8_LDB(B1, 1, 1); PG8_SCHED; PG8_LDA(At, 1, 0); PG8_STAGE_A(PG8_SA(0, 1), a2, 1);
            PG8_WAIT_V(8); PG8_WAIT_L(0); PG8_BAR; PG8_MMA(0, 0, At, B0); PG8_MMA(0, 1, At, B1); PG8_BAR; PG8_SCHED;
            PG8_LDA(At, 1, 1); PG8_STAGE(PG8_SB(1, 0), b3, voffB); PG8_STAGE(PG8_SB(1, 1), b3 + hstep, voffB);
            PG8_WAIT_V(6); PG8_WAIT_L(0); PG8_BAR; PG8_MMA(1, 0, At, B0); PG8_SCHED; PG8_STAGE_A(PG8_SA(1, 0), a3, 0); PG8_SCHED; PG8_MMA(1, 1, At, B1); PG8_BAR; PG8_SCHED;
        }
        if (wr == 0) PG8_BAR;
        if constexpr (FP8) asm volatile("s_nop 15\n\ts_nop 15" ::: "memory");
        E(acc, cur, wr, wc, fr, fq, (const LAS float*)(lds + 133120 + (ui & 1) * 2048));
        if (!has_next) break;
#pragma unroll
        for (int a = 0; a < 2; ++a)
#pragma unroll
            for (int b = 0; b < 2; ++b)
#pragma unroll
                for (int m = 0; m < 4; ++m)
#pragma unroll
                    for (int n = 0; n < 2; ++n) acc[a][b][m][n] = (f32x4){0.f, 0.f, 0.f, 0.f};
        cur = nxt; cA = nA; cB = nB; ++ui;
        if (wr == 1) PG8_BAR;
    }
    PG8_WAIT_V(0);
    PG8_BAR;
#undef PG8_SA
#undef PG8_SB
#undef PG8_STAGE
#undef PG8_STAGE_A
#undef PG8_LDA
#undef PG8_LDB
#undef PG8_MMA
#undef PG8_WAIT_V
#undef PG8_WAIT_L
#undef PG8_BAR
#undef PG8_SCHED
#undef PG8_SETVOFF
}
}

struct Args { const float* in[22]; float* out; unsigned char* ws; int ph_lo, ph_hi, rep_phase, rep_n; };
typedef const __attribute__((address_space(4))) Args KArgs;
struct Frame {
    LAS unsigned char* lds;
    int tid, lane, wave, G, bx, vcu;
};

__device__ __forceinline__ void transpose_item(const float* W, int N, int k0, int n0, bf16_t* WT, int ldk, int drow0, const float* kscale, LAS float* scr, int lane) {
#pragma unroll 8
    for (int i = 0; i < 32; ++i) { const int kk = 2 * i + (lane >> 5); float v = __builtin_nontemporal_load(W + (size_t)(k0 + kk) * N + n0 + (lane & 31)); if (kscale) v *= kscale[k0 + kk]; scr[kk * 33 + (lane & 31)] = v; }
    LDS_WAIT(); asm volatile("" ::: "memory");
    const int c = lane & 7;
#pragma unroll
    for (int j = 0; j < 4; ++j) { const int n = (lane >> 3) + 8 * j; const LAS float* s = scr + (8 * c) * 33 + n;
        u32x4 o; o.x = pk2(s[0 * 33], s[1 * 33]); o.y = pk2(s[2 * 33], s[3 * 33]); o.z = pk2(s[4 * 33], s[5 * 33]); o.w = pk2(s[6 * 33], s[7 * 33]);
        *(u32x4*)(WT + (size_t)(drow0 + n) * ldk + k0 + 8 * c) = o; }
    LDS_WAIT(); asm volatile("" ::: "memory");
}
struct WItem { const float* src; unsigned char* dst; int N, ldk; };
__device__ __forceinline__ WItem w_item(KArgs& a, int which, int r, int lane) {
    unsigned char* ws = a.ws; WItem it; const int e = r >> 9, q = r & 511; const int kq = lane >> 4, n4 = (lane & 15) * 4;
    if (which < 2) { const int kb = q >> 5, nb = q & 31, n0 = nb * 64; it.N = DFF; it.ldk = DM;
        it.src = a.in[18 + which] + (size_t)e * DM * DFF + (size_t)(kb * 64 + kq) * DFF + n0 + n4;
        it.dst = (unsigned char*)(ws + WS_WGU) + (size_t)e * 4096 * DM + (size_t)((n0 >> 7) * 256 + which * 128 + (n0 & 127)) * DM + kb * 64; }
    else { const int kb = q >> 4, nb = q & 15; it.N = DM; it.ldk = DFF;
        it.src = a.in[20] + (size_t)e * DFF * DM + (size_t)(kb * 64 + kq) * DM + nb * 64 + n4;
        it.dst = (unsigned char*)(ws + WS_WD) + (size_t)e * DM * DFF + (size_t)(nb * 64) * DFF + kb * 64; }
    return it;
}
__device__ __forceinline__ void w_load(const WItem& it, f32x4 (&v)[16]) {
#pragma unroll
    for (int i = 0; i < 16; ++i) v[i] = __builtin_nontemporal_load((const f32x4*)(it.src + (size_t)(4 * i) * it.N));
}
__device__ __forceinline__ void w_finish(const WItem& it, const f32x4 (&v)[16], LAS float* scr, int lane) {
    const int kq = lane >> 4, n4 = (lane & 15) * 4;
#pragma unroll
    for (int i = 0; i < 16; ++i) { const int kk = kq + 4 * i; *(LAS f32x4*)(scr + kk * 68 + ((n4 + 8 * (kk >> 4)) & 63)) = v[i] * 32.0f; }
    LDS_WAIT(); asm volatile("" ::: "memory");
    const int nl = lane >> 2, j = lane & 3;
#pragma unroll
    for (int p = 0; p < 4; ++p) { const int n = 16 * p + nl; const LAS float* sp = scr + (16 * j) * 68 + ((n + 8 * j) & 63);
        u32x4 o; o.x = pk4_fp8(sp[0 * 68], sp[1 * 68], sp[2 * 68], sp[3 * 68]); o.y = pk4_fp8(sp[4 * 68], sp[5 * 68], sp[6 * 68], sp[7 * 68]);
        o.z = pk4_fp8(sp[8 * 68], sp[9 * 68], sp[10 * 68], sp[11 * 68]); o.w = pk4_fp8(sp[12 * 68], sp[13 * 68], sp[14 * 68], sp[15 * 68]);
        __builtin_nontemporal_store(o, (u32x4*)(it.dst + (size_t)n * it.ldk + 16 * j)); }
    LDS_WAIT(); asm volatile("" ::: "memory");
}
constexpr int WD_SPLIT = 6144;
__device__ __forceinline__ void expert_w_items(const Frame& F, KArgs& a, int which, int gwi, int ngw, int r_lo = 0, int r_hi = 8192) {
    LAS float* scr = (LAS float*)(F.lds + F.wave * 17408);
    for (int r = r_lo + gwi; r < r_hi; r += ngw) { const WItem it = w_item(a, which, r, F.lane); f32x4 v[16]; w_load(it, v); w_finish(it, v, scr, F.lane); }
}
__device__ __forceinline__ void p0_prep(const Frame& F, KArgs& a) {
    unsigned char* ws = a.ws;
    LAS float* scr = (LAS float*)(F.lds + F.wave * 17408);
    const int gw = F.vcu * NWAVES + F.wave, NGW = F.G * NWAVES;
    for (int r0 = (a.rep_phase == 100) ? a.rep_n : 0; r0 >= 0; --r0) { const float* x = a.in[0]; bf16_t* xb = (bf16_t*)(ws + WS_XB); float* rstd = (float*)(ws + WS_RSTD1);
      for (int m = gw; m < MTOK; m += 2 * NGW) {
          const int m2 = m + NGW;
          const f32x4* xr = (const f32x4*)(x + (size_t)m * DM) + F.lane; const f32x4* xr2 = (const f32x4*)(x + (size_t)(m2 < MTOK ? m2 : m) * DM) + F.lane; f32x4 v[4], v2[4]; float s = 0.f, s2 = 0.f;
#pragma unroll
          for (int j = 0; j < 4; ++j) { v[j] = __builtin_nontemporal_load(xr + 64 * j); v2[j] = __builtin_nontemporal_load(xr2 + 64 * j); }
#pragma unroll
          for (int j = 0; j < 4; ++j) { s += (v[j].x * v[j].x + v[j].y * v[j].y) + (v[j].z * v[j].z + v[j].w * v[j].w); s2 += (v2[j].x * v2[j].x + v2[j].y * v2[j].y) + (v2[j].z * v2[j].z + v2[j].w * v2[j].w); }
          s = wave_sum(s); s2 = wave_sum(s2);
          if (F.lane == 0) { rstd[m] = 1.0f / sqrtf(s * (1.0f / DM) + EPS); if (m2 < MTOK) rstd[m2] = 1.0f / sqrtf(s2 * (1.0f / DM) + EPS); }
          unsigned long long* o8 = (unsigned long long*)(xb + (size_t)m * DM) + F.lane;
#pragma unroll
          for (int j = 0; j < 4; ++j) o8[64 * j] = (unsigned long long)pk2(v[j].x, v[j].y) | ((unsigned long long)pk2(v[j].z, v[j].w) << 32);
          if (m2 < MTOK) { unsigned long long* o82 = (unsigned long long*)(xb + (size_t)m2 * DM) + F.lane;
#pragma unroll
              for (int j = 0; j < 4; ++j) o82[64 * j] = (unsigned long long)pk2(v2[j].x, v2[j].y) | ((unsigned long long)pk2(v2[j].z, v2[j].w) << 32); }
      } }
    for (int r0 = (a.rep_phase == 101) ? a.rep_n : 0; r0 >= 0; --r0) { constexpr int I_WIN = 16 * 48, I_WOUT = 8 * 32;
      bf16_t* WinT = (bf16_t*)(ws + WS_WIN); bf16_t* W2T = (bf16_t*)(ws + WS_W2);
      for (int it = gw; it < I_WIN + I_WOUT; it += NGW) {
          int r = it;
          if (r < I_WIN) { const int kb = r / 48, nb = r % 48; transpose_item(a.in[2], NPROJ, kb * 64, nb * 32, WinT, DM, nb * 32, a.in[1], scr, F.lane); continue; } r -= I_WIN;
          { const int kb = r / 32, nb = r % 32; transpose_item(a.in[15], DM, kb * 64, nb * 32, W2T, KOUT, nb * 32, nullptr, scr, F.lane); }
      } }
    for (int r0 = (a.rep_phase == 102) ? a.rep_n : 0; r0 >= 0; --r0) { expert_w_items(F, a, 0, gw, NGW); expert_w_items(F, a, 1, gw, NGW); expert_w_items(F, a, 2, gw, NGW, 0, WD_SPLIT); }
    { LAS float* ctab = (LAS float*)(F.lds);
      __syncthreads();
      if (F.tid < 128) ctab[F.tid] = cospif((float)F.tid * (1.0f / 64.0f));
      __syncthreads();
      const float* wout = a.in[15]; bf16_t* W2T = (bf16_t*)(ws + WS_W2);
      for (int it = gw; it < 2048; it += NGW) {
          const int kb = it >> 4, nb = it & 15; const int krow0 = 512 + kb * 8; const int sn = (krow0 >= 1024) ? 1 : 0; const int cg0 = (krow0 - 512 - sn * 512); const int g = cg0 >> 7, c0 = cg0 & 127;
          const int n = nb * 64 + F.lane; float accv[8];
#pragma unroll
          for (int i = 0; i < 8; ++i) accv[i] = 0.f;
          const float* wp = wout + (size_t)(512 + g * 128) * DM + n;
#pragma unroll 1
          for (int jb = 0; jb < 128; jb += 32) { float wv[32];
#pragma unroll
              for (int jj = 0; jj < 32; ++jj) wv[jj] = wp[(size_t)(jb + jj) * DM];
#pragma unroll
              for (int jj = 0; jj < 32; ++jj) { const int j = jb + jj;
#pragma unroll
                  for (int i = 0; i < 8; ++i) { const int ph = (j * (c0 + i) - sn * 32) & 127; accv[i] += ctab[ph] * wv[jj]; } } }
          const float sc = sn ? (-1.0f / 1024.0f) : (1.0f / 1024.0f);
          u32x4 o; o.x = pk2(accv[0] * sc, accv[1] * sc); o.y = pk2(accv[2] * sc, accv[3] * sc); o.z = pk2(accv[4] * sc, accv[5] * sc); o.w = pk2(accv[6] * sc, accv[7] * sc);
          *(u32x4*)(W2T + (size_t)n * KOUT + krow0) = o;
      } }
    { bf16_t* WgT = (bf16_t*)(ws + WS_WGT);
      for (int o = (F.vcu * NTHREADS + F.tid); o < NHEAD * 256 * 64; o += F.G * NTHREADS) {
          const int k = o & 63, n = (o >> 6) & 255, h = o >> 14, mat = n >> 6, j = n & 63;
          const float* W = a.in[mat == 0 ? 5 : mat == 1 ? 7 : mat == 2 ? 10 : 12];
          WgT[o] = (bf16_t)f2bf(W[(h * 64 + k) * 64 + j]);
      } }
}

__device__ constexpr float TWR[32] = {1.000000000e+00f, 9.951847267e-01f, 9.807852804e-01f, 9.569403357e-01f, 9.238795325e-01f, 8.819212643e-01f, 8.314696123e-01f, 7.730104534e-01f, 7.071067812e-01f, 6.343932842e-01f, 5.555702330e-01f, 4.713967368e-01f, 3.826834324e-01f, 2.902846773e-01f, 1.950903220e-01f, 9.801714033e-02f, 0.0f, -9.801714033e-02f, -1.950903220e-01f, -2.902846773e-01f, -3.826834324e-01f, -4.713967368e-01f, -5.555702330e-01f, -6.343932842e-01f, -7.071067812e-01f, -7.730104534e-01f, -8.314696123e-01f, -8.819212643e-01f, -9.238795325e-01f, -9.569403357e-01f, -9.807852804e-01f, -9.951847267e-01f};
__device__ constexpr float TWI[32] = {-0.0f, -9.801714033e-02f, -1.950903220e-01f, -2.902846773e-01f, -3.826834324e-01f, -4.713967368e-01f, -5.555702330e-01f, -6.343932842e-01f, -7.071067812e-01f, -7.730104534e-01f, -8.314696123e-01f, -8.819212643e-01f, -9.238795325e-01f, -9.569403357e-01f, -9.807852804e-01f, -9.951847267e-01f, -1.000000000e+00f, -9.951847267e-01f, -9.807852804e-01f, -9.569403357e-01f, -9.238795325e-01f, -8.819212643e-01f, -8.314696123e-01f, -7.730104534e-01f, -7.071067812e-01f, -6.343932842e-01f, -5.555702330e-01f, -4.713967368e-01f, -3.826834324e-01f, -2.902846773e-01f, -1.950903220e-01f, -9.801714033e-02f};
constexpr int bitrev_c(int i, int n) { int r = 0; for (int b = 0; b < n; ++b) r |= ((i >> b) & 1) << (n - 1 - b); return r; }
template <int N, int ST, int L> struct FftStage {
    static __device__ __forceinline__ void run(float (&re)[N], float (&im)[N]) {
        constexpr int m = 1 << ST, h = m >> 1;
#pragma unroll
        for (int kk = 0; kk < N; kk += m) {
#pragma unroll
            for (int j = 0; j < h; ++j) {
                const float wr = TWR[j * (64 / m)], wi = TWI[j * (64 / m)];
                const float xr = re[kk + j + h], xi = im[kk + j + h];
                const float tr = wr * xr - wi * xi, ti = wr * xi + wi * xr;
                re[kk + j + h] = re[kk + j] - tr; im[kk + j + h] = im[kk + j] - ti;
                re[kk + j] += tr; im[kk + j] += ti;
            }
        }
        if constexpr (ST < L) FftStage<N, ST + 1, L>::run(re, im);
    }
};
template <int N, int L> __device__ __forceinline__ void fft_inreg(float (&re)[N], float (&im)[N]) {
#pragma unroll
    for (int i = 0; i < N; ++i) { const int j = bitrev_c(i, L); if (i < j) { float t = re[i]; re[i] = re[j]; re[j] = t; t = im[i]; im[i] = im[j]; im[j] = t; } }
    FftStage<N, 1, L>::run(re, im);
}

__device__ __forceinline__ void fft1_item(const Frame& F, const bf16_t* P, u32x2* V, int item) {
    const int b = item >> 7, sg = (item >> 3) & 15, cc = item & 7;
    const int s2a = 16 * sg + 2 * F.wave, c = cc * 64 + F.lane;
    float re[32], im[32];
    const bf16_t* src = P + ((size_t)b * SEQ + s2a) * NPROJ + 1024 + c;
#pragma unroll
    for (int i = 0; i < 32; ++i) { re[i] = bf2f(__builtin_nontemporal_load(src + (size_t)i * 256 * NPROJ)); im[i] = bf2f(__builtin_nontemporal_load(src + (size_t)i * 256 * NPROJ + NPROJ)); }
    fft_inreg<32, 5>(re, im);
    float sa, ca, sb, cb; sincospif((float)s2a * (1.0f / 4096.0f), &sa, &ca); sincospif((float)(s2a + 1) * (1.0f / 4096.0f), &sb, &cb);
    float war = 1.f, wai = 0.f, wbr = 1.f, wbi = 0.f;
    u32x2* dst = V + (((size_t)b * 17) * 128 + (s2a >> 1)) * 512 + c;
#pragma unroll
    for (int k = 0; k <= 16; ++k) {
        const int km = (32 - k) & 31;
        const float ar = 0.5f * (re[k] + re[km]), ai = 0.5f * (im[k] - im[km]), br = 0.5f * (im[k] + im[km]), bi = -0.5f * (re[k] - re[km]);
        f32x2 va, vb; va.x = ar * war - ai * wai; va.y = ar * wai + ai * war; vb.x = br * wbr - bi * wbi; vb.y = br * wbi + bi * wbr;
        dst[(size_t)k * 128 * 512] = (u32x2){pk2(va.x, va.y), pk2(vb.x, vb.y)};
        const float t0 = war * ca + wai * sa; wai = wai * ca - war * sa; war = t0;
        const float t1 = wbr * cb + wbi * sb; wbi = wbi * cb - wbr * sb; wbr = t1;
    }
}
__device__ __forceinline__ void fft2_item(const Frame& F, const u32x2* V, bf16_t* A2, int b, int k1, int cc) {
    const int w = F.wave, c = cc * 64 + F.lane;
    LAS f32x2* T = (LAS f32x2*)F.lds;
    { u32x2 pv[16];
      const u32x2* src = V + (((size_t)b * 17 + k1) * 128 + w) * 512 + c;
#pragma unroll
      for (int j1 = 0; j1 < 16; ++j1) pv[j1] = __builtin_nontemporal_load(src + (size_t)j1 * 8 * 512);
#pragma unroll
      for (int jj = 0; jj < 2; ++jj) { const int j2 = 2 * w + jj; float re[16], im[16];
#pragma unroll
          for (int j1 = 0; j1 < 16; ++j1) { const unsigned q = jj ? pv[j1].y : pv[j1].x; re[j1] = bf2f(q & 0xffffu); im[j1] = bf2f(q >> 16); }
          fft_inreg<16, 4>(re, im);
#pragma unroll
          for (int q1 = 0; q1 < 16; ++q1) { float sn, cs; sincospif((float)(q1 * j2) * (1.0f / 128.0f), &sn, &cs);
              f32x2 o; o.x = re[q1] * cs + im[q1] * sn; o.y = im[q1] * cs - re[q1] * sn; T[(q1 * 16 + j2) * 64 + F.lane] = o; } } }
    __syncthreads();
#pragma unroll 1
    for (int qq = 0; qq < 2; ++qq) { const int q1 = 2 * w + qq; float re[16], im[16];
#pragma unroll
        for (int j2 = 0; j2 < 16; ++j2) { const f32x2 v = T[(q1 * 16 + j2) * 64 + F.lane]; re[j2] = v.x; im[j2] = v.y; }
        fft_inreg<16, 4>(re, im);
#pragma unroll
        for (int q2 = 0; q2 < 16; ++q2) { const int k = k1 + 32 * (q1 + 16 * q2);
            bf16_t* d = A2 + ((size_t)b * SEQ + k) * KOUT + 512 + c; d[0] = (bf16_t)f2bf(re[q2]); d[512] = (bf16_t)f2bf(-im[q2]);
            if (k1 != 0 && k1 != 16) { bf16_t* dm = A2 + ((size_t)b * SEQ + (SEQ - k)) * KOUT + 512 + c; dm[0] = (bf16_t)f2bf(re[q2]); dm[512] = (bf16_t)f2bf(im[q2]); } } }
    __syncthreads();
}

constexpr int LRU_WG = 0, LRU_CS = 32768, LRU_CF = 49152, LRU_XT = 81920, LRU_GT = 98816  , LRU_AGW = 115200, LRU_WCAR = 123392, LRU_CARRY = 127488, LRU_CONST = 131584;
static_assert(LRU_XT + 131 * 128 <= LRU_GT && LRU_GT + 16384 <= LRU_AGW && LRU_AGW + 8192 <= LRU_WCAR && LRU_WCAR + 4096 <= LRU_CARRY && LRU_CARRY + 4096 <= LRU_CONST && LRU_CONST + 11 * 256 <= MISC_OFF, "LRU LDS map");
template <int PASS>
__device__ __forceinline__ void lru_super_item(const Frame& F, KArgs& a, int si) {
    const int b = si >> 6, h = (si >> 3) & 7, j0 = (si & 7) * 8;
    const int tid = F.tid, lane = F.lane, w = F.wave, fr = lane & 15, fq = lane >> 4;
    unsigned char* ws = a.ws;
    const bf16_t* P = (const bf16_t*)a.out;
    LAS unsigned char* lds = F.lds;
    f32x2* agg = (f32x2*)(ws + WS_AGG);
    { const bf16_t* WgT = (const bf16_t*)(ws + WS_WGT) + (size_t)h * 256 * 64;
#pragma unroll
      for (int i = 0; i < 4; ++i) { const int q = tid + 512 * i, n = q >> 3, ch = q & 7; const u32x4 v = *(const u32x4*)(WgT + n * 64 + ch * 8); *(LAS u32x4*)(lds + LRU_WG + n * 128 + ((ch ^ (n & 7)) << 4)) = v; } }
    { LAS float* KC = (LAS float*)(lds + LRU_CONST);
      if (tid < 64) { const int ch = h * 64 + tid;
          KC[0 * 64 + tid] = -8.0f * log1pf(expf(-a.in[9][ch])) * 1.4426950408889634f; KC[1 * 64 + tid] = -8.0f * log1pf(expf(-a.in[14][ch])) * 1.4426950408889634f;
          KC[2 * 64 + tid] = a.in[6][ch]; KC[3 * 64 + tid] = a.in[8][ch]; KC[4 * 64 + tid] = a.in[11][ch]; KC[5 * 64 + tid] = a.in[13][ch]; KC[6 * 64 + tid] = a.in[4][ch];
#pragma unroll
          for (int k = 0; k < 4; ++k) KC[(7 + k) * 64 + tid] = a.in[3][k * DLRU + ch]; } }
    const LAS float* KC = (const LAS float*)(lds + LRU_CONST);
    const int ch4 = tid & 15, tq = tid >> 4;
    if (PASS == 2) {
        if (tid < 128) { const int dir = tid >> 6, ch = tid & 63; LAS float* CAR = (LAS float*)(lds + LRU_CARRY);
            float carry = 0.f;
            if (dir == 0) { for (int jj = 0; jj < j0 + 8; ++jj) { if (jj >= j0) CAR[((jj - j0) * 2 + 0) * 64 + ch] = carry; const f32x2 ah = agg[(((size_t)b * 64 + jj) * 2 + 0) * 512 + h * 64 + ch]; carry = ah.x * carry + ah.y; } }
            else { for (int jj = 63; jj >= j0; --jj) { if (jj < j0 + 8) CAR[((jj - j0) * 2 + 1) * 64 + ch] = carry; const f32x2 ah = agg[(((size_t)b * 64 + jj) * 2 + 1) * 512 + h * 64 + ch]; carry = ah.x * carry + ah.y; } }
        }
    }
    __syncthreads();
    u32x4 px[3], pg[2];
#define LRU_LOAD_CHUNK(jj) do { const int _t0 = (jj) * 128; \
        _Pragma("unroll") for (int _i = 0; _i < 3; ++_i) { const int _q = tid + 512 * _i, _r = _q >> 3, _c = _q & 7, _t = _t0 - 2 + _r; px[_i] = (u32x4){0u, 0u, 0u, 0u}; \
            if (_q < 131 * 8 && _t >= 0 && _t < SEQ) { const u32x4* _p = (const u32x4*)(P + ((size_t)b * SEQ + _t) * NPROJ + h * 64 + _c * 8); px[_i] = (PASS == 2) ? __builtin_nontemporal_load(_p) : *_p; } } \
        if (PASS == 2) { _Pragma("unroll") for (int _i = 0; _i < 2; ++_i) { const int _q = tid + 512 * _i, _r = _q >> 3, _c = _q & 7; pg[_i] = __builtin_nontemporal_load((const u32x4*)(P + ((size_t)b * SEQ + _t0 + _r) * NPROJ + 512 + h * 64 + _c * 8)); } } } while (0)
    LRU_LOAD_CHUNK(j0);
    for (int jl = 0; jl < 8; ++jl) {
        const int j = j0 + jl, t0 = j * 128;
#pragma unroll
        for (int i = 0; i < 3; ++i) { const int q = tid + 512 * i, r = q >> 3, chk = q & 7; if (q < 131 * 8) *(LAS u32x4*)(lds + LRU_XT + r * 128 + chk * 16) = px[i]; }
        if (PASS == 2) {
#pragma unroll
            for (int i = 0; i < 2; ++i) { const int q = tid + 512 * i, r = q >> 3, chk = q & 7; *(LAS u32x4*)(lds + LRU_GT + r * 128 + chk * 16) = pg[i]; } }
        __syncthreads();
        if (jl < 7) LRU_LOAD_CHUNK(j + 1);
        { float xv[7][4]; const f32x4 cbias = *(const LAS f32x4*)(KC + 6 * 64 + ch4 * 4); f32x4 cwv[4];
#pragma unroll
          for (int k = 0; k < 4; ++k) cwv[k] = *(const LAS f32x4*)(KC + (7 + k) * 64 + ch4 * 4);
#pragma unroll
          for (int r = 0; r < 7; ++r) { const u32x2 v = *(const LAS u32x2*)(lds + LRU_XT + (4 * tq + r) * 128 + ch4 * 8); xv[r][0] = bf2f(v.x & 0xffffu); xv[r][1] = bf2f(v.x >> 16); xv[r][2] = bf2f(v.y & 0xffffu); xv[r][3] = bf2f(v.y >> 16); }
#pragma unroll
          for (int tt = 0; tt < 4; ++tt) { const int t = 4 * tq + tt; f32x4 cv;
#pragma unroll
              for (int i = 0; i < 4; ++i) { float s = cbias[i];
#pragma unroll
                  for (int k = 0; k < 4; ++k) s += cwv[k][i] * xv[tt + k][i];
                  cv[i] = s; }
              *(LAS f32x4*)(lds + LRU_CF + t * 256 + ch4 * 16) = cv;
              u32x2 pk; pk.x = pk2(cv[0], cv[1]); pk.y = pk2(cv[2], cv[3]);
              *(LAS u32x2*)(lds + LRU_CS + t * 128 + (((ch4 >> 1) ^ (t & 7)) << 4) + (ch4 & 1) * 8) = pk; } }
        __syncthreads();
        bf16x8 af[2];
        { const int row = 16 * w + fr;
#pragma unroll
          for (int kk = 0; kk < 2; ++kk) af[kk] = *(const LAS bf16x8*)(lds + LRU_CS + row * 128 + (((kk * 4 + fq) ^ (row & 7)) << 4)); }
#pragma unroll 1
        for (int hf = 0; hf < 2; ++hf) {
            float Pf[2][4], Hf[2][4], Pb[2][4], Hb[2][4];
#pragma unroll
            for (int cb = 0; cb < 2; ++cb) { const int cb4 = 2 * hf + cb;
                f32x4 acc[4];
#pragma unroll
                for (int mat = 0; mat < 4; ++mat) { acc[mat] = (f32x4){0.f, 0.f, 0.f, 0.f}; const int n = (mat * 4 + cb4) * 16 + fr;
#pragma unroll
                    for (int kk = 0; kk < 2; ++kk) { const bf16x8 bfr = *(const LAS bf16x8*)(lds + LRU_WG + n * 128 + (((kk * 4 + fq) ^ (n & 7)) << 4)); acc[mat] = __builtin_amdgcn_mfma_f32_16x16x32_bf16(af[kk], bfr, acc[mat], 0, 0, 0); } }
                float af_[4], bf_[4], ab_[4], bb_[4]; const int chl = cb4 * 16 + fr;
                const float k_c8f = KC[chl], k_c8b = KC[64 + chl], k_baf = KC[128 + chl], k_bxf = KC[192 + chl], k_bab = KC[256 + chl], k_bxb = KC[320 + chl];
#pragma unroll
                for (int r = 0; r < 4; ++r) { const int t = 16 * w + 4 * fq + r; const float cval = *(const LAS float*)(lds + LRU_CF + t * 256 + chl * 4);
                    const float rf = fast_sigmoid(acc[0][r] + k_baf), xf = fast_sigmoid(acc[1][r] + k_bxf);
                    const float rb = fast_sigmoid(acc[2][r] + k_bab), xb = fast_sigmoid(acc[3][r] + k_bxb);
                    const float a1 = __builtin_amdgcn_exp2f(k_c8f * rf), a2 = __builtin_amdgcn_exp2f(k_c8b * rb);
                    af_[r] = a1; bf_[r] = __builtin_amdgcn_sqrtf(fmaxf(fmaf(-a1, a1, 1.0f), 0.f)) * xf * cval;
                    ab_[r] = a2; bb_[r] = __builtin_amdgcn_sqrtf(fmaxf(fmaf(-a2, a2, 1.0f), 0.f)) * xb * cval; }
                Pf[cb][0] = af_[0]; Hf[cb][0] = bf_[0];
#pragma unroll
                for (int r = 1; r < 4; ++r) { Pf[cb][r] = af_[r] * Pf[cb][r - 1]; Hf[cb][r] = af_[r] * Hf[cb][r - 1] + bf_[r]; }
                Pb[cb][3] = ab_[3]; Hb[cb][3] = bb_[3];
#pragma unroll
                for (int r = 2; r >= 0; --r) { Pb[cb][r] = ab_[r] * Pb[cb][r + 1]; Hb[cb][r] = ab_[r] * Hb[cb][r + 1] + bb_[r]; }
            }
            float gPf[2], gHf[2], gPb[2], gHb[2];
            { LAS f32x2* AGW = (LAS f32x2*)(lds + LRU_AGW);
#pragma unroll
              for (int cb = 0; cb < 2; ++cb) { const int chl = (2 * hf + cb) * 16 + fr;
                  const bool odd = (fq & 1) != 0, hi = (fq & 2) != 0;
                  { const float A = Pf[cb][3], H = Hf[cb][3];
                    const float A1 = xchg16(A, lane), H1 = xchg16(H, lane);
                    const float pA = odd ? A1 : 1.f, pH = odd ? H1 : 0.f, qA = A * A1, qH = odd ? (A * H1 + H) : (A1 * H + H1);
                    const float QA = xchg32(qA, lane), QH = xchg32(qH, lane);
                    gPf[cb] = hi ? pA * QA : pA; gHf[cb] = hi ? (pA * QH + pH) : pH;
                    if (fq == 0) AGW[(w * 2 + 0) * 64 + chl] = (f32x2){qA * QA, QA * qH + QH}; }
                  { const float A = Pb[cb][0], H = Hb[cb][0];
                    const float A1 = xchg16(A, lane), H1 = xchg16(H, lane);
                    const float pA = odd ? 1.f : A1, pH = odd ? 0.f : H1, qA = A * A1, qH = odd ? (A1 * H + H1) : (A * H1 + H);
                    const float QA = xchg32(qA, lane), QH = xchg32(qH, lane);
                    gPb[cb] = hi ? pA : pA * QA; gHb[cb] = hi ? pH : (pA * QH + pH);
                    if (fq == 0) AGW[(w * 2 + 1) * 64 + chl] = (f32x2){qA * QA, qA * QH + qH}; }
              } }
            __syncthreads();
            if (tid < 64) { const int dir = tid >> 5, ch = hf * 32 + (tid & 31); const LAS f32x2* AGW = (const LAS f32x2*)(lds + LRU_AGW); LAS float* WCAR = (LAS float*)(lds + LRU_WCAR);
                float carry = (PASS == 2) ? ((const LAS float*)(lds + LRU_CARRY))[(jl * 2 + dir) * 64 + ch] : 0.f; float ptot = 1.f;
                if (dir == 0) { for (int ww = 0; ww < 8; ++ww) { WCAR[(ww * 2 + 0) * 64 + ch] = carry; const f32x2 ah = AGW[(ww * 2 + 0) * 64 + ch]; carry = ah.x * carry + ah.y; ptot *= ah.x; } }
                else { for (int ww = 7; ww >= 0; --ww) { WCAR[(ww * 2 + 1) * 64 + ch] = carry; const f32x2 ah = AGW[(ww * 2 + 1) * 64 + ch]; carry = ah.x * carry + ah.y; ptot *= ah.x; } }
                if (PASS == 1) agg[(((size_t)b * 64 + j) * 2 + dir) * 512 + h * 64 + ch] = (f32x2){ptot, carry};
            }
            if (PASS == 2) {
                __syncthreads();
                const LAS float* WCAR = (const LAS float*)(lds + LRU_WCAR);
#pragma unroll
                for (int cb = 0; cb < 2; ++cb) { const int ch = (2 * hf + cb) * 16 + fr;
                    const float cf = gHf[cb] + gPf[cb] * WCAR[(w * 2 + 0) * 64 + ch], cbk = gHb[cb] + gPb[cb] * WCAR[(w * 2 + 1) * 64 + ch];
#pragma unroll
                    for (int r = 0; r < 4; ++r) { const int t = 16 * w + 4 * fq + r; const float hs = (Hf[cb][r] + Pf[cb][r] * cf) + (Hb[cb][r] + Pb[cb][r] * cbk);
                        LAS bf16_t* gp = (LAS bf16_t*)(lds + LRU_GT + t * 128 + ch * 2); const float g = bf2f((unsigned)*gp);
                        const float u = 0.7978845608028654f * (g + 0.044715f * g * g * g); const float th = 1.0f - 2.0f * __builtin_amdgcn_rcpf(1.0f + __builtin_amdgcn_exp2f(2.885390081777927f * u));
                        *gp = (bf16_t)f2bf(0.5f * g * (1.0f + th) * hs); } }
            }
        }
        if (PASS == 2) {
            __syncthreads();
            bf16_t* A2 = (bf16_t*)(ws + WS_A2);
#pragma unroll
            for (int i = 0; i < 2; ++i) { const int q = tid + 512 * i, r = q >> 3, chk = q & 7; const u32x4 v = *(const LAS u32x4*)(lds + LRU_GT + r * 128 + chk * 16);
                *(u32x4*)(A2 + ((size_t)b * SEQ + t0 + r) * KOUT + h * 64 + chk * 8) = v; }
        }
        __syncthreads();
    }
#undef LRU_LOAD_CHUNK
}

constexpr int P5_PITCH = 2048 + 16;
__device__ __forceinline__ void p5_router(const Frame& F, KArgs& a) {
    unsigned char* ws = a.ws;
    LAS unsigned char* WH = F.lds; LAS unsigned char* WL = F.lds + 16 * P5_PITCH;
    { const float* wr = a.in[17];
      for (int o = F.tid; o < DM * NEXP; o += NTHREADS) { const int k = o >> 4, e = o & 15; const float w = wr[o]; const unsigned hi = f2bf(w); const float lo = w - bf2f(hi);
          *(LAS bf16_t*)(WH + e * P5_PITCH + k * 2) = (bf16_t)hi; *(LAS bf16_t*)(WL + e * P5_PITCH + k * 2) = (bf16_t)f2bf(lo); } }
    __syncthreads();
    const bf16_t* xm = (const bf16_t*)(ws + WS_DELTA); const float* g2 = a.in[16];
    unsigned char* h2 = (unsigned char*)(ws + WS_H2); float* scores = (float*)(ws + WS_SCORES); float* rstd2 = (float*)(ws + WS_RSTD1);
    const int gw = F.vcu * NWAVES + F.wave, NGW = F.G * NWAVES, fr = F.lane & 15, fq = F.lane >> 4;
    for (int grp = gw; grp < MTOK / 16; grp += NGW) {
        const int m0 = grp * 16;
        const bf16_t* xrow = xm + (size_t)(m0 + fr) * DM + 16 * fq; unsigned char* hrow = h2 + (size_t)(m0 + fr) * DM + 16 * fq;
        f32x4 acc = (f32x4){0.f, 0.f, 0.f, 0.f}; float ssq = 0.f;
#pragma unroll 2
        for (int kp = 0; kp < 16; ++kp) {
            const u32x4 x0 = *(const u32x4*)(xrow + 64 * kp), x1 = *(const u32x4*)(xrow + 64 * kp + 8); unsigned qq[4];
#pragma unroll
            for (int hh = 0; hh < 2; ++hh) { const u32x4 xv = hh ? x1 : x0; const int k0 = 64 * kp + 16 * fq + 8 * hh;
                f32x4 xa, xb; xa.x = bf2f(xv.x & 0xffffu); xa.y = bf2f(xv.x >> 16); xa.z = bf2f(xv.y & 0xffffu); xa.w = bf2f(xv.y >> 16); xb.x = bf2f(xv.z & 0xffffu); xb.y = bf2f(xv.z >> 16); xb.z = bf2f(xv.w & 0xffffu); xb.w = bf2f(xv.w >> 16);
                const f32x4 ga = *(const f32x4*)(g2 + k0), gb = *(const f32x4*)(g2 + k0 + 4);
                ssq += (xa.x * xa.x + xa.y * xa.y) + (xa.z * xa.z + xa.w * xa.w) + (xb.x * xb.x + xb.y * xb.y) + (xb.z * xb.z + xb.w * xb.w);
                const f32x4 va = xa * ga, vb = xb * gb;
                u32x4 hi, lo;
                hi.x = pk2(va.x, va.y); hi.y = pk2(va.z, va.w); hi.z = pk2(vb.x, vb.y); hi.w = pk2(vb.z, vb.w);
                lo.x = pk2(va.x - bf2f(hi.x & 0xffffu), va.y - bf2f(hi.x >> 16)); lo.y = pk2(va.z - bf2f(hi.y & 0xffffu), va.w - bf2f(hi.y >> 16));
                lo.z = pk2(vb.x - bf2f(hi.z & 0xffffu), vb.y - bf2f(hi.z >> 16)); lo.w = pk2(vb.z - bf2f(hi.w & 0xffffu), vb.w - bf2f(hi.w >> 16));
                const bf16x8 bh = *(const LAS bf16x8*)(WH + fr * P5_PITCH + k0 * 2), bl = *(const LAS bf16x8*)(WL + fr * P5_PITCH + k0 * 2);
                acc = __builtin_amdgcn_mfma_f32_16x16x32_bf16((bf16x8)hi, bh, acc, 0, 0, 0);
                acc = __builtin_amdgcn_mfma_f32_16x16x32_bf16((bf16x8)lo, bh, acc, 0, 0, 0);
                acc = __builtin_amdgcn_mfma_f32_16x16x32_bf16((bf16x8)hi, bl, acc, 0, 0, 0);
                qq[2 * hh] = pk4_fp8(va.x, va.y, va.z, va.w); qq[2 * hh + 1] = pk4_fp8(vb.x, vb.y, vb.z, vb.w); }
            *(u32x4*)(hrow + 64 * kp) = (u32x4){qq[0], qq[1], qq[2], qq[3]};
        }
        ssq += __shfl_xor(ssq, 16); ssq += __shfl_xor(ssq, 32);
        const float rs = 1.0f / sqrtf(ssq * (1.0f / DM) + EPS);
        if (fq == 0) rstd2[m0 + fr] = rs;
        f32x4 sc;
#pragma unroll
        for (int r = 0; r < 4; ++r) { const float l = acc[r] * __shfl(rs, 4 * fq + r);
            float mx = l;
#pragma unroll
            for (int o = 1; o < 16; o <<= 1) mx = fmaxf(mx, __shfl_xor(mx, o));
            const float ex = expf(l - mx); float sm = ex;
#pragma unroll
            for (int o = 1; o < 16; o <<= 1) sm += __shfl_xor(sm, o);
            sc[r] = ex / sm; }
        const int bb = m0 >> 13, s0 = m0 & (SEQ - 1);
        *(f32x4*)(scores + ((size_t)bb * NEXP + fr) * SEQ + s0 + 4 * fq) = sc;
    }
}

__device__ __forceinline__ void p6_topk_item(const Frame& F, KArgs& a, int item) {
    unsigned char* ws = a.ws; const int b = item >> 4, e = item & 15, tid = F.tid;
    const float* sc = (const float*)(ws + WS_SCORES) + (size_t)item * SEQ;
    int* tok = (int*)(ws + WS_TOK) + e * EROWS + b * CAP; float* gate = (float*)(ws + WS_GATE) + e * EROWS + b * CAP; int* inv = (int*)(ws + WS_INV) + (size_t)item * SEQ;
    float* rsl = (float*)(ws + WS_RS) + e * EROWS + b * CAP; const float* rstd2 = (const float*)(ws + WS_RSTD1) + b * SEQ;
    LAS unsigned* hist = (LAS unsigned*)F.lds;
    LAS unsigned* sfx = hist + 256;
    LAS unsigned* bc = hist + 512;
    LAS unsigned* scan = hist + 768;
    unsigned key[16];
    { const u32x4* p = (const u32x4*)(sc + tid * 16);
#pragma unroll
      for (int i = 0; i < 4; ++i) { const u32x4 v = p[i]; key[4 * i] = v.x; key[4 * i + 1] = v.y; key[4 * i + 2] = v.z; key[4 * i + 3] = v.w; } }
    unsigned prefix = 0, need = CAP;
    const int lane = F.lane, wv = F.wave;
    if (tid < 256) hist[tid] = 0u;
    __syncthreads();
#pragma unroll 1
    for (int pass = 0; pass < 4; ++pass) {
        const int shift = 24 - 8 * pass; const unsigned himask = pass == 0 ? 0u : (0xffffffffu << (shift + 8));
#pragma unroll
        for (int i = 0; i < 16; ++i) if ((key[i] & himask) == prefix) __hip_atomic_fetch_add(&hist[(key[i] >> shift) & 255u], 1u, __ATOMIC_RELAXED, __HIP_MEMORY_SCOPE_WORKGROUP);
        __syncthreads();
        unsigned hv = 0u, sv = 0u;
        if (tid < 256) { hv = hist[tid]; hist[tid] = 0u; sv = hv;
#pragma unroll
            for (int d = 1; d < 64; d <<= 1) { const unsigned o = __shfl_down(sv, d); if (lane + d < 64) sv += o; }
            if (lane == 0) sfx[wv] = sv; }
        __syncthreads();
        if (tid < 256) { unsigned ge = sv;
#pragma unroll
            for (int k = 1; k < 4; ++k) if (wv + k < 4) ge += sfx[wv + k];
            const unsigned gt = ge - hv;
            if (ge >= need && gt < need) { bc[0] = prefix | ((unsigned)tid << shift); bc[1] = need - gt; } }
        __syncthreads();
        prefix = bc[0]; need = bc[1];
    }
    const unsigned T = prefix;
    unsigned ngt = 0, neq = 0;
#pragma unroll
    for (int i = 0; i < 16; ++i) { ngt += key[i] > T ? 1u : 0u; neq += key[i] == T ? 1u : 0u; }
    unsigned incl = ngt | (neq << 16);
#pragma unroll
    for (int d = 1; d < 64; d <<= 1) { const unsigned o = __shfl_up(incl, d); if (lane >= d) incl += o; }
    if (lane == 63) scan[wv] = incl;
    __syncthreads();
    unsigned tot = 0u;
#pragma unroll
    for (int k = 0; k < 8; ++k) { const unsigned wt = scan[k]; if (k < wv) incl += wt; tot += wt; }
    const unsigned totgt = tot & 0xffffu;
    unsigned pgt = (incl & 0xffffu) - ngt, peq = (incl >> 16) - neq;
#pragma unroll
    for (int i = 0; i < 16; ++i) { const int s = tid * 16 + i; int slot = -1;
        if (key[i] > T) { slot = (int)pgt; ++pgt; }
        else if (key[i] == T) { if (peq < need) slot = (int)(totgt + peq); ++peq; }
        inv[s] = slot;
        if (slot >= 0) { tok[slot] = b * SEQ + s; gate[slot] = __builtin_bit_cast(float, key[i]); rsl[slot] = rstd2[s]; } }
    __syncthreads();
}

__device__ __forceinline__ void p9_final(const Frame& F, KArgs& a, float* dst) {
    unsigned char* ws = a.ws; const bf16_t* dl = (const bf16_t*)(ws + WS_DELTA); const float* gf = a.in[21]; const unsigned char* eo = (const unsigned char*)(ws + WS_EO); const int* inv = (const int*)(ws + WS_INV);
    const int gw = F.vcu * NWAVES + F.wave, NGW = F.G * NWAVES;
    f32x4 gv[4];
#pragma unroll
    for (int j = 0; j < 4; ++j) gv[j] = ((const f32x4*)gf)[F.lane + 64 * j];
    unsigned long long dn[4]; int slotn = -1;
    { const int m0 = gw < MTOK ? gw : 0; const unsigned long long* dr = (const unsigned long long*)(dl + (size_t)m0 * DM) + F.lane;
#pragma unroll
      for (int j = 0; j < 4; ++j) dn[j] = __builtin_nontemporal_load(dr + 64 * j);
      if (F.lane < 16) slotn = inv[((size_t)(m0 >> 13) * NEXP + F.lane) * SEQ + (m0 & (SEQ - 1))]; }
    for (int m = gw; m < MTOK; m += NGW) {
        f32x4 v[4]; const int myslot = slotn;
#pragma unroll
        for (int j = 0; j < 4; ++j) { const unsigned lo = (unsigned)dn[j], hi = (unsigned)(dn[j] >> 32); v[j].x = bf2f(lo & 0xffffu); v[j].y = bf2f(lo >> 16); v[j].z = bf2f(hi & 0xffffu); v[j].w = bf2f(hi >> 16); }
        const int bb = m >> 13;
        { const int mn = (m + NGW < MTOK) ? m + NGW : m; const unsigned long long* dr = (const unsigned long long*)(dl + (size_t)mn * DM) + F.lane;
#pragma unroll
          for (int j = 0; j < 4; ++j) dn[j] = __builtin_nontemporal_load(dr + 64 * j);
          slotn = -1; if (F.lane < 16) slotn = inv[((size_t)(mn >> 13) * NEXP + F.lane) * SEQ + (mn & (SEQ - 1))]; }
#if !DBG_NO_MOE
        unsigned mask = (unsigned)__ballot(myslot >= 0) & 0xffffu;
        while (mask) {
            unsigned q[4][4]; int ne = 0;
#pragma unroll
            for (int t = 0; t < 4; ++t) { if (mask) { const int e = __builtin_ctz(mask); mask &= mask - 1u; const int slot = __builtin_amdgcn_readlane(myslot, e);
                    const unsigned* er = (const unsigned*)(eo + ((size_t)e * EROWS + bb * CAP + slot) * DM) + F.lane;
#pragma unroll
                    for (int j = 0; j < 4; ++j) q[t][j] = __builtin_nontemporal_load(er + 64 * j);
                    ne = t + 1; } }
#pragma unroll
            for (int t = 0; t < 4; ++t) { if (t < ne) {
#pragma unroll
                    for (int j = 0; j < 4; ++j) { const f32x2 lo = __builtin_amdgcn_cvt_pk_f32_fp8((int)q[t][j], false), hi = __builtin_amdgcn_cvt_pk_f32_fp8((int)q[t][j], true);
                        v[j].x += lo.x * 0.0625f; v[j].y += lo.y * 0.0625f; v[j].z += hi.x * 0.0625f; v[j].w += hi.y * 0.0625f; } } }
        }
#endif
        float s = 0.f;
#pragma unroll
        for (int j = 0; j < 4; ++j) s += (v[j].x * v[j].x + v[j].y * v[j].y) + (v[j].z * v[j].z + v[j].w * v[j].w);
        const float rstd = 1.0f / sqrtf(wave_sum(s) * (1.0f / DM) + EPS);
        f32x4* xw = (f32x4*)(dst + (size_t)m * DM) + F.lane;
#pragma unroll
        for (int j = 0; j < 4; ++j) xw[64 * j] = v[j] * rstd * gv[j];
    }
}

__global__ void __launch_bounds__(NTHREADS, 2) fwd(Args args) {
    extern __shared__ __attribute__((aligned(16))) unsigned char lds_raw[];
    Frame F;
    F.lds = (LAS unsigned char*)lds_raw;
    F.tid = threadIdx.x; F.lane = F.tid & 63; F.wave = __builtin_amdgcn_readfirstlane(F.tid >> 6);
    F.G = gridDim.x; F.bx = blockIdx.x; F.vcu = (F.G % 8 == 0) ? (F.bx % 8) * (F.G / 8) + F.bx / 8 : F.bx;
    volatile LAS unsigned* MISC = (volatile LAS unsigned*)(F.lds + MISC_OFF);
    if (F.tid < 16) MISC[F.tid] = 0u;
    __syncthreads();
    KArgs* kap = (KArgs*)__builtin_amdgcn_kernarg_segment_ptr();
    unsigned char* ws = args.ws;
    unsigned* ctl = (unsigned*)(ws + WS_CTL);
    const int lo = args.ph_lo, hi = args.ph_hi;
    const __amdgpu_buffer_rsrc_t rsrc = __builtin_amdgcn_make_buffer_rsrc((void*)ws, (short)0, (int)0x7fffffff, (int)0x00020000);
#if !N_LAUNCH_PER_PHASE
    XcdBarrier bar = xcd_barrier_post(ctl + 1024, MISC + 8);
#if USE_COOP == 1
    cg::this_grid().sync();
#endif
#define GRID_BAR() xcd_barrier(bar)
#else
#define GRID_BAR() do {} while (0)
#endif
#ifdef ONLY_PHASE
#define IN(k) ((k) == ONLY_PHASE && lo <= (k) && (k) < hi)
#else
#define IN(k) (lo <= (k) && (k) < hi)
#endif
#define REFRESH() int t_ = threadIdx.x; asm volatile("" : "+v"(t_)); F.tid = t_; F.lane = t_ & 63; F.wave = __builtin_amdgcn_readfirstlane(t_ >> 6); KArgs* ap_ = kap; asm volatile("" : "+s"(ap_)); KArgs& A = *ap_
#define REPS(k) for (int rep = (args.rep_phase == (k)) ? args.rep_n : 0; rep >= 0; --rep)
    if (IN(0)) REPS(0) { REFRESH(); p0_prep(F, A); GRID_BAR(); }
    if (IN(1)) REPS(1) { REFRESH();
        pg8::DenseOrder S; S.init(WS_XB, WS_WIN, MTOK, NPROJ, DM, F.G, F.bx);
        pg8::EpiP E{(bf16_t*)A.out, (unsigned)WS_RSTD1};
        pg8::gemm_phase<pg8::EpiP, pg8::DenseOrder, false, false>(F.lds, rsrc, F.tid, DM * 2, S, E);
        GRID_BAR();
    }
    if (IN(2)) REPS(2) { REFRESH();
        for (int r2 = (A.rep_phase == 20) ? A.rep_n : 0; r2 >= 0; --r2)
        for (int si = F.bx; si < 256; si += F.G) lru_super_item<1>(F, A, si);
        for (int r2 = (A.rep_phase == 21) ? A.rep_n : 0; r2 >= 0; --r2)
        for (int it = F.bx; it < 512; it += F.G) fft1_item(F, (const bf16_t*)A.out, (u32x2*)(ws + WS_V), it);
        GRID_BAR();
    }
    if (IN(3)) REPS(3) { REFRESH();
        for (int r2 = (A.rep_phase == 30) ? A.rep_n : 0; r2 >= 0; --r2)
        for (int si = F.bx; si < 256; si += F.G) lru_super_item<2>(F, A, si);
        for (int r2 = (A.rep_phase == 31) ? A.rep_n : 0; r2 >= 0; --r2)
        for (int it = F.bx; it < NB * 16 * 8; it += F.G) { const int cc = it & 7, kk = (it >> 3) & 15, b = it >> 7;
            if (kk == 0) { fft2_item(F, (const u32x2*)(ws + WS_V), (bf16_t*)(ws + WS_A2), b, 0, cc); fft2_item(F, (const u32x2*)(ws + WS_V), (bf16_t*)(ws + WS_A2), b, 16, cc); }
            else fft2_item(F, (const u32x2*)(ws + WS_V), (bf16_t*)(ws + WS_A2), b, kk, cc); }
        GRID_BAR();
    }
    if (IN(4)) REPS(4) { REFRESH();
        pg8::DenseOrder S; S.init(WS_A2, WS_W2, MTOK, DM, KOUT, F.G, F.bx);
        pg8::EpiD E{(bf16_t*)(ws + WS_DELTA), (const bf16_t*)(ws + WS_XB)};
        pg8::gemm_phase<pg8::EpiD, pg8::DenseOrder, false, false>(F.lds, rsrc, F.tid, KOUT * 2, S, E);
        GRID_BAR();
    }
    if (IN(5)) REPS(5) { REFRESH(); p5_router(F, A); GRID_BAR(); }
    if (IN(6)) REPS(6) { REFRESH();
        if (F.G > NB * NEXP) { if (F.bx < NB * NEXP) p6_topk_item(F, A, F.bx); else expert_w_items(F, A, 2, (F.bx - NB * NEXP) * NWAVES + F.wave, (F.G - NB * NEXP) * NWAVES, WD_SPLIT, 8192); }
        else { for (int it = F.bx; it < NB * NEXP; it += F.G) p6_topk_item(F, A, it); expert_w_items(F, A, 2, F.bx * NWAVES + F.wave, F.G * NWAVES, WD_SPLIT, 8192); }
        GRID_BAR(); }
#if !DBG_NO_MOE
    if (IN(7)) REPS(7) { REFRESH();
        pg8::G1Order S{(unsigned)WS_H2, (unsigned)WS_WGU, (const int*)(ws + WS_TOK), F.G, F.bx};
        pg8::EpiH E{(unsigned char*)(ws + WS_H), (unsigned)WS_RS};
        pg8::gemm_phase<pg8::EpiH, pg8::G1Order, true, true>(F.lds, rsrc, F.tid, DM, S, E);
        GRID_BAR();
    }
    if (IN(8)) REPS(8) { REFRESH();
        pg8::G2Order S{(unsigned)WS_H, (unsigned)WS_WD, F.G, F.bx};
        pg8::EpiEo E{(unsigned char*)(ws + WS_EO), (unsigned)WS_GATE};
        pg8::gemm_phase<pg8::EpiEo, pg8::G2Order, false, true>(F.lds, rsrc, F.tid, DFF, S, E);
        GRID_BAR();
    }
#endif
    if (IN(9)) REPS(9) { REFRESH(); p9_final(F, A, rep > 0 ? (float*)(ws + WS_H) : A.out); if (rep > 0) GRID_BAR(); }
#undef IN
}

extern "C" void kernel_launch(void* const* d_in, const int* in_sizes, int n_in, void* d_out, int out_size, void* d_ws, size_t ws_size, hipStream_t stream) {
    static int grid = 0;
    if (grid == 0) {
        if (n_in != 22 || out_size != MTOK * DM || ws_size < WS_END) { fprintf(stderr, "kernel_launch: unexpected problem (n_in %d out %d ws %zu)\n", n_in, out_size, ws_size); grid = -1; return; }
        int dev = 0, cus = 0, per_cu = 0;
        (void)hipGetDevice(&dev);
        (void)hipDeviceGetAttribute(&cus, hipDeviceAttributeMultiprocessorCount, dev);
        (void)hipFuncSetAttribute((const void*)fwd, hipFuncAttributeMaxDynamicSharedMemorySize, LDS_BYTES);
        (void)hipOccupancyMaxActiveBlocksPerMultiprocessor(&per_cu, (const void*)fwd, NTHREADS, LDS_BYTES);
        (void)hipGetLastError();
        if (per_cu < 1) { fprintf(stderr, "kernel_launch: occupancy query says %d workgroups per CU; nothing launched\n", per_cu); grid = -1; return; }
        grid = cus * 1;
    }
    if (grid < 0) return;
    (void)hipMemsetAsync((char*)d_ws + WS_CTL, 0, 65536, stream);
    Args a{};
    for (int i = 0; i < 22; ++i) a.in[i] = (const float*)d_in[i];
    a.out = (float*)d_out; a.ws = (unsigned char*)d_ws; a.rep_phase = REPEAT_PHASE; a.rep_n = REPEAT_N;
#if N_LAUNCH_PER_PHASE
    for (int p = 0; p < 10; ++p) { a.ph_lo = p; a.ph_hi = p + 1; hipLaunchKernelGGL(fwd, dim3(grid), dim3(NTHREADS), LDS_BYTES, stream, a); }
#else
    a.ph_lo = 0; a.ph_hi = 10;
    void* kargs[] = {&a};
#if USE_COOP
    hipError_t e = hipLaunchCooperativeKernel((const void*)fwd, dim3(grid), dim3(NTHREADS), kargs, LDS_BYTES, stream);
    if (e != hipSuccess) fprintf(stderr, "cooperative launch failed: %s (grid %d)\n", hipGetErrorString(e), grid);
#else
    (void)kargs; hipLaunchKernelGGL(fwd, dim3(grid), dim3(NTHREADS), LDS_BYTES, stream, a);
#endif
#endif
}
```
